# Optimizing an MI355X kernel written in HIP

```python
import jax, jax.numpy as jnp
from jax import lax
import numpy as np

D_MODEL = 1024
BATCH = 16
SEQ = 2048
DEPTH = 2

N_MIXERS = 2
D_RNN = 1280
LRU_BLOCKS = 16
LRU_BLOCK_W = D_RNN // LRU_BLOCKS
CONV_W = 4
LRU_C = 8.0
N_HEADS = 16
N_KV_HEADS = 4
HEAD_DIM = 64
GROUP = N_HEADS // N_KV_HEADS
WINDOW = 128
ATT_BLOCK = WINDOW
Q_DIM = N_HEADS * HEAD_DIM
KV_DIM = N_KV_HEADS * HEAD_DIM
QKV_DIM = Q_DIM + 2 * KV_DIM
N_GROUPS = 4
EXPERTS_PER_GROUP = 8
N_EXPERTS = N_GROUPS * EXPERTS_PER_GROUP
TOP_K = 2
D_EXPERT = 512
MOE_BLOCK = 128
ALPHA = (2 * DEPTH) ** 0.25
BETA = (8 * DEPTH) ** -0.25
LN_EPS = 1e-5
N_REC_LAYERS = (DEPTH + N_MIXERS - 1) // N_MIXERS
N_ATT_LAYERS = DEPTH // N_MIXERS

kernel_name = 'hybrid_rglru_swa_sink_alibi_hmoe'


def layer_norm(x, g, b):
    xf = x.astype(jnp.float32)
    mu = jnp.mean(xf, axis=-1, keepdims=True)
    xc = xf - mu
    var = jnp.mean(xc * xc, axis=-1, keepdims=True)
    y = xc * lax.rsqrt(var + LN_EPS) * g.astype(jnp.float32) + b.astype(jnp.float32)
    return y.astype(x.dtype)


def _linear_recurrence_combine(c1, c2):
    a1, b1 = c1
    a2, b2 = c2
    return a1 * a2, a2 * b1 + b2


def rglru_block(x, w_in, conv_w, conv_b, w_r, b_r, w_i, b_i, lam, w_out):
    B, S, _ = x.shape
    gate, xr = jnp.split(x @ w_in, 2, axis=-1)
    xp = jnp.pad(xr, ((0, 0), (CONV_W - 1, 0), (0, 0)))
    xc = conv_b + sum(xp[:, k:k + S] * conv_w[k] for k in range(CONV_W))
    xb = xc.reshape(B, S, LRU_BLOCKS, LRU_BLOCK_W)
    r = jax.nn.sigmoid(jnp.einsum('bsnk,nkj->bsnj', xb, w_r).reshape(B, S, D_RNN) + b_r)
    i = jax.nn.sigmoid(jnp.einsum('bsnk,nkj->bsnj', xb, w_i).reshape(B, S, D_RNN) + b_i)
    log_a = -LRU_C * r.astype(jnp.float32) * jax.nn.softplus(-lam.astype(jnp.float32))
    a = jnp.exp(log_a)
    u = jnp.sqrt(-jnp.expm1(2.0 * log_a)) * (i * xc).astype(jnp.float32)
    _, h = lax.associative_scan(_linear_recurrence_combine, (a, u), axis=1)
    y = h.astype(x.dtype) * jax.nn.gelu(gate)
    return y @ w_out


def alibi_slopes():
    return 2.0 ** (-8.0 * jnp.arange(1, N_HEADS + 1, dtype=jnp.float32) / N_HEADS)


def _with_prev_block(t):
    prev = jnp.concatenate([jnp.zeros_like(t[:, :1]), t[:, :-1]], axis=1)
    return jnp.concatenate([prev, t], axis=2)


def swa_sink_alibi(x, w_qkv, sinks, w_o):
    B, S, _ = x.shape
    NB = S // ATT_BLOCK
    qkv = x @ w_qkv
    q = qkv[..., :Q_DIM].reshape(B, NB, ATT_BLOCK, N_KV_HEADS, GROUP, HEAD_DIM) * (HEAD_DIM ** -0.5)
    k = qkv[..., Q_DIM:Q_DIM + KV_DIM].reshape(B, NB, ATT_BLOCK, N_KV_HEADS, HEAD_DIM)
    v = qkv[..., Q_DIM + KV_DIM:].reshape(B, NB, ATT_BLOCK, N_KV_HEADS, HEAD_DIM)
    kk = _with_prev_block(k)
    vv = _with_prev_block(v)
    s = jnp.einsum('bnqkgd,bnskd->bnkgqs', q, kk).astype(jnp.float32)
    qi = jnp.arange(ATT_BLOCK)[:, None]
    sj = jnp.arange(2 * ATT_BLOCK)[None, :]
    dist = qi - sj + ATT_BLOCK
    valid = (dist >= 0) & (dist < WINDOW)
    not_before_start = (jnp.arange(NB)[:, None, None] > 0) | (sj[None] >= ATT_BLOCK)
    mask = valid[None] & not_before_start
    slopes = alibi_slopes().reshape(N_KV_HEADS, GROUP)
    s = s - slopes[:, :, None, None] * dist.astype(jnp.float32)
    s = jnp.where(mask[None, :, None, None], s, -jnp.inf)
    sink = sinks.astype(jnp.float32).reshape(N_KV_HEADS, GROUP)[None, None, :, :, None, None]
    m = jnp.maximum(jnp.max(s, axis=-1, keepdims=True), sink)
    p = jnp.exp(s - m)
    denom = jnp.sum(p, axis=-1, keepdims=True) + jnp.exp(sink - m)
    o = jnp.einsum('bnkgqs,bnskd->bnqkgd', (p / denom).astype(x.dtype), vv)
    return o.reshape(B, S, Q_DIM) @ w_o


def hier_moe(x, w_rg, b_rg, w_re, b_re, w1, w3, w2):
    B, S, D = x.shape
    T = B * S
    TK = T * TOP_K
    xf = x.reshape(T, D)
    g_logits = (xf @ w_rg + b_rg).astype(jnp.float32)
    g_idx = jnp.argmax(g_logits, axis=-1)
    g_gate = jnp.take_along_axis(jax.nn.softmax(g_logits, axis=-1), g_idx[:, None], axis=1)
    e_logits = (xf @ w_re + b_re).astype(jnp.float32).reshape(T, N_GROUPS, EXPERTS_PER_GROUP)
    e_in_group = jnp.take_along_axis(e_logits, g_idx[:, None, None], axis=1)[:, 0]
    top_v, top_i = lax.top_k(e_in_group, TOP_K)
    gates = jax.nn.softmax(top_v, axis=-1) * g_gate
    expert = g_idx[:, None] * EXPERTS_PER_GROUP + top_i
    flat_e = expert.reshape(TK)
    order = jnp.argsort(flat_e)
    sorted_e = flat_e[order]
    counts = jnp.bincount(flat_e, length=N_EXPERTS)
    padded = ((counts + MOE_BLOCK - 1) // MOE_BLOCK) * MOE_BLOCK
    starts = jnp.cumsum(counts) - counts
    pends = jnp.cumsum(padded)
    pstarts = pends - padded
    dest = pstarts[sorted_e] + (jnp.arange(TK) - starts[sorted_e])
    slot_dest = jnp.zeros_like(dest).at[order].set(dest)
    n_blocks = -(-(TK + N_EXPERTS * (MOE_BLOCK - 1)) // MOE_BLOCK)
    n_rows = n_blocks * MOE_BLOCK
    xbuf = jnp.zeros((n_rows, D), x.dtype).at[slot_dest].set(jnp.repeat(xf, TOP_K, axis=0))
    block_start = jnp.arange(n_blocks) * MOE_BLOCK
    block_e = jnp.minimum(jnp.sum(block_start[:, None] >= pends[None, :], axis=1), N_EXPERTS - 1)

    def expert_block(args):
        xb, e = args
        hdn = jax.nn.silu(xb @ w1[e]) * (xb @ w3[e])
        return hdn @ w2[e]

    ybuf = lax.map(expert_block, (xbuf.reshape(n_blocks, MOE_BLOCK, D), block_e)).reshape(n_rows, D)
    y_slots = ybuf[slot_dest].reshape(T, TOP_K, D)
    out = jnp.einsum('tk,tkd->td', gates.astype(x.dtype), y_slots)
    return out.reshape(B, S, D)


def setup_inputs(seed: int = 0) -> dict:
    key = jax.random.key(seed)
    ks = jax.random.split(key, 24)

    def nrm(k, shape, scale):
        return jax.random.normal(k, shape, jnp.float32) * scale

    x = nrm(ks[0], (BATCH, SEQ, D_MODEL), 1.0)
    rec_w_in = nrm(ks[1], (N_REC_LAYERS, D_MODEL, 2 * D_RNN), D_MODEL ** -0.5)
    rec_conv_w = nrm(ks[2], (N_REC_LAYERS, CONV_W, D_RNN), CONV_W ** -0.5)
    rec_conv_b = nrm(ks[3], (N_REC_LAYERS, D_RNN), 0.01)
    rec_w_r = nrm(ks[4], (N_REC_LAYERS, LRU_BLOCKS, LRU_BLOCK_W, LRU_BLOCK_W), LRU_BLOCK_W ** -0.5)
    rec_b_r = nrm(ks[5], (N_REC_LAYERS, D_RNN), 0.01)
    rec_w_i = nrm(ks[6], (N_REC_LAYERS, LRU_BLOCKS, LRU_BLOCK_W, LRU_BLOCK_W), LRU_BLOCK_W ** -0.5)
    rec_b_i = nrm(ks[7], (N_REC_LAYERS, D_RNN), 0.01)
    a_c = jax.random.uniform(ks[8], (N_REC_LAYERS, D_RNN), jnp.float32, minval=0.9, maxval=0.999)
    a0 = a_c ** (1.0 / LRU_C)
    rec_lambda = jnp.log(a0) - jnp.log1p(-a0)
    rec_w_out = nrm(ks[9], (N_REC_LAYERS, D_RNN, D_MODEL), BETA * D_RNN ** -0.5)
    col_scale = jnp.concatenate([jnp.ones((Q_DIM + KV_DIM,), jnp.float32), jnp.full((KV_DIM,), BETA, jnp.float32)])
    att_w_qkv = nrm(ks[10], (N_ATT_LAYERS, D_MODEL, QKV_DIM), D_MODEL ** -0.5) * col_scale
    att_sinks = nrm(ks[11], (N_ATT_LAYERS, N_HEADS), 0.5)
    att_w_o = nrm(ks[12], (N_ATT_LAYERS, Q_DIM, D_MODEL), BETA * Q_DIM ** -0.5)
    moe_w_group = nrm(ks[13], (DEPTH, D_MODEL, N_GROUPS), D_MODEL ** -0.5)
    moe_b_group = nrm(ks[14], (DEPTH, N_GROUPS), 0.01)
    moe_w_expert = nrm(ks[15], (DEPTH, D_MODEL, N_EXPERTS), D_MODEL ** -0.5)
    moe_b_expert = nrm(ks[16], (DEPTH, N_EXPERTS), 0.01)
    moe_w1 = nrm(ks[17], (DEPTH, N_EXPERTS, D_MODEL, D_EXPERT), D_MODEL ** -0.5)
    moe_w3 = nrm(ks[18], (DEPTH, N_EXPERTS, D_MODEL, D_EXPERT), D_MODEL ** -0.5)
    moe_w2 = nrm(ks[19], (DEPTH, N_EXPERTS, D_EXPERT, D_MODEL), BETA * D_EXPERT ** -0.5)
    ln_g = 1.0 + nrm(ks[20], (DEPTH, 2, D_MODEL), 0.02)
    ln_b = nrm(ks[21], (DEPTH, 2, D_MODEL), 0.02)
    return {'x': x, 'rec_w_in': rec_w_in, 'rec_conv_w': rec_conv_w, 'rec_conv_b': rec_conv_b,
            'rec_w_r': rec_w_r, 'rec_b_r': rec_b_r, 'rec_w_i': rec_w_i, 'rec_b_i': rec_b_i,
            'rec_lambda': rec_lambda, 'rec_w_out': rec_w_out, 'att_w_qkv': att_w_qkv,
            'att_sinks': att_sinks, 'att_w_o': att_w_o, 'moe_w_group': moe_w_group,
            'moe_b_group': moe_b_group, 'moe_w_expert': moe_w_expert, 'moe_b_expert': moe_b_expert,
            'moe_w1': moe_w1, 'moe_w3': moe_w3, 'moe_w2': moe_w2, 'ln_g': ln_g, 'ln_b': ln_b}


def reference(x, rec_w_in, rec_conv_w, rec_conv_b, rec_w_r, rec_b_r, rec_w_i, rec_b_i, rec_lambda,
              rec_w_out, att_w_qkv, att_sinks, att_w_o, moe_w_group, moe_b_group, moe_w_expert,
              moe_b_expert, moe_w1, moe_w3, moe_w2, ln_g, ln_b):
    for layer in range(DEPTH):
        j = layer // N_MIXERS
        if layer % N_MIXERS == 0:
            h = rglru_block(x, rec_w_in[j], rec_conv_w[j], rec_conv_b[j], rec_w_r[j], rec_b_r[j],
                            rec_w_i[j], rec_b_i[j], rec_lambda[j], rec_w_out[j])
        else:
            h = swa_sink_alibi(x, att_w_qkv[j], att_sinks[j], att_w_o[j])
        x = layer_norm(ALPHA * x + h, ln_g[layer, 0], ln_b[layer, 0])
        f = hier_moe(x, moe_w_group[layer], moe_b_group[layer], moe_w_expert[layer], moe_b_expert[layer],
                     moe_w1[layer], moe_w3[layer], moe_w2[layer])
        x = layer_norm(ALPHA * x + f, ln_g[layer, 1], ln_b[layer, 1])
    return x
```

```cpp
#include <hip/hip_runtime.h>
#include <stdint.h>
#include <cstdio>
#include <hip/hip_cooperative_groups.h>
namespace cg = cooperative_groups;

typedef unsigned short bf16_t;
constexpr int D = 1024, BATCH = 16, SEQ = 2048, T = BATCH * SEQ;
constexpr int DR = 1280, BW = 80;
constexpr int NH = 16, HD = 64, WIN = 128;
constexpr int QKVD = 1536;
constexpr int NE = 32, DE = 512;
constexpr int MB = 256;
constexpr int TK = T * 2;
constexpr int NROWS_MAX = TK + NE * MB;
constexpr float ALPHA = 1.41421356237309515f;
constexpr float LN_EPS = 1e-5f;
constexpr float QSCALE = 0.125f * 1.4426950408889634f;

constexpr size_t MiB = 1u << 20;
constexpr size_t WS_CTL = 0;
constexpr size_t WS_READY = 256 * 1024, READY_BANK = 128 * 1024;
constexpr size_t WS_BAR = 512 * 1024;
constexpr size_t WS_WIN = 1 * MiB, WS_WOUT = 6 * MiB, WS_WQKV = 8 * MiB + 512 * 1024, WS_WO = 11 * MiB + 512 * 1024, WS_GF = 13 * MiB + 512 * 1024;
constexpr size_t WS_ROUTE = 14 * MiB;
constexpr size_t WS_W13 = 16 * MiB, WS_W2 = 144 * MiB, WS_XB = 208 * MiB, WS_M = 272 * MiB, WS_END = 488 * MiB;
constexpr size_t M_G = 0, M_XR = 80 * MiB, M_TMP = 160 * MiB;
constexpr size_t M_QKV = 0, M_O = 96 * MiB;
constexpr size_t M_HDN = 0, M_YS = 72 * MiB;

__device__ __forceinline__ float bf2f(bf16_t v) { return __uint_as_float((unsigned)v << 16); }
__device__ __forceinline__ bf16_t f2bf(float f) { unsigned u = __float_as_uint(f); return (bf16_t)((u + 0x7fffu + ((u >> 16) & 1u)) >> 16); }


#ifndef WT_STORES
#define WT_STORES 0
#endif
typedef unsigned wt_v4u __attribute__((ext_vector_type(4)));
typedef unsigned wt_v2u __attribute__((ext_vector_type(2)));
__device__ __forceinline__ void st16_wt(void* p, wt_v4u v) {
#if WT_STORES
    asm volatile("global_store_dwordx4 %0, %1, off sc1\n\ts_nop 1" :: "v"(p), "v"(v) : "memory");
#else
    *(wt_v4u*)p = v;
#endif
}
__device__ __forceinline__ void st8_wt(void* p, wt_v2u v) {
#if WT_STORES
    asm volatile("global_store_dwordx2 %0, %1, off sc1\n\ts_nop 0" :: "v"(p), "v"(v) : "memory");
#else
    *(wt_v2u*)p = v;
#endif
}

#ifndef WT_GEMM
#define WT_GEMM 0
#endif
__device__ __forceinline__ void st16_gemm(void* p, wt_v4u v) {
#if WT_GEMM == 1
    asm volatile("global_store_dwordx4 %0, %1, off sc1\n\ts_nop 1" :: "v"(p), "v"(v) : "memory");
#elif WT_GEMM == 2
    asm volatile("global_store_dwordx4 %0, %1, off nt\n\ts_nop 1" :: "v"(p), "v"(v) : "memory");
#elif WT_GEMM == 3
    asm volatile("global_store_dwordx4 %0, %1, off sc0 sc1\n\ts_nop 1" :: "v"(p), "v"(v) : "memory");
#else
    *(wt_v4u*)p = v;
#endif
}
#ifndef PG8_ROWMAJOR
#define PG8_ROWMAJOR 0
#endif
#ifndef PG8_XCDREMAP
#define PG8_XCDREMAP 1
#endif
#ifndef PG8_WGM
#define PG8_WGM 2
#endif
namespace pg8 {
#define PG8_LAS __attribute__((address_space(3)))
typedef short bf16x8 __attribute__((ext_vector_type(8)));
typedef float f32x4 __attribute__((ext_vector_type(4)));
typedef unsigned u32x4 __attribute__((ext_vector_type(4)));
typedef unsigned u32x2 __attribute__((ext_vector_type(2)));
constexpr int BM = 256, BK = 64, HALF = 128, HTB = HALF * BK * 2  , STAGE_BYTES = 8 * HTB, NXCD = 8, WGM = PG8_WGM;

__host__ __device__ __forceinline__ int lds_byte(int r, int c) { const int st = (r >> 4) * 2 + (c >> 5), rr = r & 15, cc = c & 31, ob = rr * 64 + cc * 2; return st * 1024 + (ob ^ (((ob >> 9) & 1) << 5)); }
__host__ __device__ __forceinline__ void stage_rc(int b, int& R, int& C) { const int st = b / 1024, sb = b % 1024, swz = sb ^ (((sb >> 9) & 1) << 5); R = (st >> 1) * 16 + swz / 64; C = (st & 1) * 32 + (swz % 64) / 2; }
__host__ __device__ __forceinline__ int perm32(int rho) { const int n = rho >> 4, i = rho & 15; return 8 * (i >> 2) + 4 * n + (i & 3); }

struct Unit { int pm, pn, li; };

template <int WGM_> __device__ __forceinline__ bool order_at(long L, int nM, int nN, Unit& u) {
    constexpr int WGM = WGM_;
    const int nwg = nM * nN; if (L >= nwg) return false;
    int wgid = (int)L; if (PG8_XCDREMAP) { const int q = nwg / NXCD, r = nwg % NXCD, xcd = wgid % NXCD, off = wgid / NXCD; wgid = (xcd < r ? xcd * (q + 1) : r * (q + 1) + (xcd - r) * q) + off; }
    const int nig = WGM * nN, gid = wgid / nig, fm = gid * WGM, gsz = (nM - fm) < WGM ? (nM - fm) : WGM;
    if (PG8_ROWMAJOR) { u.pm = fm + ((wgid % nig) / nN); u.pn = (wgid % nig) % nN; if (u.pm >= fm + gsz) { const int idx = wgid % nig; u.pm = fm + idx % gsz; u.pn = idx / gsz; } }
    else { u.pm = fm + ((wgid % nig) % gsz); u.pn = (wgid % nig) / gsz; }
    return true;
}
template <int WGM_> __device__ __forceinline__ bool order_next(int i, int G, int c, int nM, int nN, Unit& u) { return order_at<WGM_>((long)i * G + c, nM, nN, u); }
template <int K_, int NN_, bool GATHER, bool EXPERT, int DEP = 0, int WGM_ = PG8_WGM>
struct Order {
    static constexpr int K = K_, nN = NN_, AUX_A = (DEP == 2) ? 16 : 0;
    int nM, G, c; const char* A; const char* Bt; const int* block_e; const int* rowtok; unsigned* ready; unsigned need; const PG8_LAS int* tokl;
    __device__ __forceinline__ bool next(int i, Unit& u) const {
        if (DEP == 2) {
            const int nU = nM * nN, m = nU / G, rem = nU % G;
            if (m >= 1 && 3 * rem <= G) {
                long L;
                if (i < m - 1) L = (long)i * G + c;
                else if (i == m - 1) { if (c < rem) return false; L = (long)(m - 1) * G + (c - rem); }
                else if (i == m) { if (c < rem || c >= 3 * rem) return false; L = (long)(m - 1) * G + (G - rem) + (c - rem); }
                else return false;
                return order_at<WGM_>(L, nM, nN, u);
            }
            return order_next<WGM_>(i, G, G - 1 - c, nM, nN, u);
        }
        return order_next<WGM_>(i, G, c, nM, nN, u);
    }
    __device__ __forceinline__ const char* a_base(const Unit& u) const { return GATHER ? A : A + (size_t)u.pm * BM * K * 2; }
    __device__ __forceinline__ const char* b_base(const Unit& u) const { return Bt + (EXPERT ? (size_t)block_e[u.pm] * (size_t)(nN * BM) * K * 2 : (size_t)0) + (size_t)u.pn * BM * K * 2; }
    __device__ __forceinline__ unsigned a_rowoff(const Unit& u, int r) const {
        if (GATHER) return (unsigned)tokl[u.li * BM + r] * (unsigned)(K * 2);
        return (unsigned)(r * K * 2);
    }
    __device__ __forceinline__ void fill_tokl(PG8_LAS int* dst, int tid) const {
        Unit u;
        for (int i = 0; next(i, u); ++i) if (tid < BM) { const int s = rowtok[u.pm * BM + tid]; dst[i * BM + tid] = s >= 0 ? (s >> 1) : 0; }
    }
    __device__ __forceinline__ void a_ready(const Unit& u, int tid) const {
        if (DEP == 2) {
            if (tid < 64) { unsigned spins = 0;
                while ((unsigned)__builtin_amdgcn_readfirstlane(__hip_atomic_load(ready + 64 * u.pm, __ATOMIC_RELAXED, __HIP_MEMORY_SCOPE_AGENT)) < need) { __builtin_amdgcn_s_sleep(2); if (++spins > (1u << 22)) break; } }
            asm volatile("" ::: "memory"); __builtin_amdgcn_s_barrier(); asm volatile("" ::: "memory");
        }
    }
    __device__ __forceinline__ void done(const Unit& u, int lane) const {
        if (DEP == 1) { asm volatile("s_waitcnt vmcnt(0)" ::: "memory"); if (lane == 0) __hip_atomic_fetch_add(ready + 64 * u.pm, 1u, __ATOMIC_RELAXED, __HIP_MEMORY_SCOPE_AGENT); }
    }
};

__device__ __forceinline__ unsigned cvt_pk_bf16(float lo, float hi) { unsigned r; asm volatile("v_cvt_pk_bf16_f32 %0, %1, %2" : "=v"(r) : "v"(lo), "v"(hi)); return r; }

__device__ __forceinline__ void store_full_lines(bf16_t* grp  , int ldc, int fr, int fq, const u32x4 (&w)[2]) {
    const bool lo = fr < 8;
    u32x4 snd, rcv;
#pragma unroll
    for (int k = 0; k < 4; ++k) { snd[k] = lo ? w[1][k] : w[0][k]; rcv[k] = (unsigned)__builtin_amdgcn_update_dpp(0, (int)snd[k], 0x128  , 0xF, 0xF, false); }
    u32x4 da, db;
#pragma unroll
    for (int k = 0; k < 4; ++k) { da[k] = lo ? w[0][k] : rcv[k]; db[k] = lo ? rcv[k] : w[1][k]; }
    bf16_t* p = grp + (size_t)(fr & 7) * ldc + (lo ? 0 : 32) + 8 * fq;
    *(u32x4*)p = da; *(u32x4*)(p + (size_t)8 * ldc) = db;
}
struct EpiBf16 {
    static constexpr bool PERM = true, FULL = true;
    bf16_t* O; int ldc; int split_cols; size_t split_stride; float scale0;
    __device__ __forceinline__ void operator()(const f32x4 (&acc)[2][2][4][2], const Unit& u, int wr, int wc, int fr, int fq) const {
        int colt = u.pn * BM; bf16_t* base = O;
        float sc = 1.f; if (split_cols) { const int t = colt / split_cols; base += (size_t)t * split_stride; colt -= t * split_cols; if (t == 0) sc = scale0; }
#pragma unroll
        for (int ai = 0; ai < 2; ++ai)
#pragma unroll
            for (int m = 0; m < 4; ++m) { u32x4 w[2];
#pragma unroll
                for (int bj = 0; bj < 2; ++bj) { const f32x4 v0 = acc[ai][bj][m][0] * sc, v1 = acc[ai][bj][m][1] * sc;
                    w[bj].x = cvt_pk_bf16(v0[0], v0[1]); w[bj].y = cvt_pk_bf16(v0[2], v0[3]); w[bj].z = cvt_pk_bf16(v1[0], v1[1]); w[bj].w = cvt_pk_bf16(v1[2], v1[3]); }
                store_full_lines(base + (size_t)(u.pm * BM + wr * 64 + ai * HALF + m * 16) * ldc + colt + wc * 64, ldc, fr, fq, w); }
    }
};
struct EpiNull {
    static constexpr bool PERM = true, FULL = true;
    __device__ __forceinline__ void operator()(const f32x4 (&acc)[2][2][4][2], const Unit&, int, int, int, int) const {
#pragma unroll
        for (int ai = 0; ai < 2; ++ai)
#pragma unroll
            for (int bj = 0; bj < 2; ++bj)
#pragma unroll
                for (int m = 0; m < 4; ++m)
#pragma unroll
                    for (int n = 0; n < 2; ++n) asm volatile("" :: "v"(acc[ai][bj][m][n]));
    }
};
template <bool RES_BF16>
struct EpiResidZ {
    static constexpr bool PERM = true, FULL = true;
    const void* res; bf16_t* Z; float alpha;
    __device__ __forceinline__ void operator()(const f32x4 (&acc)[2][2][4][2], const Unit& u, int wr, int wc, int fr, int fq) const {
        const int row0 = u.pm * BM + wr * 64 + fr, col0 = u.pn * BM + wc * 64 + 8 * fq;
#pragma unroll
        for (int ai = 0; ai < 2; ++ai)
#pragma unroll
            for (int m = 0; m < 4; ++m) { const size_t off = (size_t)(row0 + ai * HALF + m * 16) * 1024 + col0; u32x4 w[2];
#pragma unroll
                for (int bj = 0; bj < 2; ++bj) { f32x4 r0, r1;
                    if (RES_BF16) { const u32x4 rb = *(const u32x4*)((const bf16_t*)res + off + bj * 32);
                        r0 = (f32x4){__uint_as_float(rb.x << 16), __uint_as_float(rb.x & 0xffff0000u), __uint_as_float(rb.y << 16), __uint_as_float(rb.y & 0xffff0000u)};
                        r1 = (f32x4){__uint_as_float(rb.z << 16), __uint_as_float(rb.z & 0xffff0000u), __uint_as_float(rb.w << 16), __uint_as_float(rb.w & 0xffff0000u)}; }
                    else { r0 = *(const f32x4*)((const float*)res + off + bj * 32); r1 = *(const f32x4*)((const float*)res + off + bj * 32 + 4); }
                    const f32x4 v0 = r0 * alpha + acc[ai][bj][m][0], v1 = r1 * alpha + acc[ai][bj][m][1];
                    w[bj].x = cvt_pk_bf16(v0[0], v0[1]); w[bj].y = cvt_pk_bf16(v0[2], v0[3]); w[bj].z = cvt_pk_bf16(v1[0], v1[1]); w[bj].w = cvt_pk_bf16(v1[2], v1[3]); }
                store_full_lines(Z + (size_t)(u.pm * BM + wr * 64 + ai * HALF + m * 16) * 1024 + u.pn * BM + wc * 64, 1024, fr, fq, w); }
    }
};
struct EpiSwiglu {
    static constexpr bool PERM = true, FULL = false;
    bf16_t* H;
    __device__ __forceinline__ void operator()(const f32x4 (&acc)[2][2][4][2], const Unit& u, int wr, int wc, int fr, int fq) const {
        const int row0 = u.pm * BM + wr * 64 + fr, col0 = u.pn * HALF + wc * 32 + 8 * fq;
#pragma unroll
        for (int ai = 0; ai < 2; ++ai)
#pragma unroll
            for (int m = 0; m < 4; ++m) { float h[8];
#pragma unroll
                for (int n = 0; n < 2; ++n)
#pragma unroll
                    for (int j = 0; j < 4; ++j) { const float a = acc[ai][0][m][n][j], b = acc[ai][1][m][n][j];
                        h[n * 4 + j] = a * __builtin_amdgcn_rcpf(1.f + __builtin_amdgcn_exp2f(-1.4426950408889634f * a)) * b; }
                u32x4 w; w.x = cvt_pk_bf16(h[0], h[1]); w.y = cvt_pk_bf16(h[2], h[3]); w.z = cvt_pk_bf16(h[4], h[5]); w.w = cvt_pk_bf16(h[6], h[7]);
                asm volatile("global_store_dwordx4 %0, %1, off sc1\n\ts_nop 1" :: "v"(H + (size_t)(row0 + ai * HALF + m * 16) * 512 + col0), "v"(w) : "memory"); }
    }
};

template <class Epi, class Sched, bool ALIGN_EPI>
__device__ __forceinline__ void gemm_phase(PG8_LAS unsigned char* lds, const int tid_in, const Sched& S, const Epi& E) {
    constexpr int K = Sched::K;
    int tid = tid_in; asm volatile("" : "+v"(tid));
    const int wid = __builtin_amdgcn_readfirstlane(tid >> 6), lane = tid & 63, wr = wid >> 2, wc = wid & 3, fr = lane & 15, fq = lane >> 4;
    const int nt = K / BK;
    int Rr[2], Cc[2]; unsigned voffB[2][2];
#pragma unroll
    for (int i = 0; i < 2; ++i) { int R, C; stage_rc(tid * 16 + i * 8192, R, C); Rr[i] = R; Cc[i] = C;
#pragma unroll
        for (int h = 0; h < 2; ++h) {
            const int col = Epi::FULL ? (64 * (R >> 5) + 32 * h + perm32(R & 31)) : (HALF * h + (Epi::PERM ? ((R & ~31) + perm32(R & 31)) : R));
            voffB[h][i] = (unsigned)(col * K + C) * 2u; } }
    const size_t kstep = (size_t)(BK * 2);
    const unsigned ldsw = (unsigned)wid * 1024u;
    const int aoff = lds_byte(wr * 64 + fr, fq * 8), boff = lds_byte(wc * 32 + fr, fq * 8);
#define PG8_SA(b, h) (((b) * 2 + (h)) * HTB)
#define PG8_SB(b, h) ((4 + (b) * 2 + (h)) * HTB)
#define PG8_STAGE(bufoff, gbase, voff) do { _Pragma("unroll") for (int _i = 0; _i < 2; ++_i) \
        __builtin_amdgcn_global_load_lds((const unsigned*)((const char*)(gbase) + (voff)[_i]), (PG8_LAS unsigned*)(lds + (bufoff) + ldsw + _i * 8192), 16, 0, 0); } while (0)
#define PG8_STAGEA(bufoff, gbase, voff) do { _Pragma("unroll") for (int _i = 0; _i < 2; ++_i) \
        __builtin_amdgcn_global_load_lds((const unsigned*)((const char*)(gbase) + (voff)[_i]), (PG8_LAS unsigned*)(lds + (bufoff) + ldsw + _i * 8192), 16, 0, Sched::AUX_A); } while (0)
#define PG8_LDA(dst, b, h) do { _Pragma("unroll") for (int m = 0; m < 4; ++m) _Pragma("unroll") for (int k = 0; k < 2; ++k) dst[m][k] = *(const PG8_LAS bf16x8*)(lds + PG8_SA(b, h) + aoff + m * 2048 + k * 1024); } while (0)
#define PG8_LDB(dst, b, h) do { _Pragma("unroll") for (int n = 0; n < 2; ++n) _Pragma("unroll") for (int k = 0; k < 2; ++k) dst[n][k] = *(const PG8_LAS bf16x8*)(lds + PG8_SB(b, h) + boff + n * 2048 + k * 1024); } while (0)
#define PG8_MMA(ai, bj, At, Bt) do { __builtin_amdgcn_s_setprio(1); _Pragma("unroll") for (int m = 0; m < 4; ++m) _Pragma("unroll") for (int n = 0; n < 2; ++n) _Pragma("unroll") for (int k = 0; k < 2; ++k) \
        acc[ai][bj][m][n] = __builtin_amdgcn_mfma_f32_16x16x32_bf16(Bt[n][k], At[m][k], acc[ai][bj][m][n], 0, 0, 0); __builtin_amdgcn_s_setprio(0); } while (0)
#define PG8_WAIT_V(n) asm volatile("s_waitcnt vmcnt(" #n ")" ::: "memory")
#define PG8_WAIT_L(n) asm volatile("s_waitcnt lgkmcnt(" #n ")" ::: "memory")
#define PG8_BAR __builtin_amdgcn_s_barrier()
#define PG8_SCHED __builtin_amdgcn_sched_barrier(0)
#define PG8_VOFF(dst, u) do { _Pragma("unroll") for (int _h = 0; _h < 2; ++_h) _Pragma("unroll") for (int _i = 0; _i < 2; ++_i) dst[_h][_i] = S.a_rowoff(u, _h * HALF + Rr[_i]) + (unsigned)(Cc[_i] * 2); } while (0)
    Unit cur, nxt; int ui = 0;
    if (!S.next(0, cur)) return;
    cur.li = 0;
    f32x4 acc[2][2][4][2];
#pragma unroll
    for (int a = 0; a < 2; ++a)
#pragma unroll
        for (int b = 0; b < 2; ++b)
#pragma unroll
            for (int m = 0; m < 4; ++m)
#pragma unroll
                for (int n = 0; n < 2; ++n) acc[a][b][m][n] = (f32x4){0.f, 0.f, 0.f, 0.f};
    bf16x8 At[4][2], B0[2][2], B1[2][2];
    unsigned vC[2][2], vN[2][2];
    PG8_VOFF(vC, cur);
    const char* cA = S.a_base(cur); const char* cB = S.b_base(cur);
    S.a_ready(cur, tid);
    PG8_STAGE(PG8_SB(0, 0), cB, voffB[0]); PG8_STAGE(PG8_SB(0, 1), cB, voffB[1]); PG8_STAGEA(PG8_SA(0, 0), cA, vC[0]); PG8_STAGEA(PG8_SA(0, 1), cA, vC[1]);
    if (wr == 1) PG8_BAR;
    PG8_WAIT_V(2); PG8_BAR;
    PG8_STAGE(PG8_SB(1, 0), cB + kstep, voffB[0]); PG8_STAGEA(PG8_SA(1, 0), cA + kstep, vC[0]); PG8_STAGE(PG8_SB(1, 1), cB + kstep, voffB[1]);
    PG8_WAIT_V(6); PG8_BAR;
    for (;;) {
        const bool has_next = S.next(ui + 1, nxt); nxt.li = ui + 1;
        const char* nA = cA; const char* nB = cB;
#pragma unroll
        for (int h = 0; h < 2; ++h)
#pragma unroll
            for (int i = 0; i < 2; ++i) vN[h][i] = vC[h][i];
        if (has_next) { nA = S.a_base(nxt); nB = S.b_base(nxt); PG8_VOFF(vN, nxt); }
        for (int t = 0; t < nt; t += 2) {
            const bool last = (t == nt - 2);
            if (last && has_next) S.a_ready(nxt, tid);
            const char* a1 = cA + (size_t)(t + 1) * kstep;
            const char* a2 = last ? nA : cA + (size_t)(t + 2) * kstep; const char* b2 = last ? nB : cB + (size_t)(t + 2) * kstep;
            const char* a3 = a2 + kstep; const char* b3 = b2 + kstep;
            unsigned v2[2][2];
#pragma unroll
            for (int h = 0; h < 2; ++h)
#pragma unroll
                for (int i = 0; i < 2; ++i) v2[h][i] = last ? vN[h][i] : vC[h][i];
            PG8_LDB(B0, 0, 0); PG8_LDB(B1, 0, 1); PG8_SCHED; PG8_LDA(At, 0, 0); PG8_STAGEA(PG8_SA(1, 1), a1, vC[1]);
            PG8_WAIT_V(8); PG8_WAIT_L(0); PG8_BAR; PG8_MMA(0, 0, At, B0); PG8_MMA(0, 1, At, B1); PG8_BAR; PG8_SCHED;
            PG8_LDA(At, 0, 1); PG8_STAGE(PG8_SB(0, 0), b2, voffB[0]); PG8_STAGE(PG8_SB(0, 1), b2, voffB[1]); PG8_STAGEA(PG8_SA(0, 0), a2, v2[0]);
            PG8_WAIT_V(8); PG8_WAIT_L(0); PG8_BAR; PG8_MMA(1, 0, At, B0); PG8_MMA(1, 1, At, B1); PG8_BAR; PG8_SCHED;
            PG8_LDB(B0, 1, 0); PG8_LDB(B1, 1, 1); PG8_SCHED; PG8_LDA(At, 1, 0); PG8_STAGEA(PG8_SA(0, 1), a2, v2[1]);
            PG8_WAIT_V(8); PG8_WAIT_L(0); PG8_BAR; PG8_MMA(0, 0, At, B0); PG8_MMA(0, 1, At, B1); PG8_BAR; PG8_SCHED;
            PG8_LDA(At, 1, 1); PG8_STAGE(PG8_SB(1, 0), b3, voffB[0]); PG8_STAGE(PG8_SB(1, 1), b3, voffB[1]); PG8_STAGEA(PG8_SA(1, 0), a3, v2[0]);
            PG8_WAIT_V(8); PG8_WAIT_L(0); PG8_BAR; PG8_MMA(1, 0, At, B0); PG8_MMA(1, 1, At, B1); PG8_BAR; PG8_SCHED;
        }
        if constexpr (ALIGN_EPI) { if (wr == 0) PG8_BAR; }
        E(acc, cur, wr, wc, fr, fq); S.done(cur, lane);
        if (!has_next) break;
#pragma unroll
        for (int a = 0; a < 2; ++a)
#pragma unroll
            for (int b = 0; b < 2; ++b)
#pragma unroll
                for (int m = 0; m < 4; ++m)
#pragma unroll
                    for (int n = 0; n < 2; ++n) acc[a][b][m][n] = (f32x4){0.f, 0.f, 0.f, 0.f};
        cur = nxt; cA = nA; cB = nB; ++ui;
#pragma unroll
        for (int h = 0; h < 2; ++h)
#pragma unroll
            for (int i = 0; i < 2; ++i) vC[h][i] = vN[h][i];
        if constexpr (ALIGN_EPI) { if (wr == 1) PG8_BAR; }
    }
    PG8_WAIT_V(0);
    if constexpr (!ALIGN_EPI) { if (wr == 0) PG8_BAR; }
    PG8_BAR;
#undef PG8_SA
#undef PG8_SB
#undef PG8_STAGE
#undef PG8_STAGEA
#undef PG8_LDA
#undef PG8_LDB
#undef PG8_MMA
#undef PG8_WAIT_V
#undef PG8_WAIT_L
#undef PG8_BAR
#undef PG8_SCHED
#undef PG8_VOFF
}
}
#define GAS __attribute__((address_space(1)))
#define LAS __attribute__((address_space(3)))
typedef unsigned v4u __attribute__((ext_vector_type(4)));
typedef unsigned v2u __attribute__((ext_vector_type(2)));
typedef float f32x4 __attribute__((ext_vector_type(4)));
typedef short s16x4 __attribute__((ext_vector_type(4)));
typedef short bf16x8 __attribute__((ext_vector_type(8)));
constexpr int NWAVES = 8, NTHREADS = 512;
constexpr int LDS_BYTES = 163840;
#define LDS_WAIT() asm volatile("s_waitcnt lgkmcnt(0)" ::: "memory")

struct Params { const float* in[22]; float* out; unsigned char* ws; };

typedef const __attribute__((address_space(4))) Params* KParamsPtr;
__device__ __forceinline__ Params kparams() {
    KParamsPtr p = (KParamsPtr)__builtin_amdgcn_kernarg_segment_ptr();
    asm volatile("" : "+s"(p));
    Params P;
#pragma unroll
    for (int i = 0; i < 22; ++i) P.in[i] = p->in[i];
    P.out = p->out; P.ws = p->ws;
    return P;
}
__device__ __forceinline__ unsigned pk2(float lo, float hi) { return (unsigned)f2bf(lo) | ((unsigned)f2bf(hi) << 16); }

__device__ __forceinline__ void transpose_item(const float* W, int ldw, bf16_t* WT, int ldt, int k0, int n0, int orow0, LAS float* scr, int lane) {
#pragma unroll 8
    for (int i = 0; i < 32; ++i) { const int kk = 2 * i + (lane >> 5); scr[kk * 33 + (lane & 31)] = W[(size_t)(k0 + kk) * ldw + n0 + (lane & 31)]; }
    LDS_WAIT(); asm volatile("" ::: "memory");
    const int c = lane & 7;
#pragma unroll
    for (int j = 0; j < 4; ++j) { const int n = (lane >> 3) + 8 * j; const LAS float* s = scr + (8 * c) * 33 + n;
        v4u o; o.x = pk2(s[0 * 33], s[1 * 33]); o.y = pk2(s[2 * 33], s[3 * 33]); o.z = pk2(s[4 * 33], s[5 * 33]); o.w = pk2(s[6 * 33], s[7 * 33]);
        st16_wt(WT + (size_t)(orow0 + n) * ldt + k0 + 8 * c, o); }
    LDS_WAIT(); asm volatile("" ::: "memory");
}

constexpr int IT_WIN = (D / 64) * (2 * DR / 32);
constexpr int IT_WOUT = (DR / 64) * (D / 32);
constexpr int IT_WQKV = (D / 64) * (QKVD / 32);
constexpr int IT_WO = (D / 64) * (D / 32);
constexpr int IT_W1 = (D / 64) * (DE / 32);
constexpr int IT_W2 = (DE / 64) * (D / 32);
constexpr int IT_MOE_LAYER = NE * (2 * IT_W1 + IT_W2);
constexpr int IT_DENSE = IT_WIN + IT_WOUT + IT_WQKV + IT_WO;

__device__ __forceinline__ void cvt_dense_item(const Params& P, int r, LAS float* scr, int lane) {
    unsigned char* ws = P.ws;
    if (r < IT_WIN) { const int nb = 2 * DR / 32, kb = r / nb, n0 = (r % nb) * 32; transpose_item(P.in[1], 2 * DR, (bf16_t*)(ws + WS_WIN), D, kb * 64, n0, n0, scr, lane); return; } r -= IT_WIN;
    if (r < IT_WOUT) { const int nb = D / 32, kb = r / nb, n0 = (r % nb) * 32; transpose_item(P.in[9], D, (bf16_t*)(ws + WS_WOUT), DR, kb * 64, n0, n0, scr, lane); return; } r -= IT_WOUT;
    if (r < IT_WQKV) { const int nb = QKVD / 32, kb = r / nb, n0 = (r % nb) * 32; transpose_item(P.in[10], QKVD, (bf16_t*)(ws + WS_WQKV), D, kb * 64, n0, n0, scr, lane); return; } r -= IT_WQKV;
    { const int nb = D / 32, kb = r / nb, n0 = (r % nb) * 32; transpose_item(P.in[12], D, (bf16_t*)(ws + WS_WO), D, kb * 64, n0, n0, scr, lane); }
}
__device__ __forceinline__ void cvt_moe_item(const Params& P, int layer, int r, LAS float* scr, int lane) {
    unsigned char* ws = P.ws;
    const int per_e = 2 * IT_W1 + IT_W2, e = r / per_e; int q = r % per_e;
    bf16_t* W13t = (bf16_t*)(ws + WS_W13) + ((size_t)layer * NE + e) * (size_t)(D * D);
    bf16_t* W2t = (bf16_t*)(ws + WS_W2) + ((size_t)layer * NE + e) * (size_t)(D * DE);
    const size_t eoff13 = ((size_t)layer * NE + e) * (size_t)(D * DE);
    if (q < 2 * IT_W1) { const int which = q / IT_W1; q %= IT_W1; const int nb = DE / 32, kb = q / nb, n0 = (q % nb) * 32;
        const int orow0 = (n0 / 128) * 256 + which * 128 + (n0 % 128);
        transpose_item((which ? P.in[18] : P.in[17]) + eoff13, DE, W13t, D, kb * 64, n0, orow0, scr, lane); return; }
    q -= 2 * IT_W1;
    { const int nb = D / 32, kb = q / nb, n0 = (q % nb) * 32; transpose_item(P.in[19] + eoff13, D, W2t, DE, kb * 64, n0, n0, scr, lane); }
}

__device__ __forceinline__ void cvt_gate_frags(const Params& P, int gtid, int gthreads) {
    v2u* GF = (v2u*)(P.ws + WS_GF);
    for (int i = gtid; i < 2 * 16 * 25 * 64; i += gthreads) {
        const int l = i & 63, ks = (i >> 6) % 5, jt = (i / 320) % 5, n = (i / 1600) % 16, mat = i / 25600;
        const float* w = (mat ? P.in[6] : P.in[4]) + (size_t)n * BW * BW;
        const int j = 16 * jt + (l & 15), k = 16 * ks + 4 * (l >> 4);
        v2u o; o.x = pk2(w[(k + 0) * BW + j], w[(k + 1) * BW + j]); o.y = pk2(w[(k + 2) * BW + j], w[(k + 3) * BW + j]);
        GF[i] = o;
    }
}
__device__ __forceinline__ void cvt_x(const Params& P, int gtid, int gthreads) {
    const f32x4* x = (const f32x4*)P.in[0]; v4u* xb = (v4u*)(P.ws + WS_XB);
    for (size_t i = gtid; i < (size_t)T * D / 8; i += gthreads) { const f32x4 a = x[2 * i], b = x[2 * i + 1];
        v4u o; o.x = pk2(a[0], a[1]); o.y = pk2(a[2], a[3]); o.z = pk2(b[0], b[1]); o.w = pk2(b[2], b[3]); st16_wt(xb + i, o); }
}
__device__ __forceinline__ void phase_prologue(LAS unsigned char* lds, const int tid_in, int vcu, int G) {
    const Params P = kparams();
    int tid = tid_in; asm volatile("" : "+v"(tid));
    const int lane = tid & 63, wave = __builtin_amdgcn_readfirstlane(tid >> 6);
    LAS float* scr = (LAS float*)(lds + wave * 16384);
    const int gw = vcu * NWAVES + wave, NGW = G * NWAVES;
    for (int it = gw; it < IT_DENSE; it += NGW) cvt_dense_item(P, it, scr, lane);
    for (int it = gw; it < 2 * IT_MOE_LAYER; it += NGW) cvt_moe_item(P, it / IT_MOE_LAYER, it % IT_MOE_LAYER, scr, lane);
    cvt_gate_frags(P, vcu * NTHREADS + tid, G * NTHREADS);
    cvt_x(P, vcu * NTHREADS + tid, G * NTHREADS);
}

__device__ __forceinline__ void phase_cvt_moe(int layer, LAS unsigned char* lds, const int tid_in, int vcu, int G) {
    const Params P = kparams();
    int tid = tid_in; asm volatile("" : "+v"(tid));
    const int lane = tid & 63, wave = __builtin_amdgcn_readfirstlane(tid >> 6);
    LAS float* scr = (LAS float*)(lds + wave * 16384);
    const int gw = vcu * NWAVES + wave, NGW = G * NWAVES;
    for (int it = gw; it < IT_MOE_LAYER; it += NGW) cvt_moe_item(P, layer, it, scr, lane);
}
#define XB_TMO      128
#define XB_XCNT(j)  (256  + 64 * (j))
#define XB_XSUB(j)  (1280 + 64 * (j))
#define XB_XGEN(j)  (2304 + 64 * (j))
#define XB_TOP      3328
#define XB_TOPGEN   3392
#define XCD_BAR_WORDS 3456
#define XB_SPIN_CAP (1u << 18)

__device__ __forceinline__ unsigned xb_ld(unsigned* p)              { return __hip_atomic_load(p, __ATOMIC_RELAXED, __HIP_MEMORY_SCOPE_AGENT); }
__device__ __forceinline__ unsigned xb_add(unsigned* p, unsigned v) { return __hip_atomic_fetch_add(p, v, __ATOMIC_RELAXED, __HIP_MEMORY_SCOPE_AGENT); }
__device__ __forceinline__ unsigned xb_xcc_id() { return (unsigned)__builtin_amdgcn_s_getreg((3 << 11) | 20) & 0xFu; }
#define XB_SPIN(cond, bar) do { unsigned _sp = 0; while (cond) { __builtin_amdgcn_s_sleep(1); \
    if ((++_sp & 255u) == 0u) { if (xb_ld(&(bar)[XB_TMO])) break; if (_sp > XB_SPIN_CAP) { atomicAdd(&(bar)[XB_TMO], 1u); break; } } } } while (0)

struct XcdBarrier {
    unsigned* bar; unsigned x;
    volatile LAS unsigned* st;
};

__device__ __forceinline__ XcdBarrier xcd_barrier_post(unsigned* bar, volatile LAS unsigned* st, const int xb_tid) {
    XcdBarrier b; b.bar = bar; b.x = xb_xcc_id(); b.st = st;
    if (xb_tid == 0) (void)xb_add(&bar[XB_XCNT(b.x)], 1u);
    return b;
}
__device__ __forceinline__ void xcd_barrier_complete(unsigned* bar, unsigned x, unsigned& nloc, unsigned& nx) {
    const unsigned G = gridDim.x * gridDim.y * gridDim.z;
    unsigned sum, cnt, mine, sp = 0u;
    for (;;) {
        sum = 0u; cnt = 0u; mine = 0u;
#pragma unroll
        for (unsigned j = 0; j < 16; ++j) { const unsigned c = xb_ld(&bar[XB_XCNT(j)]); sum += c; cnt += (c > 0u) ? 1u : 0u; mine = (j == x) ? c : mine; }
        if (sum == G) break;
        __builtin_amdgcn_s_sleep(1);
        if ((++sp & 255u) == 0u) { if (xb_ld(&bar[XB_TMO])) break; if (sp > XB_SPIN_CAP) { atomicAdd(&bar[XB_TMO], 1u); break; } }
    }
    nloc = mine > 0u ? mine : 1u; nx = cnt > 0u ? cnt : 1u;
}

__device__ __forceinline__ void xcd_barrier(const XcdBarrier& b, const int xb_tid) {
    asm volatile("s_waitcnt vmcnt(0)" ::: "memory");
    __syncthreads();
    if (xb_tid == 0) {
        unsigned* bar = b.bar;
        __builtin_amdgcn_s_waitcnt(0);
        unsigned nloc = b.st[0], nx = b.st[1];
        if (nloc == 0u) { xcd_barrier_complete(bar, b.x, nloc, nx); b.st[0] = nloc; b.st[1] = nx; }
        const unsigned old = xb_add(&bar[XB_XSUB(b.x)], 1u);
        const unsigned gen = old / nloc;
        if (old + 1u == (gen + 1u) * nloc) {
            __builtin_amdgcn_fence(__ATOMIC_RELEASE, "agent");
            asm volatile("s_waitcnt vmcnt(0)" ::: "memory");
            const unsigned og = xb_add(&bar[XB_TOP], 1u);
            const unsigned tg = og / nx;
            if (og + 1u == (tg + 1u) * nx) xb_add(&bar[XB_TOPGEN], 1u);
            else XB_SPIN(xb_ld(&bar[XB_TOPGEN]) == tg, bar);
            __builtin_amdgcn_fence(__ATOMIC_ACQUIRE, "agent");
            xb_add(&bar[XB_XGEN(b.x)], 1u);
            asm volatile("s_waitcnt vmcnt(0)" ::: "memory");
        } else {
            XB_SPIN(xb_ld(&bar[XB_XGEN(b.x)]) == gen, bar);
            __builtin_amdgcn_fence(__ATOMIC_ACQUIRE, "agent");
            asm volatile("s_waitcnt vmcnt(0)" ::: "memory");
        }
    }
    __syncthreads();
}
#ifndef WGM_WIN
#define WGM_WIN PG8_WGM
#endif
#ifndef WGM_QKV
#define WGM_QKV PG8_WGM
#endif
#ifndef WGM_WOUT
#define WGM_WOUT PG8_WGM
#endif
#ifndef WGM_WO
#define WGM_WO PG8_WGM
#endif
#ifndef WGM_UP
#define WGM_UP PG8_WGM
#endif
#ifndef WGM_DOWN
#define WGM_DOWN PG8_WGM
#endif
#ifndef PG8_ALIGN
#define PG8_ALIGN true
#endif
enum Phase { PH_PROLOGUE = 0, PH_WIN, PH_RGLRU, PH_WOUT, PH_LN0, PH_ROUTE0, PH_UP0, PH_DOWN0, PH_COMB0, PH_QKV, PH_ATTN, PH_WO, PH_LN1, PH_ROUTE1, PH_UP1, PH_DOWN1, PH_COMB1, PH_COUNT };
__device__ __forceinline__ void phase_gemm_win(LAS unsigned char* lds, const int tid_in, int bid, int G) {
    const Params P = kparams(); unsigned char* ws = P.ws;
    typedef pg8::Order<D, 2 * DR / 256, false, false, 0, WGM_WIN> O;
    const O S{T / 256, G, bid, (const char*)(ws + WS_XB), (const char*)(ws + WS_WIN), nullptr, nullptr, nullptr, 0u, nullptr};
    const pg8::EpiBf16 E{(bf16_t*)(ws + WS_M + M_G), DR, DR, (size_t)(M_XR - M_G) / 2, 1.f};
    pg8::gemm_phase<pg8::EpiBf16, O, PG8_ALIGN>(lds, tid_in, S, E);
}
__device__ __forceinline__ void phase_gemm_qkv(LAS unsigned char* lds, const int tid_in, int bid, int G) {
    const Params P = kparams(); unsigned char* ws = P.ws;
    typedef pg8::Order<D, QKVD / 256, false, false, 0, WGM_QKV> O;
    const O S{T / 256, G, bid, (const char*)(ws + WS_XB), (const char*)(ws + WS_WQKV), nullptr, nullptr, nullptr, 0u, nullptr};
    const pg8::EpiBf16 E{(bf16_t*)(ws + WS_M + M_QKV), QKVD, 1024, 1024, QSCALE};
    pg8::gemm_phase<pg8::EpiBf16, O, PG8_ALIGN>(lds, tid_in, S, E);
}
__device__ __forceinline__ void phase_gemm_wout(LAS unsigned char* lds, const int tid_in, int bid, int G) {
    const Params P = kparams(); unsigned char* ws = P.ws;
    typedef pg8::Order<DR, D / 256, false, false, 0, WGM_WOUT> O;
    const O S{T / 256, G, bid, (const char*)(ws + WS_M + M_G), (const char*)(ws + WS_WOUT), nullptr, nullptr, nullptr, 0u, nullptr};
    const pg8::EpiResidZ<false> E{P.in[0], (bf16_t*)P.out, ALPHA};
    pg8::gemm_phase<pg8::EpiResidZ<false>, O, PG8_ALIGN>(lds, tid_in, S, E);
}
__device__ __forceinline__ void phase_gemm_wo(LAS unsigned char* lds, const int tid_in, int bid, int G) {
    const Params P = kparams(); unsigned char* ws = P.ws;
    typedef pg8::Order<D, D / 256, false, false, 0, WGM_WO> O;
    const O S{T / 256, G, bid, (const char*)(ws + WS_M + M_O), (const char*)(ws + WS_WO), nullptr, nullptr, nullptr, 0u, nullptr};
    const pg8::EpiResidZ<true> E{ws + WS_XB, (bf16_t*)P.out, ALPHA};
    pg8::gemm_phase<pg8::EpiResidZ<true>, O, PG8_ALIGN>(lds, tid_in, S, E);
}
__device__ __forceinline__ void phase_moe_up(int layer, LAS unsigned char* lds, const int tid_in, int bid, int G) {
    const Params P = kparams(); unsigned char* ws = P.ws; const int* ctl = (const int*)(ws + WS_CTL);
    typedef pg8::Order<D, 4, true, true, 1, WGM_UP> O;
    const O S{ctl[97], G, bid, (const char*)(ws + WS_XB), (const char*)(ws + WS_W13) + (size_t)layer * NE * (size_t)(D * D * 2), ctl + 128, (const int*)(ws + WS_ROUTE + 512 * 1024), (unsigned*)(ws + WS_READY + (size_t)layer * READY_BANK), 0u, (const LAS int*)(lds + 131072 + 4096)};
    { int t_ = tid_in; asm volatile("" : "+v"(t_)); S.fill_tokl((LAS int*)(lds + 131072 + 4096), t_); __syncthreads(); }
    const pg8::EpiSwiglu E{(bf16_t*)(ws + WS_M + M_HDN)};
    pg8::gemm_phase<pg8::EpiSwiglu, O, PG8_ALIGN>(lds, tid_in, S, E);
}
__device__ __forceinline__ void phase_moe_down(int layer, LAS unsigned char* lds, const int tid_in, int bid, int G) {
    const Params P = kparams(); unsigned char* ws = P.ws; const int* ctl = (const int*)(ws + WS_CTL);
    typedef pg8::Order<DE, 4, false, true, 2, WGM_DOWN> O;
    const O S{ctl[97], G, bid, (const char*)(ws + WS_M + M_HDN), (const char*)(ws + WS_W2) + (size_t)layer * NE * (size_t)(D * DE * 2), ctl + 128, nullptr, (unsigned*)(ws + WS_READY + (size_t)layer * READY_BANK), 32u, nullptr};
    const pg8::EpiBf16 E{(bf16_t*)(ws + WS_M + M_YS), D, 0, 0, 1.f};
    pg8::gemm_phase<pg8::EpiBf16, O, PG8_ALIGN>(lds, tid_in, S, E);
}

__device__ __forceinline__ void phase_gemm_win_null(LAS unsigned char* lds, const int tid_in, int bid, int G) {
    const Params P = kparams(); unsigned char* ws = P.ws;
    typedef pg8::Order<D, 2 * DR / 256, false, false> O;
    const O S{T / 256, G, bid, (const char*)(ws + WS_XB), (const char*)(ws + WS_WIN), nullptr, nullptr, nullptr, 0u, nullptr};
    const pg8::EpiNull E{};
    pg8::gemm_phase<pg8::EpiNull, O, PG8_ALIGN>(lds, tid_in, S, E);
}
constexpr size_t CTL_CNT = 16384;
constexpr int LN_ROWS = 32, LN_TILES = T / LN_ROWS;
typedef float f32x2v __attribute__((ext_vector_type(2)));

__device__ __forceinline__ float wave_sum(float v) {
#pragma unroll
    for (int o = 1; o < 64; o <<= 1) v += __shfl_xor(v, o);
    return v;
}
__device__ __forceinline__ void split_bf(float x, unsigned& hi, unsigned& lo) { hi = f2bf(x); lo = f2bf(x - __uint_as_float(hi << 16)); }

__device__ __forceinline__ void phase_ln(int layer, LAS unsigned char* lds, const int tid_in, int bid, int G, bool dry = false) {
    const Params P = kparams();
    unsigned char* ws = P.ws;
    const bf16_t* Z = (const bf16_t*)P.out; bf16_t* XB = (bf16_t*)(ws + (dry ? WS_M + 128 * MiB : WS_XB));
    const float* lg = P.in[20] + (size_t)(layer * 2) * D; const float* lb = P.in[21] + (size_t)(layer * 2) * D;
    const float* wg = P.in[13] + (size_t)layer * D * 4; const float* bg = P.in[14] + layer * 4;
    const float* we = P.in[15] + (size_t)layer * D * 32; const float* be = P.in[16] + layer * 32;
    unsigned char* rbase = ws + (dry ? WS_M + 192 * MiB : WS_ROUTE);
    int* EXP = (int*)(rbase); float* GATE = (float*)(rbase + 256 * 1024); int* rowtok = (int*)(rbase + 512 * 1024);
    int* CNT = dry ? (int*)(rbase + 2 * MiB) : (int*)(ws + WS_CTL) + CTL_CNT;
    int tid = tid_in; asm volatile("" : "+v"(tid));
    const int lane = tid & 63, w = __builtin_amdgcn_readfirstlane(tid >> 6), fr = lane & 15, fq = lane >> 4;
    for (int i = bid * NTHREADS + tid; i < NROWS_MAX; i += G * NTHREADS) rowtok[i] = -1;
    LAS float* stat = (LAS float*)lds;
    LAS float* part = (LAS float*)(lds + 2048);
    LAS float* logit = (LAS float*)(lds + 2048 + 49152);
    LAS int* hist = (LAS int*)(lds + 2048 + 49152 + 6144);
    v2u vp[2][4][2];
#define LN_LOAD(tl) do { _Pragma("unroll") for (int rt = 0; rt < 2; ++rt) _Pragma("unroll") for (int s = 0; s < 4; ++s) _Pragma("unroll") for (int hf = 0; hf < 2; ++hf) \
        vp[rt][s][hf] = *(const v2u*)(Z + (size_t)((tl) * LN_ROWS + 16 * rt + fr) * D + 128 * w + 32 * s + 16 * hf + 4 * fq); } while (0)
#define LN_UNPACK(p) ((f32x4){__uint_as_float((p).x << 16), __uint_as_float((p).x & 0xffff0000u), __uint_as_float((p).y << 16), __uint_as_float((p).y & 0xffff0000u)})
    if (bid < LN_TILES) LN_LOAD(bid);
    bf16x8 Bh[4][3];
    LAS bf16x8* Bl = (LAS bf16x8*)(lds + 58368) + (w * 12) * 64 + lane;
    { float wv[4][3][8];
#pragma unroll
      for (int s = 0; s < 4; ++s)
#pragma unroll
          for (int ct = 0; ct < 3; ++ct)
#pragma unroll
              for (int j = 0; j < 8; ++j) {
                  const int col = 128 * w + 32 * s + (j < 4 ? 4 * fq + j : 16 + 4 * fq + (j - 4));
                  wv[s][ct][j] = (ct < 2) ? we[(size_t)col * 32 + 16 * ct + fr] : wg[(size_t)col * 4 + (fr & 3)];
              }
#pragma unroll
      for (int s = 0; s < 4; ++s)
#pragma unroll
          for (int ct = 0; ct < 3; ++ct) {
              unsigned h[8], l[8];
#pragma unroll
              for (int j = 0; j < 8; ++j) split_bf((ct < 2 || fr < 4) ? wv[s][ct][j] : 0.f, h[j], l[j]);
              Bh[s][ct] = __builtin_bit_cast(bf16x8, (v4u){h[0] | (h[1] << 16), h[2] | (h[3] << 16), h[4] | (h[5] << 16), h[6] | (h[7] << 16)});
              Bl[(s * 3 + ct) * 64] = __builtin_bit_cast(bf16x8, (v4u){l[0] | (l[1] << 16), l[2] | (l[3] << 16), l[4] | (l[5] << 16), l[6] | (l[7] << 16)});
          } }
    for (int tile = bid; tile < LN_TILES; tile += G) {
        const int row0 = tile * LN_ROWS;
        if (tid < 32) hist[tid] = 0;
#pragma unroll
        for (int rt = 0; rt < 2; ++rt) {
            float sm = 0.f, sq = 0.f;
#pragma unroll
            for (int s = 0; s < 4; ++s)
#pragma unroll
                for (int hf = 0; hf < 2; ++hf) { const f32x4 x = LN_UNPACK(vp[rt][s][hf]); sm += (x[0] + x[1]) + (x[2] + x[3]); sq += (x[0] * x[0] + x[1] * x[1]) + (x[2] * x[2] + x[3] * x[3]); }
            sm += __shfl_xor(sm, 16); sm += __shfl_xor(sm, 32); sq += __shfl_xor(sq, 16); sq += __shfl_xor(sq, 32);
            if (fq == 0) *(LAS f32x2v*)(stat + ((w * 32) + 16 * rt + fr) * 2) = (f32x2v){sm, sq};
        }
#pragma unroll
        for (int rt = 0; rt < 2; ++rt)
#pragma unroll
            for (int s = 0; s < 4; ++s) asm volatile("" : "+v"(vp[rt][s][0]), "+v"(vp[rt][s][1]));
        __syncthreads();
        float mean[2], rstd[2];
#pragma unroll
        for (int rt = 0; rt < 2; ++rt) { float sm = 0.f, sq = 0.f;
#pragma unroll
            for (int ww = 0; ww < 8; ++ww) { const f32x2v a = *(LAS f32x2v*)(stat + ((ww * 32) + 16 * rt + fr) * 2); sm += a.x; sq += a.y; }
            mean[rt] = sm * (1.f / D); const float var = fmaxf(sq * (1.f / D) - mean[rt] * mean[rt], 0.f); rstd[rt] = 1.f / sqrtf(var + LN_EPS); }
        f32x4 acc[2][3];
#pragma unroll
        for (int rt = 0; rt < 2; ++rt)
#pragma unroll
            for (int ct = 0; ct < 3; ++ct) acc[rt][ct] = (f32x4){0.f, 0.f, 0.f, 0.f};
#pragma unroll
        for (int s = 0; s < 4; ++s) {
            asm volatile("" ::: "memory");
            f32x4 gg[2], bb[2];
#pragma unroll
            for (int hf = 0; hf < 2; ++hf) { gg[hf] = *(const f32x4*)(lg + 128 * w + 32 * s + 16 * hf + 4 * fq); bb[hf] = *(const f32x4*)(lb + 128 * w + 32 * s + 16 * hf + 4 * fq); }
#pragma unroll
            for (int rt = 0; rt < 2; ++rt) {
                unsigned h[8], l[8];
#pragma unroll
                for (int hf = 0; hf < 2; ++hf) {
                    f32x4 y = (LN_UNPACK(vp[rt][s][hf]) - mean[rt]) * rstd[rt] * gg[hf] + bb[hf];
                    const size_t off = (size_t)(row0 + 16 * rt + fr) * D + 128 * w + 32 * s + 16 * hf + 4 * fq;
#pragma unroll
                    for (int j = 0; j < 4; ++j) split_bf(y[j], h[4 * hf + j], l[4 * hf + j]);
                    st8_wt(XB + off, (v2u){h[4 * hf] | (h[4 * hf + 1] << 16), h[4 * hf + 2] | (h[4 * hf + 3] << 16)});
                }
                const bf16x8 Ah = __builtin_bit_cast(bf16x8, (v4u){h[0] | (h[1] << 16), h[2] | (h[3] << 16), h[4] | (h[5] << 16), h[6] | (h[7] << 16)});
                const bf16x8 Al = __builtin_bit_cast(bf16x8, (v4u){l[0] | (l[1] << 16), l[2] | (l[3] << 16), l[4] | (l[5] << 16), l[6] | (l[7] << 16)});
#pragma unroll
                for (int ct = 0; ct < 3; ++ct) {
                    acc[rt][ct] = __builtin_amdgcn_mfma_f32_16x16x32_bf16(Ah, Bh[s][ct], acc[rt][ct], 0, 0, 0);
                    acc[rt][ct] = __builtin_amdgcn_mfma_f32_16x16x32_bf16(Ah, Bl[(s * 3 + ct) * 64], acc[rt][ct], 0, 0, 0);
                    acc[rt][ct] = __builtin_amdgcn_mfma_f32_16x16x32_bf16(Al, Bh[s][ct], acc[rt][ct], 0, 0, 0);
                }
                __builtin_amdgcn_sched_barrier(0);
            }
        }
#pragma unroll
        for (int rt = 0; rt < 2; ++rt)
#pragma unroll
            for (int ct = 0; ct < 3; ++ct) *(LAS f32x4*)(part + (((w * 2 + rt) * 3 + ct) * 64 + lane) * 4) = acc[rt][ct];
        asm volatile("" ::: "memory");
        if (tile + G < LN_TILES) LN_LOAD(tile + G);
        __syncthreads();
#pragma unroll
        for (int k = 0; k < 3; ++k) {
            const int idx = tid + k * NTHREADS, r = idx & 3, ln = (idx >> 2) & 63, t6 = idx >> 8;
            float s = 0.f;
#pragma unroll
            for (int ww = 0; ww < 8; ++ww) s += part[((ww * 6 + t6) * 64 + ln) * 4 + r];
            const int rt = t6 / 3, ct = t6 % 3, row = 16 * rt + 4 * (ln >> 4) + r, col = 16 * ct + (ln & 15);
            logit[row * 48 + col] = s;
        }
        __syncthreads();
        if (tid < 32) {
            const LAS float* L = logit + tid * 48;
            int gi = 0; float gm = L[32] + bg[0];
            for (int o = 1; o < 4; ++o) { const float x = L[32 + o] + bg[o]; if (x > gm) { gm = x; gi = o; } }
            float gs = 0.f;
            for (int o = 0; o < 4; ++o) gs += __expf(L[32 + o] + bg[o] - gm);
            const float ggate = 1.f / gs;
            int i0 = 0; float v0 = L[gi * 8] + be[gi * 8];
            for (int i = 1; i < 8; ++i) { const float x = L[gi * 8 + i] + be[gi * 8 + i]; if (x > v0) { v0 = x; i0 = i; } }
            int i1 = -1; float v1 = -INFINITY;
            for (int i = 0; i < 8; ++i) { const float x = L[gi * 8 + i] + be[gi * 8 + i]; if (i != i0 && x > v1) { v1 = x; i1 = i; } }
            const float w0 = 1.f / (1.f + __expf(v1 - v0)), w1 = 1.f - w0;
            const int row = row0 + tid, e0 = gi * 8 + i0, e1 = gi * 8 + i1;
            EXP[row * 2] = e0; EXP[row * 2 + 1] = e1; GATE[row * 2] = w0 * ggate; GATE[row * 2 + 1] = w1 * ggate;
            __hip_atomic_fetch_add(&hist[e0], 1, __ATOMIC_RELAXED, __HIP_MEMORY_SCOPE_WORKGROUP); __hip_atomic_fetch_add(&hist[e1], 1, __ATOMIC_RELAXED, __HIP_MEMORY_SCOPE_WORKGROUP);
        }
        __syncthreads();
        if (tid < 32) CNT[tile * 32 + tid] = hist[tid];
    }
#undef LN_LOAD
#undef LN_UNPACK
}

__device__ __forceinline__ void phase_route(LAS unsigned char* lds, const int tid_in, int bid, int G) {
    const Params P = kparams();
    unsigned char* ws = P.ws;
    int* ctl = (int*)(ws + WS_CTL); const int* CNT = ctl + CTL_CNT;
    const int* EXP = (const int*)(ws + WS_ROUTE); int* rowtok = (int*)(ws + WS_ROUTE + 512 * 1024); int* slotrow = (int*)(ws + WS_ROUTE + 1024 * 1024);
    int tid = tid_in; asm volatile("" : "+v"(tid));
    const int lane = tid & 63, w = __builtin_amdgcn_readfirstlane(tid >> 6);
    LAS int* tab = (LAS int*)lds;
    LAS int* csum = (LAS int*)(lds + 131072);
    LAS int* cbase = (LAS int*)(lds + 131072 + 2048);
    typedef int i32x4 __attribute__((ext_vector_type(4)));
#pragma unroll 4
    for (int i = tid; i < LN_TILES * 32 / 4; i += NTHREADS) ((LAS i32x4*)tab)[i] = ((const i32x4*)CNT)[i];
    __syncthreads();
    const int e = tid & 31, ch = tid >> 5;
    { int run = 0;
#pragma unroll 8
      for (int t = 0; t < 64; ++t) { LAS int* p = tab + (ch * 64 + t) * 32 + e; const int v = *p; *p = run; run += v; }
      csum[ch * 32 + e] = run; }
    __syncthreads();
    if (tid < 32) { int run = 0; for (int c = 0; c < 16; ++c) { const int v = csum[c * 32 + tid]; cbase[c * 32 + tid] = run; run += v; } csum[tid] = run;   }
    __syncthreads();
    if (tid == 0) { int off = 0; for (int x = 0; x < NE; ++x) { const int p = (csum[x] + MB - 1) / MB * MB; csum[32 + x] = off;
            if (bid == 0) for (int r = off / MB; r < (off + p) / MB; ++r) ctl[128 + r] = x;
            off += p; }
        if (bid == 0) { ctl[96] = off; ctl[97] = off / MB; } }
    __syncthreads();
    for (int tile = bid * NWAVES + w; tile < LN_TILES; tile += G * NWAVES) {
        const int slot = tile * 64 + lane, ex = EXP[slot];
        int rank = 0;
        for (int x = 0; x < NE; ++x) { const unsigned long long m = __ballot(ex == x); if (ex == x) rank = __popcll(m & ((1ull << lane) - 1ull)); }
        const int row = csum[32 + ex] + cbase[(tile >> 6) * 32 + ex] + tab[tile * 32 + ex] + rank;
        rowtok[row] = slot; slotrow[slot] = row;
    }
}

__device__ __forceinline__ void phase_combine(int layer, const int tid_in, int bid, int G, bool dry = false) {
    const Params P = kparams();
    unsigned char* ws = P.ws;
    bf16_t* XB = (bf16_t*)(ws + WS_XB); float* Xo = P.out; const bf16_t* YS = (const bf16_t*)(ws + WS_M + M_YS);
    const float* GATE = (const float*)(ws + WS_ROUTE + 256 * 1024); const int* slotrow = (const int*)(ws + WS_ROUTE + 1024 * 1024);
    const float* g = P.in[20] + (size_t)(layer * 2 + 1) * D; const float* b = P.in[21] + (size_t)(layer * 2 + 1) * D;
    int tid = tid_in; asm volatile("" : "+v"(tid));
    const int lane = tid & 63, w = __builtin_amdgcn_readfirstlane(tid >> 6);
    const int NW = G * NWAVES;
    for (int rowa = bid * NWAVES + w; rowa < T; rowa += 2 * NW) {
        int rows[2]; rows[0] = rowa; rows[1] = rowa + NW;
        f32x4 v[2][4]; float s[2];
#pragma unroll
        for (int q = 0; q < 2; ++q) {
            const int row = rows[q] < T ? rows[q] : rowa;
            const float g0 = GATE[row * 2], g1 = GATE[row * 2 + 1];
            const v2u* xr = (const v2u*)(XB + (size_t)row * D);
            const v2u* y0 = (const v2u*)(YS + (size_t)slotrow[row * 2] * D);
            const v2u* y1 = (const v2u*)(YS + (size_t)slotrow[row * 2 + 1] * D);
            s[q] = 0.f;
#pragma unroll
            for (int j = 0; j < 4; ++j) { const v2u xx = xr[lane + 64 * j], a = y0[lane + 64 * j], c = y1[lane + 64 * j];
                const f32x4 x = {__uint_as_float(xx.x << 16), __uint_as_float(xx.x & 0xffff0000u), __uint_as_float(xx.y << 16), __uint_as_float(xx.y & 0xffff0000u)};
                const f32x4 fa = {__uint_as_float(a.x << 16), __uint_as_float(a.x & 0xffff0000u), __uint_as_float(a.y << 16), __uint_as_float(a.y & 0xffff0000u)};
                const f32x4 fc = {__uint_as_float(c.x << 16), __uint_as_float(c.x & 0xffff0000u), __uint_as_float(c.y << 16), __uint_as_float(c.y & 0xffff0000u)};
                v[q][j] = x * ALPHA + (fa * g0 + fc * g1);
                s[q] += (v[q][j][0] + v[q][j][1]) + (v[q][j][2] + v[q][j][3]); }
        }
#pragma unroll
        for (int q = 0; q < 2; ++q) {
            if (rows[q] >= T) continue;
            const int row = rows[q];
            const float mean = wave_sum(s[q]) * (1.f / D);
            float qq = 0.f;
#pragma unroll
            for (int j = 0; j < 4; ++j) { v[q][j] = v[q][j] - mean; qq += (v[q][j][0] * v[q][j][0] + v[q][j][1] * v[q][j][1]) + (v[q][j][2] * v[q][j][2] + v[q][j][3] * v[q][j][3]); }
            const float rstd = 1.f / sqrtf(wave_sum(qq) * (1.f / D) + LN_EPS);
#pragma unroll
            for (int j = 0; j < 4; ++j) { const f32x4 gg = ((const f32x4*)g)[lane + 64 * j], bb = ((const f32x4*)b)[lane + 64 * j];
                const f32x4 y = v[q][j] * rstd * gg + bb;
                if (layer == 0) ((v2u*)(XB + (size_t)row * D))[lane + 64 * j] = (v2u){pk2(y[0], y[1]), pk2(y[2], y[3])};
                else ((f32x4*)(Xo + (size_t)row * D))[lane + 64 * j] = y; }
        }
    }
}
constexpr int ATT_KSTR = 144;
constexpr int ATT_VSTR = 528;
constexpr int ATT_K_OFF = 0, ATT_V_OFF = 256 * ATT_KSTR;
template <int VAR = 0> __device__ __forceinline__ void phase_attn(LAS unsigned char* lds, const int tid_in, int bid, int G) {
    const Params P = kparams();
    unsigned char* ws = P.ws;
    const bf16_t* QKV = (const bf16_t*)(ws + WS_M + M_QKV); bf16_t* O = (bf16_t*)(ws + WS_M + M_O);
    const float* sinks = P.in[11];
    int tid = tid_in; asm volatile("" : "+v"(tid));
    const int lane = tid & 63, w = __builtin_amdgcn_readfirstlane(tid >> 6), fr = lane & 15, fq = lane >> 4;
    const int g = w >> 1, qh = w & 1;
    const int vcu = (G % 8 == 0) ? (bid % 8) * (G / 8) + bid / 8 : bid;
    LAS unsigned char* Kl = lds + ATT_K_OFF; LAS unsigned char* Vl = lds + ATT_V_OFF;
    const float L2E = 1.4426950408889634f;
    v4u kvr[4], vvr[4];
#pragma unroll
    for (int it = 0; it < 4; ++it) { kvr[it] = (v4u){0u, 0u, 0u, 0u}; vvr[it] = (v4u){0u, 0u, 0u, 0u}; }
    for (int L = vcu * 4; L < BATCH * 4 * 16; L += G * 4) {
      for (int u4 = 0; u4 < 4; ++u4) {
        const int unit = L + u4; if (unit >= BATCH * 4 * 16) break;
        const int nb = unit & 15, kvh = (unit >> 4) & 3, b = unit >> 6;
        const int h = kvh * 4 + g;
        const float slope2 = __builtin_amdgcn_exp2f(-0.5f * (float)(h + 1)) * L2E, sink2 = sinks[h] * L2E;
        const long rowbase = (long)b * SEQ + nb * 128 - 128;
        if (u4 == 0) {
#pragma unroll
            for (int it = 0; it < 4; ++it) {
                const int c = tid + it * NTHREADS, sj = c >> 3, ch = c & 7;
                kvr[it] = (v4u){0u, 0u, 0u, 0u}; vvr[it] = (v4u){0u, 0u, 0u, 0u};
                if (!(VAR & 1) && (nb > 0 || sj >= 128)) { const bf16_t* rp = QKV + (size_t)(rowbase + sj) * QKVD + kvh * 64 + ch * 8; kvr[it] = *(const v4u*)(rp + 1024); vvr[it] = *(const v4u*)(rp + 1280); }
            }
        }
        __syncthreads();
#pragma unroll
        for (int it = 0; it < 4; ++it) {
            const int c = tid + it * NTHREADS, sj = c >> 3, ch = c & 7;
            *(LAS v4u*)(Kl + sj * ATT_KSTR + ch * 16) = kvr[it];
            LAS bf16_t* vt = (LAS bf16_t*)(Vl + (ch * 8) * ATT_VSTR) + (sj ^ (ch << 2));
            const v4u vv = vvr[it];
#pragma unroll
            for (int e = 0; e < 8; ++e) vt[e * (ATT_VSTR / 2)] = (bf16_t)(vv[e >> 1] >> (16 * (e & 1)));
        }
        __syncthreads();
        if (u4 < 3 && unit + 1 < BATCH * 4 * 16) {
            const long rb2 = rowbase + 128;
#pragma unroll
            for (int it = 0; it < 4; ++it) {
                const int c = tid + it * NTHREADS, sj = c >> 3, ch = c & 7;
                const bf16_t* rp = QKV + (size_t)(rb2 + sj) * QKVD + kvh * 64 + ch * 8;
                if (!(VAR & 1)) { kvr[it] = *(const v4u*)(rp + 1024); vvr[it] = *(const v4u*)(rp + 1280); }
            }
        }
#pragma unroll 1
        for (int it = 0; it < 2; ++it) {
            const int kb = 4 * qh + 2 * it;
            const int qrow0 = 64 * qh + 32 * it;
            bf16x8 qf[2][2];
#pragma unroll
            for (int qt = 0; qt < 2; ++qt)
#pragma unroll
                for (int ds = 0; ds < 2; ++ds)
                    qf[qt][ds] = *(const bf16x8*)(QKV + (size_t)(rowbase + 128 + qrow0 + 16 * qt + fr) * QKVD + h * 64 + 32 * ds + 8 * fq);
            f32x4 acc[2][9];
#pragma unroll
            for (int qt = 0; qt < 2; ++qt)
#pragma unroll
                for (int i = 0; i < 9; ++i) acc[qt][i] = (f32x4){0.f, 0.f, 0.f, 0.f};
#pragma unroll
            for (int u = 0; u < 10; ++u)
#pragma unroll
                for (int ds = 0; ds < 2; ++ds) {
                    const bf16x8 kf = *(const LAS bf16x8*)(Kl + (16 * (kb + u) + fr) * ATT_KSTR + ds * 64 + fq * 16);
                    if (u <= 8) acc[0][u] = __builtin_amdgcn_mfma_f32_16x16x32_bf16(kf, qf[0][ds], acc[0][u], 0, 0, 0);
                    if (u >= 1) acc[1][u - 1] = __builtin_amdgcn_mfma_f32_16x16x32_bf16(kf, qf[1][ds], acc[1][u - 1], 0, 0, 0);
                }
#pragma unroll
            for (int qt = 0; qt < 2; ++qt) {
                const int kt0 = kb + qt;
                const int q = qrow0 + 16 * qt + fr;
                float m = -INFINITY;
                const float abias = -slope2 * (float)(fr - 4 * fq);
#pragma unroll
                for (int i = 0; i < 9; ++i)
#pragma unroll
                    for (int r = 0; r < 4; ++r) {
                        const int e = 4 * fq + r;
                        bool ok = (i == 0) ? (e > fr) : (i == 8) ? (e <= fr) : true;
                        if (nb == 0) ok = ok && (kt0 + i >= 8);
                        const float s = (VAR & 2) ? acc[qt][i][r] : (ok ? acc[qt][i][r] + __builtin_fmaf(slope2, (float)(r - 16 * (8 - i)), abias) : -INFINITY);
                        acc[qt][i][r] = s; m = fmaxf(m, s);
                    }
                m = fmaxf(m, __shfl_xor(m, 16)); m = fmaxf(m, __shfl_xor(m, 32));
                m = fmaxf(m, sink2);
                float l = 0.f;
                unsigned pk[10][2];
#pragma unroll
                for (int i = 0; i < 9; ++i) {
                    float p[4];
#pragma unroll
                    for (int r = 0; r < 4; ++r) { p[r] = (VAR & 2) ? acc[qt][i][r] : __builtin_amdgcn_exp2f(acc[qt][i][r] - m); l += p[r]; }
                    pk[i][0] = pg8::cvt_pk_bf16(p[0], p[1]); pk[i][1] = pg8::cvt_pk_bf16(p[2], p[3]);
                }
                pk[9][0] = 0u; pk[9][1] = 0u;
                l += __shfl_xor(l, 16); l += __shfl_xor(l, 32);
                l += __builtin_amdgcn_exp2f(sink2 - m);
                const float rl = 1.f / l;
                f32x4 oacc[4];
#pragma unroll
                for (int dt = 0; dt < 4; ++dt) oacc[dt] = (f32x4){0.f, 0.f, 0.f, 0.f};
#pragma unroll
                for (int c = 0; c < 5; ++c) {
                    const int i0 = 2 * c, i1 = (c < 4) ? 2 * c + 1 : 7;
                    const bf16x8 pf = __builtin_bit_cast(bf16x8, (v4u){pk[i0][0], pk[i0][1], pk[2 * c + 1][0], pk[2 * c + 1][1]});
#pragma unroll
                    for (int dt = 0; dt < 4; ++dt) {
                        const LAS unsigned char* vr = Vl + (16 * dt + fr) * ATT_VSTR;
                        const int vsw = (((16 * dt + fr) >> 3) & 7) << 3;
                        const v2u a0 = *(const LAS v2u*)(vr + ((32 * (kt0 + i0) + 8 * fq) ^ vsw)), a1 = *(const LAS v2u*)(vr + ((32 * (kt0 + i1) + 8 * fq) ^ vsw));
                        const bf16x8 vf = __builtin_bit_cast(bf16x8, (v4u){a0.x, a0.y, a1.x, a1.y});
                        oacc[dt] = __builtin_amdgcn_mfma_f32_16x16x32_bf16(vf, pf, oacc[dt], 0, 0, 0);
                    }
                }
                bf16_t* orow = O + (size_t)(rowbase + 128 + q) * D + h * 64 + 4 * fq;
#pragma unroll
                for (int dt = 0; dt < 4; ++dt) st8_wt(orow + 16 * dt, (v2u){pg8::cvt_pk_bf16(oacc[dt][0] * rl, oacc[dt][1] * rl), pg8::cvt_pk_bf16(oacc[dt][2] * rl, oacc[dt][3] * rl)});
            }
        }
      }
    }
}
constexpr int RG_GF_OFF = 0;
constexpr int RG_C_OFF = 25600;
constexpr int RG_TOT_OFF = 25600 + 2560;
constexpr int RG_RS = 176;
constexpr int RG_X_OFF = 35840, RG_XB = 131 * RG_RS + 48;
constexpr int RG_G_OFF = RG_X_OFF + 2 * RG_XB, RG_GB = 128 * RG_RS;
constexpr int RG_Y_OFF = RG_G_OFF + 2 * RG_GB;
static_assert(RG_Y_OFF + RG_GB <= 163840 - 16, "RG-LRU LDS map");
__device__ __forceinline__ float fast_sigmoid(float x) { return __builtin_amdgcn_rcpf(1.f + __builtin_amdgcn_exp2f(-1.4426950408889634f * x)); }
template <int VAR = 0> __device__ __forceinline__ void phase_rglru(LAS unsigned char* lds, const int tid_in, int bid, int G, bool dry = false) {
    const Params P = kparams();
    unsigned char* ws = P.ws;
    const bf16_t* Gt = (const bf16_t*)(ws + WS_M + M_G); bf16_t* Yo = dry ? (bf16_t*)P.out : (bf16_t*)(ws + WS_M + M_G); const bf16_t* XR = (const bf16_t*)(ws + WS_M + M_XR);
    int tid = tid_in; asm volatile("" : "+v"(tid));
    const int lane = tid & 63, w = __builtin_amdgcn_readfirstlane(tid >> 6), fr = lane & 15, fq = lane >> 4;
    LAS v2u* gfl = (LAS v2u*)(lds + RG_GF_OFF);
    LAS float* cst = (LAS float*)(lds + RG_C_OFF);
    LAS float* tot = (LAS float*)(lds + RG_TOT_OFF);
    LAS float* hinb = (LAS float*)(lds + RG_TOT_OFF + 5120);
    const int vcu = (G % 8 == 0) ? (bid % 8) * (G / 8) + bid / 8 : bid;
    int xro[3], gro[3];
    unsigned xgo[3];
#pragma unroll
    for (int i = 0; i < 3; ++i) { const int idx = tid + i * NTHREADS, rw = idx / 10, ch = idx % 10;
        xro[i] = (idx < 1310) ? rw * RG_RS + ch * 16 : -1; gro[i] = (idx < 1280) ? rw * RG_RS + ch * 16 : -1; xgo[i] = (unsigned)(rw * DR + ch * 8); }
    for (int unit = vcu; unit < BATCH * 16; unit += G) {
        const int b = unit >> 4, n = unit & 15;
        const bf16_t* xbase = XR + ((size_t)b * SEQ) * DR + n * 80; const bf16_t* gbase = Gt + ((size_t)b * SEQ) * DR + n * 80; bf16_t* ybase = Yo + ((size_t)b * SEQ) * DR + n * 80;
#define RG_FETCH(rr) do { _Pragma("unroll") for (int i = 0; i < 3; ++i) { xs[i] = (v4u){0u, 0u, 0u, 0u}; gs[i] = (v4u){0u, 0u, 0u, 0u}; \
            if (xro[i] >= 0 && ((rr) > 0 || xro[i] >= 3 * RG_RS)) xs[i] = *(const v4u*)(xbase + (long)(128 * (rr) - 3) * DR + xgo[i]); \
            if (gro[i] >= 0) gs[i] = *(const v4u*)(gbase + (size_t)(128 * (rr)) * DR + xgo[i]); } } while (0)
#define RG_STASH(bufi) do { _Pragma("unroll") for (int i = 0; i < 3; ++i) { \
            if (xro[i] >= 0) *(LAS v4u*)(lds + RG_X_OFF + (bufi) * RG_XB + xro[i]) = xs[i]; \
            if (gro[i] >= 0) *(LAS v4u*)(lds + RG_G_OFF + (bufi) * RG_GB + gro[i]) = gs[i]; } } while (0)
#define RG_YSTORE(rr) do { _Pragma("unroll") for (int i = 0; i < 3; ++i) { if (gro[i] >= 0) \
            st16_wt(ybase + (size_t)(128 * (rr)) * DR + xgo[i], *(const LAS v4u*)(lds + RG_Y_OFF + gro[i])); } } while (0)
        v4u xs[3], gs[3];
        __syncthreads();
        RG_FETCH(0);
        { const v2u* GF = (const v2u*)(ws + WS_GF);
          for (int i = tid; i < 2 * 1600; i += NTHREADS) { const int mat = i / 1600, rem = i % 1600; gfl[i] = GF[(size_t)(mat * 16 + n) * 1600 + rem]; }
          if (tid < 80) { const int c = n * 80 + tid;
              cst[0 * 80 + tid] = P.in[2][0 * DR + c]; cst[1 * 80 + tid] = P.in[2][1 * DR + c]; cst[2 * 80 + tid] = P.in[2][2 * DR + c]; cst[3 * 80 + tid] = P.in[2][3 * DR + c];
              cst[4 * 80 + tid] = P.in[3][c]; cst[5 * 80 + tid] = P.in[5][c]; cst[6 * 80 + tid] = P.in[7][c];
              cst[7 * 80 + tid] = -8.0f * log1pf(expf(-P.in[8][c])) * 1.4426950408889634f; } }
        RG_STASH(0);
        __syncthreads();
        float hcar = 0.f;
#pragma unroll 1
        for (int r = 0; r < SEQ / 128; ++r) {
            const LAS unsigned char* xb = lds + RG_X_OFF + (r & 1) * RG_XB + (16 * w + fr) * RG_RS + 8 * fq;
            const LAS unsigned char* gb = lds + RG_G_OFF + (r & 1) * RG_GB + (16 * w + fr) * RG_RS + 8 * fq;
            if (!(VAR & 2)) { if (r + 1 < SEQ / 128) RG_FETCH(r + 1); }
            float xc[5][4]; s16x4 bfr[5];
#pragma unroll
            for (int ks = 0; ks < 5; ++ks) {
                const int c0 = 16 * ks + 4 * fq;
                f32x4 s = *(LAS f32x4*)(cst + 4 * 80 + c0);
#pragma unroll
                for (int k = 0; k < 4; ++k) { const f32x4 wv = *(LAS f32x4*)(cst + k * 80 + c0); const v2u x = *(const LAS v2u*)(xb + k * RG_RS + 32 * ks);
                    s[0] += __uint_as_float(x.x << 16) * wv[0]; s[1] += __uint_as_float(x.x & 0xffff0000u) * wv[1]; s[2] += __uint_as_float(x.y << 16) * wv[2]; s[3] += __uint_as_float(x.y & 0xffff0000u) * wv[3]; }
#pragma unroll
                for (int j = 0; j < 4; ++j) xc[ks][j] = s[j];
                bfr[ks] = __builtin_bit_cast(s16x4, (v2u){pg8::cvt_pk_bf16(s[0], s[1]), pg8::cvt_pk_bf16(s[2], s[3])});
            }
            f32x4 ra[5], ia[5];
#pragma unroll
            for (int jt = 0; jt < 5; ++jt) { ra[jt] = (f32x4){0.f, 0.f, 0.f, 0.f}; ia[jt] = (f32x4){0.f, 0.f, 0.f, 0.f};
#pragma unroll
                for (int ks = 0; ks < 5; ++ks) {
                    const s16x4 ar = __builtin_bit_cast(s16x4, gfl[(jt * 5 + ks) * 64 + lane]), ai = __builtin_bit_cast(s16x4, gfl[1600 + (jt * 5 + ks) * 64 + lane]);
                    ra[jt] = __builtin_amdgcn_mfma_f32_16x16x16bf16_1k(ar, bfr[ks], ra[jt], 0, 0, 0);
                    ia[jt] = __builtin_amdgcn_mfma_f32_16x16x16bf16_1k(ai, bfr[ks], ia[jt], 0, 0, 0);
                } }
            float A[5][4], U[5][4];
#pragma unroll
            for (int jt = 0; jt < 5; ++jt) {
                const int c0 = 16 * jt + 4 * fq;
                const f32x4 brv = *(LAS f32x4*)(cst + 5 * 80 + c0), biv = *(LAS f32x4*)(cst + 6 * 80 + c0), cav = *(LAS f32x4*)(cst + 7 * 80 + c0);
#pragma unroll
                for (int j = 0; j < 4; ++j) {
                    const float rg = fast_sigmoid(ra[jt][j] + brv[j]), ig = fast_sigmoid(ia[jt][j] + biv[j]);
                    const float la2 = rg * cav[j];
                    float a = __builtin_amdgcn_exp2f(la2);
                    float u = __builtin_amdgcn_sqrtf(fmaxf(1.f - a * a, 0.f)) * (ig * xc[jt][j]);
                    A[jt][j] = a; U[jt][j] = u;
                }
#define RG_SCAN4(S) asm volatile("s_nop 1\n\t" \
                    "v_fmac_f32_dpp %0, %0, %4 row_shr:" #S " row_mask:0xf bank_mask:0xf\n\tv_fmac_f32_dpp %1, %1, %5 row_shr:" #S " row_mask:0xf bank_mask:0xf\n\t" \
                    "v_fmac_f32_dpp %2, %2, %6 row_shr:" #S " row_mask:0xf bank_mask:0xf\n\tv_fmac_f32_dpp %3, %3, %7 row_shr:" #S " row_mask:0xf bank_mask:0xf\n\t" \
                    "v_mul_f32_dpp %4, %4, %4 row_shr:" #S " row_mask:0xf bank_mask:0xf\n\tv_mul_f32_dpp %5, %5, %5 row_shr:" #S " row_mask:0xf bank_mask:0xf\n\t" \
                    "v_mul_f32_dpp %6, %6, %6 row_shr:" #S " row_mask:0xf bank_mask:0xf\n\tv_mul_f32_dpp %7, %7, %7 row_shr:" #S " row_mask:0xf bank_mask:0xf" \
                    : "+v"(U[jt][0]), "+v"(U[jt][1]), "+v"(U[jt][2]), "+v"(U[jt][3]), "+v"(A[jt][0]), "+v"(A[jt][1]), "+v"(A[jt][2]), "+v"(A[jt][3]))
                RG_SCAN4(1); RG_SCAN4(2); RG_SCAN4(4); RG_SCAN4(8);
#undef RG_SCAN4
            }
            if (fr == 15) {
#pragma unroll
                for (int jt = 0; jt < 5; ++jt)
#pragma unroll
                    for (int j = 0; j < 4; j += 2) *(LAS f32x4*)(tot + w * 160 + (16 * jt + 4 * fq + j) * 2) = (f32x4){A[jt][j], U[jt][j], A[jt][j + 1], U[jt][j + 1]};
            }
            if (!(VAR & 1)) __syncthreads();
            if (tid < 80) {
#pragma unroll
                for (int ww = 0; ww < 8; ++ww) { const f32x2v q = *(LAS f32x2v*)(tot + ww * 160 + tid * 2); hinb[ww * 80 + tid] = hcar; hcar = q.x * hcar + q.y; }
            }
            if (r > 0) RG_YSTORE(r - 1);
            if (!(VAR & 2)) { if (r + 1 < SEQ / 128) RG_STASH((r + 1) & 1); }
            if (!(VAR & 1)) __syncthreads();
#pragma unroll
            for (int jt = 0; jt < 5; ++jt) {
                const f32x4 hq = *(LAS f32x4*)(hinb + w * 80 + 16 * jt + 4 * fq);
                const v2u gv = *(const LAS v2u*)(gb + 32 * jt);
                float y[4];
#pragma unroll
                for (int j = 0; j < 4; ++j) {
                    const float h = A[jt][j] * hq[j] + U[jt][j];
                    const unsigned gw = (j < 2) ? gv.x : gv.y;
                    const float gt = (j & 1) ? __uint_as_float(gw & 0xffff0000u) : __uint_as_float(gw << 16);
                    const float uu = 0.7978845608028654f * (gt + 0.044715f * gt * gt * gt);
                    y[j] = h * gt * __builtin_amdgcn_rcpf(1.f + __builtin_amdgcn_exp2f(-2.885390081777927f * uu));
                }
                *(LAS v2u*)(lds + RG_Y_OFF + (16 * w + fr) * RG_RS + 8 * fq + 32 * jt) = (v2u){pg8::cvt_pk_bf16(y[0], y[1]), pg8::cvt_pk_bf16(y[2], y[3])};
            }
        }
        __syncthreads();
        RG_YSTORE(SEQ / 128 - 1);
#undef RG_FETCH
#undef RG_STASH
#undef RG_YSTORE
    }
}
#ifndef PROBE_MASK
#define PROBE_MASK 0
#endif
#ifndef PROBE_VAR
#define PROBE_VAR 0
#endif
#ifndef PROBE_PFX_NULL
#define PROBE_PFX_NULL 0
#endif
#ifndef PROBE_DRY
#define PROBE_DRY 0
#endif
struct Args { Params P; int ph_lo, ph_hi; };
__device__ __forceinline__ int lane_id_now() { int l; asm volatile("v_mbcnt_lo_u32_b32 %0, -1, 0\n\tv_mbcnt_hi_u32_b32 %0, -1, %0" : "=v"(l)); return l; }
__global__ void __launch_bounds__(NTHREADS, 2) mk_fwd(Args a) {
    extern __shared__ __attribute__((aligned(16))) unsigned char lds_raw[];
    LAS unsigned char* lds = (LAS unsigned char*)lds_raw;
    const int wv = __builtin_amdgcn_readfirstlane(threadIdx.x >> 6);
#define MYTID(wvv) ((wvv) * 64 + lane_id_now())
    volatile LAS unsigned* bst = (volatile LAS unsigned*)(lds + LDS_BYTES - 16);
    { const int t0 = MYTID(wv); if (t0 < 4) bst[t0] = 0u;
      __syncthreads();
      const Params P0 = kparams(); (void)xcd_barrier_post((unsigned*)(P0.ws + WS_BAR), bst, t0); }
#define SEAM(ph) do { if (hi > PH_COUNT) cg::this_grid().sync();   { const Params Pb = kparams(); XcdBarrier xb; xb.bar = (unsigned*)(Pb.ws + WS_BAR); xb.x = xb_xcc_id(); xb.st = bst; xcd_barrier(xb, tid_in); } } while (0)
#define RUN(ph, call) do { if (lo <= (ph) && (ph) < hi) { int bid = blockIdx.x, G = gridDim.x, wvl = wv; asm volatile("" : "+s"(bid), "+s"(G), "+s"(wvl)); const int tid_in = MYTID(wvl); \
        call; if ((PROBE_MASK >> (ph)) & 1) { call; } if ((ph) + 1 < hi && (ph) != PH_UP0 && (ph) != PH_UP1) SEAM(ph); } } while (0)
#define PHASE_PROGRAM \
    RUN(PH_PROLOGUE, phase_prologue(lds, tid_in, bid, G)); \
    RUN(PH_WIN, { if (pfx && PROBE_PFX_NULL) phase_gemm_win_null(lds, tid_in, bid, G); else phase_gemm_win(lds, tid_in, bid, G); }); \
    if ((PROBE_DRY >> PH_RGLRU) & 1) { int bid = blockIdx.x, G = gridDim.x; asm volatile("" : "+s"(bid), "+s"(G)); phase_rglru<PROBE_VAR>(lds, MYTID(wv), bid, G, true); } \
    RUN(PH_RGLRU, phase_rglru(lds, tid_in, bid, G)); \
    RUN(PH_WOUT, phase_gemm_wout(lds, tid_in, bid, G)); \
    RUN(PH_LN0, phase_ln(0, lds, tid_in, bid, G)); \
    RUN(PH_ROUTE0, phase_route(lds, tid_in, bid, G)); \
    RUN(PH_UP0, phase_moe_up(0, lds, tid_in, bid, G)); \
    RUN(PH_DOWN0, phase_moe_down(0, lds, tid_in, bid, G)); \
    RUN(PH_COMB0, phase_combine(0, tid_in, bid, G)); \
    RUN(PH_QKV, phase_gemm_qkv(lds, tid_in, bid, G)); \
    if ((PROBE_DRY >> PH_ATTN) & 1) { int bid = blockIdx.x, G = gridDim.x; asm volatile("" : "+s"(bid), "+s"(G)); phase_attn<PROBE_VAR>(lds, MYTID(wv), bid, G); } \
    RUN(PH_ATTN, phase_attn(lds, tid_in, bid, G)); \
    RUN(PH_WO, phase_gemm_wo(lds, tid_in, bid, G)); \
    RUN(PH_LN1, phase_ln(1, lds, tid_in, bid, G)); \
    RUN(PH_ROUTE1, phase_route(lds, tid_in, bid, G)); \
    RUN(PH_UP1, phase_moe_up(1, lds, tid_in, bid, G)); \
    RUN(PH_DOWN1, phase_moe_down(1, lds, tid_in, bid, G)); \
    RUN(PH_COMB1, phase_combine(1, tid_in, bid, G));
#ifdef PROBE_PREFIX
    { const int lo = 0, hi = PROBE_PREFIX; const bool pfx = true; PHASE_PROGRAM { const int tid_in = MYTID(wv); SEAM(0); } }
#endif
    { const int lo = a.ph_lo, hi = a.ph_hi; const bool pfx = false; PHASE_PROGRAM }
#ifdef PROBE_XBAR
    { const int hi = a.ph_hi; const int tid_in = MYTID(wv); for (int i = 0; i < PROBE_XBAR; ++i) SEAM(PH_COUNT - 1); }
#endif
#undef RUN
#undef SEAM
#undef MYTID
}
static int g_grid = 0;
extern "C" void kernel_launch(void* const* d_in, const int* in_sizes, int n_in, void* d_out, int out_size, void* d_ws, size_t ws_size, hipStream_t stream) {
    if (ws_size < WS_END || n_in < 22) { fprintf(stderr, "kernel_launch: workspace too small (%zu < %zu) or %d inputs\n", ws_size, (size_t)WS_END, n_in); return; }
    if (g_grid == 0) {
        int dev = 0, cus = 0, per_cu = 0;
        (void)hipGetDevice(&dev); (void)hipDeviceGetAttribute(&cus, hipDeviceAttributeMultiprocessorCount, dev);
        if (hipFuncSetAttribute((const void*)mk_fwd, hipFuncAttributeMaxDynamicSharedMemorySize, LDS_BYTES) != hipSuccess) fprintf(stderr, "kernel_launch: hipFuncSetAttribute failed\n");
        if (hipOccupancyMaxActiveBlocksPerMultiprocessor(&per_cu, (const void*)mk_fwd, NTHREADS, LDS_BYTES) != hipSuccess || per_cu < 1) { fprintf(stderr, "kernel_launch: occupancy query says %d blocks per CU\n", per_cu); per_cu = 1; }
        (void)hipGetLastError();
        g_grid = cus;
    }
    (void)hipMemsetAsync((unsigned char*)d_ws + WS_READY, 0, WS_BAR + 16384 - WS_READY, stream);
    Args a{};
    for (int i = 0; i < 22; ++i) a.P.in[i] = (const float*)d_in[i];
    a.P.out = (float*)d_out; a.P.ws = (unsigned char*)d_ws;
    a.ph_lo = 0; a.ph_hi = PH_COUNT;
    void* args[] = {&a};
    hipError_t e = hipLaunchCooperativeKernel((const void*)mk_fwd, dim3(g_grid), dim3(NTHREADS), args, LDS_BYTES, stream);
    if (e != hipSuccess) fprintf(stderr, "kernel_launch: cooperative launch failed: %s (grid %d)\n", hipGetErrorString(e), g_grid);
}
```

```cpp
#include <hip/hip_runtime.h>
#include <stdint.h>
#include <cstdio>
#include <hip/hip_cooperative_groups.h>
namespace cg = cooperative_groups;

typedef unsigned short bf16_t;
constexpr int D = 1024, BATCH = 16, SEQ = 2048, T = BATCH * SEQ;
constexpr int DR = 1280, BW = 80;
constexpr int NH = 16, HD = 64, WIN = 128;
constexpr int QKVD = 1536;
constexpr int NE = 32, DE = 512;
constexpr int MB = 256;
constexpr int TK = T * 2;
constexpr int NROWS_MAX = TK + NE * MB;
constexpr float ALPHA = 1.41421356237309515f;
constexpr float LN_EPS = 1e-5f;
constexpr float QSCALE = 0.125f * 1.4426950408889634f;

constexpr size_t MiB = 1u << 20;
constexpr size_t WS_CTL = 0;
constexpr size_t WS_READY = 256 * 1024, READY_BANK = 128 * 1024;
constexpr size_t WS_BAR = 512 * 1024;
constexpr size_t WS_WIN = 1 * MiB, WS_WOUT = 6 * MiB, WS_WQKV = 8 * MiB + 512 * 1024, WS_WO = 11 * MiB + 512 * 1024, WS_GF = 13 * MiB + 512 * 1024;
constexpr size_t WS_ROUTE = 14 * MiB;
constexpr size_t WS_W13 = 16 * MiB, WS_W2 = 144 * MiB, WS_XB = 208 * MiB, WS_M = 272 * MiB, WS_END = 488 * MiB;
constexpr size_t M_G = 0, M_XR = 80 * MiB, M_TMP = 160 * MiB;
constexpr size_t M_QKV = 0, M_O = 96 * MiB;
constexpr size_t M_HDN = 0, M_YS = 72 * MiB;

__device__ __forceinline__ float bf2f(bf16_t v) { return __uint_as_float((unsigned)v << 16); }
__device__ __forceinline__ bf16_t f2bf(float f) { unsigned u = __float_as_uint(f); return (bf16_t)((u + 0x7fffu + ((u >> 16) & 1u)) >> 16); }


#ifndef WT_STORES
#define WT_STORES 0
#endif
typedef unsigned wt_v4u __attribute__((ext_vector_type(4)));
typedef unsigned wt_v2u __attribute__((ext_vector_type(2)));
__device__ __forceinline__ void st16_wt(void* p, wt_v4u v) {
#if WT_STORES
    asm volatile("global_store_dwordx4 %0, %1, off sc1\n\ts_nop 1" :: "v"(p), "v"(v) : "memory");
#else
    *(wt_v4u*)p = v;
#endif
}
__device__ __forceinline__ void st8_wt(void* p, wt_v2u v) {
#if WT_STORES
    asm volatile("global_store_dwordx2 %0, %1, off sc1\n\ts_nop 0" :: "v"(p), "v"(v) : "memory");
#else
    *(wt_v2u*)p = v;
#endif
}

#ifndef WT_GEMM
#define WT_GEMM 0
#endif
__device__ __forceinline__ void st16_gemm(void* p, wt_v4u v) {
#if WT_GEMM == 1
    asm volatile("global_store_dwordx4 %0, %1, off sc1\n\ts_nop 1" :: "v"(p), "v"(v) : "memory");
#elif WT_GEMM == 2
    asm volatile("global_store_dwordx4 %0, %1, off nt\n\ts_nop 1" :: "v"(p), "v"(v) : "memory");
#elif WT_GEMM == 3
    asm volatile("global_store_dwordx4 %0, %1, off sc0 sc1\n\ts_nop 1" :: "v"(p), "v"(v) : "memory");
#else
    *(wt_v4u*)p = v;
#endif
}
#ifndef PG8_ROWMAJOR
#define PG8_ROWMAJOR 0
#endif
#ifndef PG8_XCDREMAP
#define PG8_XCDREMAP 1
#endif
#ifndef PG8_WGM
#define PG8_WGM 2
#endif
namespace pg8 {
#define PG8_LAS __attribute__((address_space(3)))
typedef short bf16x8 __attribute__((ext_vector_type(8)));
typedef float f32x4 __attribute__((ext_vector_type(4)));
typedef unsigned u32x4 __attribute__((ext_vector_type(4)));
typedef unsigned u32x2 __attribute__((ext_vector_type(2)));
constexpr int BM = 256, BK = 64, HALF = 128, HTB = HALF * BK * 2  , STAGE_BYTES = 8 * HTB, NXCD = 8, WGM = PG8_WGM;

__host__ __device__ __forceinline__ int lds_byte(int r, int c) { const int st = (r >> 4) * 2 + (c >> 5), rr = r & 15, cc = c & 31, ob = rr * 64 + cc * 2; return st * 1024 + (ob ^ (((ob >> 9) & 1) << 5)); }
__host__ __device__ __forceinline__ void stage_rc(int b, int& R, int& C) { const int st = b / 1024, sb = b % 1024, swz = sb ^ (((sb >> 9) & 1) << 5); R = (st >> 1) * 16 + swz / 64; C = (st & 1) * 32 + (swz % 64) / 2; }
__host__ __device__ __forceinline__ int perm32(int rho) { const int n = rho >> 4, i = rho & 15; return 8 * (i >> 2) + 4 * n + (i & 3); }

struct Unit { int pm, pn, li; };

template <int WGM_> __device__ __forceinline__ bool order_at(long L, int nM, int nN, Unit& u) {
    constexpr int WGM = WGM_;
    const int nwg = nM * nN; if (L >= nwg) return false;
    int wgid = (int)L; if (PG8_XCDREMAP) { const int q = nwg / NXCD, r = nwg % NXCD, xcd = wgid % NXCD, off = wgid / NXCD; wgid = (xcd < r ? xcd * (q + 1) : r * (q + 1) + (xcd - r) * q) + off; }
    const int nig = WGM * nN, gid = wgid / nig, fm = gid * WGM, gsz = (nM - fm) < WGM ? (nM - fm) : WGM;
    if (PG8_ROWMAJOR) { u.pm = fm + ((wgid % nig) / nN); u.pn = (wgid % nig) % nN; if (u.pm >= fm + gsz) { const int idx = wgid % nig; u.pm = fm + idx % gsz; u.pn = idx / gsz; } }
    else { u.pm = fm + ((wgid % nig) % gsz); u.pn = (wgid % nig) / gsz; }
    return true;
}
template <int WGM_> __device__ __forceinline__ bool order_next(int i, int G, int c, int nM, int nN, Unit& u) { return order_at<WGM_>((long)i * G + c, nM, nN, u); }
template <int K_, int NN_, bool GATHER, bool EXPERT, int DEP = 0, int WGM_ = PG8_WGM>
struct Order {
    static constexpr int K = K_, nN = NN_, AUX_A = (DEP == 2) ? 16 : 0;
    int nM, G, c; const char* A; const char* Bt; const int* block_e; const int* rowtok; unsigned* ready; unsigned need; const PG8_LAS int* tokl;
    __device__ __forceinline__ bool next(int i, Unit& u) const { return order_next<WGM_>(i, G, c, nM, nN, u); }
    __device__ __forceinline__ const char* a_base(const Unit& u) const { return GATHER ? A : A + (size_t)u.pm * BM * K * 2; }
    __device__ __forceinline__ const char* b_base(const Unit& u) const { return Bt + (EXPERT ? (size_t)block_e[u.pm] * (size_t)(nN * BM) * K * 2 : (size_t)0) + (size_t)u.pn * BM * K * 2; }
    __device__ __forceinline__ unsigned a_rowoff(const Unit& u, int r) const {
        if (GATHER) return (unsigned)tokl[u.li * BM + r] * (unsigned)(K * 2);
        return (unsigned)(r * K * 2);
    }
    __device__ __forceinline__ void fill_tokl(PG8_LAS int* dst, int tid) const {
        Unit u;
        for (int i = 0; next(i, u); ++i) if (tid < BM) { const int s = rowtok[u.pm * BM + tid]; dst[i * BM + tid] = s >= 0 ? (s >> 1) : 0; }
    }
    __device__ __forceinline__ void a_ready(const Unit& u, int tid) const {
        if (DEP == 2) {
            if (tid < 64) { unsigned spins = 0;
                while ((unsigned)__builtin_amdgcn_readfirstlane(__hip_atomic_load(ready + 64 * u.pm, __ATOMIC_RELAXED, __HIP_MEMORY_SCOPE_AGENT)) < need) { __builtin_amdgcn_s_sleep(2); if (++spins > (1u << 22)) break; } }
            asm volatile("" ::: "memory"); __builtin_amdgcn_s_barrier(); asm volatile("" ::: "memory");
        }
    }
    __device__ __forceinline__ void done(const Unit& u, int lane) const {
        if (DEP == 1) { asm volatile("s_waitcnt vmcnt(0)" ::: "memory"); if (lane == 0) __hip_atomic_fetch_add(ready + 64 * u.pm, 1u, __ATOMIC_RELAXED, __HIP_MEMORY_SCOPE_AGENT); }
    }
};

__device__ __forceinline__ unsigned cvt_pk_bf16(float lo, float hi) { unsigned r; asm volatile("v_cvt_pk_bf16_f32 %0, %1, %2" : "=v"(r) : "v"(lo), "v"(hi)); return r; }

__device__ __forceinline__ void store_full_lines(bf16_t* grp  , int ldc, int fr, int fq, const u32x4 (&w)[2]) {
    const bool lo = fr < 8;
    u32x4 snd, rcv;
#pragma unroll
    for (int k = 0; k < 4; ++k) { snd[k] = lo ? w[1][k] : w[0][k]; rcv[k] = (unsigned)__builtin_amdgcn_update_dpp(0, (int)snd[k], 0x128  , 0xF, 0xF, false); }
    u32x4 da, db;
#pragma unroll
    for (int k = 0; k < 4; ++k) { da[k] = lo ? w[0][k] : rcv[k]; db[k] = lo ? rcv[k] : w[1][k]; }
    bf16_t* p = grp + (size_t)(fr & 7) * ldc + (lo ? 0 : 32) + 8 * fq;
    *(u32x4*)p = da; *(u32x4*)(p + (size_t)8 * ldc) = db;
}
struct EpiBf16 {
    static constexpr bool PERM = true, FULL = true;
    bf16_t* O; int ldc; int split_cols; size_t split_stride; float scale0;
    __device__ __forceinline__ void operator()(const f32x4 (&acc)[2][2][4][2], const Unit& u, int wr, int wc, int fr, int fq) const {
        int colt = u.pn * BM; bf16_t* base = O;
        float sc = 1.f; if (split_cols) { const int t = colt / split_cols; base += (size_t)t * split_stride; colt -= t * split_cols; if (t == 0) sc = scale0; }
#pragma unroll
        for (int ai = 0; ai < 2; ++ai)
#pragma unroll
            for (int m = 0; m < 4; ++m) { u32x4 w[2];
#pragma unroll
                for (int bj = 0; bj < 2; ++bj) { const f32x4 v0 = acc[ai][bj][m][0] * sc, v1 = acc[ai][bj][m][1] * sc;
                    w[bj].x = cvt_pk_bf16(v0[0], v0[1]); w[bj].y = cvt_pk_bf16(v0[2], v0[3]); w[bj].z = cvt_pk_bf16(v1[0], v1[1]); w[bj].w = cvt_pk_bf16(v1[2], v1[3]); }
                store_full_lines(base + (size_t)(u.pm * BM + wr * 64 + ai * HALF + m * 16) * ldc + colt + wc * 64, ldc, fr, fq, w); }
    }
};
struct EpiNull {
    static constexpr bool PERM = true, FULL = true;
    __device__ __forceinline__ void operator()(const f32x4 (&acc)[2][2][4][2], const Unit&, int, int, int, int) const {
#pragma unroll
        for (int ai = 0; ai < 2; ++ai)
#pragma unroll
            for (int bj = 0; bj < 2; ++bj)
#pragma unroll
                for (int m = 0; m < 4; ++m)
#pragma unroll
                    for (int n = 0; n < 2; ++n) asm volatile("" :: "v"(acc[ai][bj][m][n]));
    }
};
template <bool RES_BF16>
struct EpiResidZ {
    static constexpr bool PERM = true, FULL = true;
    const void* res; bf16_t* Z; float alpha;
    __device__ __forceinline__ void operator()(const f32x4 (&acc)[2][2][4][2], const Unit& u, int wr, int wc, int fr, int fq) const {
        const int row0 = u.pm * BM + wr * 64 + fr, col0 = u.pn * BM + wc * 64 + 8 * fq;
#pragma unroll
        for (int ai = 0; ai < 2; ++ai)
#pragma unroll
            for (int m = 0; m < 4; ++m) { const size_t off = (size_t)(row0 + ai * HALF + m * 16) * 1024 + col0; u32x4 w[2];
#pragma unroll
                for (int bj = 0; bj < 2; ++bj) { f32x4 r0, r1;
                    if (RES_BF16) { const u32x4 rb = *(const u32x4*)((const bf16_t*)res + off + bj * 32);
                        r0 = (f32x4){__uint_as_float(rb.x << 16), __uint_as_float(rb.x & 0xffff0000u), __uint_as_float(rb.y << 16), __uint_as_float(rb.y & 0xffff0000u)};
                        r1 = (f32x4){__uint_as_float(rb.z << 16), __uint_as_float(rb.z & 0xffff0000u), __uint_as_float(rb.w << 16), __uint_as_float(rb.w & 0xffff0000u)}; }
                    else { r0 = *(const f32x4*)((const float*)res + off + bj * 32); r1 = *(const f32x4*)((const float*)res + off + bj * 32 + 4); }
                    const f32x4 v0 = r0 * alpha + acc[ai][bj][m][0], v1 = r1 * alpha + acc[ai][bj][m][1];
                    w[bj].x = cvt_pk_bf16(v0[0], v0[1]); w[bj].y = cvt_pk_bf16(v0[2], v0[3]); w[bj].z = cvt_pk_bf16(v1[0], v1[1]); w[bj].w = cvt_pk_bf16(v1[2], v1[3]); }
                store_full_lines(Z + (size_t)(u.pm * BM + wr * 64 + ai * HALF + m * 16) * 1024 + u.pn * BM + wc * 64, 1024, fr, fq, w); }
    }
};
struct EpiSwiglu {
    static constexpr bool PERM = true, FULL = false;
    bf16_t* H;
    __device__ __forceinline__ void operator()(const f32x4 (&acc)[2][2][4][2], const Unit& u, int wr, int wc, int fr, int fq) const {
        const int row0 = u.pm * BM + wr * 64 + fr, col0 = u.pn * HALF + wc * 32 + 8 * fq;
#pragma unroll
        for (int ai = 0; ai < 2; ++ai)
#pragma unroll
            for (int m = 0; m < 4; ++m) { float h[8];
#pragma unroll
                for (int n = 0; n < 2; ++n)
#pragma unroll
                    for (int j = 0; j < 4; ++j) { const float a = acc[ai][0][m][n][j], b = acc[ai][1][m][n][j];
                        h[n * 4 + j] = a * __builtin_amdgcn_rcpf(1.f + __builtin_amdgcn_exp2f(-1.4426950408889634f * a)) * b; }
                u32x4 w; w.x = cvt_pk_bf16(h[0], h[1]); w.y = cvt_pk_bf16(h[2], h[3]); w.z = cvt_pk_bf16(h[4], h[5]); w.w = cvt_pk_bf16(h[6], h[7]);
                asm volatile("global_store_dwordx4 %0, %1, off sc1\n\ts_nop 1" :: "v"(H + (size_t)(row0 + ai * HALF + m * 16) * 512 + col0), "v"(w) : "memory"); }
    }
};

template <class Epi, class Sched, bool ALIGN_EPI>
__device__ __forceinline__ void gemm_phase(PG8_LAS unsigned char* lds, const int tid_in, const Sched& S, const Epi& E) {
    constexpr int K = Sched::K;
    int tid = tid_in; asm volatile("" : "+v"(tid));
    const int wid = __builtin_amdgcn_readfirstlane(tid >> 6), lane = tid & 63, wr = wid >> 2, wc = wid & 3, fr = lane & 15, fq = lane >> 4;
    const int nt = K / BK;
    int Rr[2], Cc[2]; unsigned voffB[2][2];
#pragma unroll
    for (int i = 0; i < 2; ++i) { int R, C; stage_rc(tid * 16 + i * 8192, R, C); Rr[i] = R; Cc[i] = C;
#pragma unroll
        for (int h = 0; h < 2; ++h) {
            const int col = Epi::FULL ? (64 * (R >> 5) + 32 * h + perm32(R & 31)) : (HALF * h + (Epi::PERM ? ((R & ~31) + perm32(R & 31)) : R));
            voffB[h][i] = (unsigned)(col * K + C) * 2u; } }
    const size_t kstep = (size_t)(BK * 2);
    const unsigned ldsw = (unsigned)wid * 1024u;
    const int aoff = lds_byte(wr * 64 + fr, fq * 8), boff = lds_byte(wc * 32 + fr, fq * 8);
#define PG8_SA(b, h) (((b) * 2 + (h)) * HTB)
#define PG8_SB(b, h) ((4 + (b) * 2 + (h)) * HTB)
#define PG8_STAGE(bufoff, gbase, voff) do { _Pragma("unroll") for (int _i = 0; _i < 2; ++_i) \
        __builtin_amdgcn_global_load_lds((const unsigned*)((const char*)(gbase) + (voff)[_i]), (PG8_LAS unsigned*)(lds + (bufoff) + ldsw + _i * 8192), 16, 0, 0); } while (0)
#define PG8_STAGEA(bufoff, gbase, voff) do { _Pragma("unroll") for (int _i = 0; _i < 2; ++_i) \
        __builtin_amdgcn_global_load_lds((const unsigned*)((const char*)(gbase) + (voff)[_i]), (PG8_LAS unsigned*)(lds + (bufoff) + ldsw + _i * 8192), 16, 0, Sched::AUX_A); } while (0)
#define PG8_LDA(dst, b, h) do { _Pragma("unroll") for (int m = 0; m < 4; ++m) _Pragma("unroll") for (int k = 0; k < 2; ++k) dst[m][k] = *(const PG8_LAS bf16x8*)(lds + PG8_SA(b, h) + aoff + m * 2048 + k * 1024); } while (0)
#define PG8_LDB(dst, b, h) do { _Pragma("unroll") for (int n = 0; n < 2; ++n) _Pragma("unroll") for (int k = 0; k < 2; ++k) dst[n][k] = *(const PG8_LAS bf16x8*)(lds + PG8_SB(b, h) + boff + n * 2048 + k * 1024); } while (0)
#define PG8_MMA(ai, bj, At, Bt) do { __builtin_amdgcn_s_setprio(1); _Pragma("unroll") for (int m = 0; m < 4; ++m) _Pragma("unroll") for (int n = 0; n < 2; ++n) _Pragma("unroll") for (int k = 0; k < 2; ++k) \
        acc[ai][bj][m][n] = __builtin_amdgcn_mfma_f32_16x16x32_bf16(Bt[n][k], At[m][k], acc[ai][bj][m][n], 0, 0, 0); __builtin_amdgcn_s_setprio(0); } while (0)
#define PG8_WAIT_V(n) asm volatile("s_waitcnt vmcnt(" #n ")" ::: "memory")
#define PG8_WAIT_L(n) asm volatile("s_waitcnt lgkmcnt(" #n ")" ::: "memory")
#define PG8_BAR __builtin_amdgcn_s_barrier()
#define PG8_SCHED __builtin_amdgcn_sched_barrier(0)
#define PG8_VOFF(dst, u) do { _Pragma("unroll") for (int _h = 0; _h < 2; ++_h) _Pragma("unroll") for (int _i = 0; _i < 2; ++_i) dst[_h][_i] = S.a_rowoff(u, _h * HALF + Rr[_i]) + (unsigned)(Cc[_i] * 2); } while (0)
    Unit cur, nxt; int ui = 0;
    if (!S.next(0, cur)) return;
    cur.li = 0;
    f32x4 acc[2][2][4][2];
#pragma unroll
    for (int a = 0; a < 2; ++a)
#pragma unroll
        for (int b = 0; b < 2; ++b)
#pragma unroll
            for (int m = 0; m < 4; ++m)
#pragma unroll
                for (int n = 0; n < 2; ++n) acc[a][b][m][n] = (f32x4){0.f, 0.f, 0.f, 0.f};
    bf16x8 At[4][2], B0[2][2], B1[2][2];
    unsigned vC[2][2], vN[2][2];
    PG8_VOFF(vC, cur);
    const char* cA = S.a_base(cur); const char* cB = S.b_base(cur);
    S.a_ready(cur, tid);
    PG8_STAGE(PG8_SB(0, 0), cB, voffB[0]); PG8_STAGE(PG8_SB(0, 1), cB, voffB[1]); PG8_STAGEA(PG8_SA(0, 0), cA, vC[0]); PG8_STAGEA(PG8_SA(0, 1), cA, vC[1]);
    if (wr == 1) PG8_BAR;
    PG8_WAIT_V(2); PG8_BAR;
    PG8_STAGE(PG8_SB(1, 0), cB + kstep, voffB[0]); PG8_STAGEA(PG8_SA(1, 0), cA + kstep, vC[0]); PG8_STAGE(PG8_SB(1, 1), cB + kstep, voffB[1]);
    PG8_WAIT_V(6); PG8_BAR;
    for (;;) {
        const bool has_next = S.next(ui + 1, nxt); nxt.li = ui + 1;
        const char* nA = cA; const char* nB = cB;
#pragma unroll
        for (int h = 0; h < 2; ++h)
#pragma unroll
            for (int i = 0; i < 2; ++i) vN[h][i] = vC[h][i];
        if (has_next) { nA = S.a_base(nxt); nB = S.b_base(nxt); PG8_VOFF(vN, nxt); }
        for (int t = 0; t < nt; t += 2) {
            const bool last = (t == nt - 2);
            if (last && has_next) S.a_ready(nxt, tid);
            const char* a1 = cA + (size_t)(t + 1) * kstep;
            const char* a2 = last ? nA : cA + (size_t)(t + 2) * kstep; const char* b2 = last ? nB : cB + (size_t)(t + 2) * kstep;
            const char* a3 = a2 + kstep; const char* b3 = b2 + kstep;
            unsigned v2[2][2];
#pragma unroll
            for (int h = 0; h < 2; ++h)
#pragma unroll
                for (int i = 0; i < 2; ++i) v2[h][i] = last ? vN[h][i] : vC[h][i];
            PG8_LDB(B0, 0, 0); PG8_LDB(B1, 0, 1); PG8_SCHED; PG8_LDA(At, 0, 0); PG8_STAGEA(PG8_SA(1, 1), a1, vC[1]);
            PG8_WAIT_V(8); PG8_WAIT_L(0); PG8_BAR; PG8_MMA(0, 0, At, B0); PG8_MMA(0, 1, At, B1); PG8_BAR; PG8_SCHED;
            PG8_LDA(At, 0, 1); PG8_STAGE(PG8_SB(0, 0), b2, voffB[0]); PG8_STAGE(PG8_SB(0, 1), b2, voffB[1]); PG8_STAGEA(PG8_SA(0, 0), a2, v2[0]);
            PG8_WAIT_V(8); PG8_WAIT_L(0); PG8_BAR; PG8_MMA(1, 0, At, B0); PG8_MMA(1, 1, At, B1); PG8_BAR; PG8_SCHED;
            PG8_LDB(B0, 1, 0); PG8_LDB(B1, 1, 1); PG8_SCHED; PG8_LDA(At, 1, 0); PG8_STAGEA(PG8_SA(0, 1), a2, v2[1]);
            PG8_WAIT_V(8); PG8_WAIT_L(0); PG8_BAR; PG8_MMA(0, 0, At, B0); PG8_MMA(0, 1, At, B1); PG8_BAR; PG8_SCHED;
            PG8_LDA(At, 1, 1); PG8_STAGE(PG8_SB(1, 0), b3, voffB[0]); PG8_STAGE(PG8_SB(1, 1), b3, voffB[1]); PG8_STAGEA(PG8_SA(1, 0), a3, v2[0]);
            PG8_WAIT_V(8); PG8_WAIT_L(0); PG8_BAR; PG8_MMA(1, 0, At, B0); PG8_MMA(1, 1, At, B1); PG8_BAR; PG8_SCHED;
        }
        if constexpr (ALIGN_EPI) { if (wr == 0) PG8_BAR; }
        E(acc, cur, wr, wc, fr, fq); S.done(cur, lane);
        if (!has_next) break;
#pragma unroll
        for (int a = 0; a < 2; ++a)
#pragma unroll
            for (int b = 0; b < 2; ++b)
#pragma unroll
                for (int m = 0; m < 4; ++m)
#pragma unroll
                    for (int n = 0; n < 2; ++n) acc[a][b][m][n] = (f32x4){0.f, 0.f, 0.f, 0.f};
        cur = nxt; cA = nA; cB = nB; ++ui;
#pragma unroll
        for (int h = 0; h < 2; ++h)
#pragma unroll
            for (int i = 0; i < 2; ++i) vC[h][i] = vN[h][i];
        if constexpr (ALIGN_EPI) { if (wr == 1) PG8_BAR; }
    }
    PG8_WAIT_V(0);
    if constexpr (!ALIGN_EPI) { if (wr == 0) PG8_BAR; }
    PG8_BAR;
#undef PG8_SA
#undef PG8_SB
#undef PG8_STAGE
#undef PG8_STAGEA
#undef PG8_LDA
#undef PG8_LDB
#undef PG8_MMA
#undef PG8_WAIT_V
#undef PG8_WAIT_L
#undef PG8_BAR
#undef PG8_SCHED
#undef PG8_VOFF
}
}
#define GAS __attribute__((address_space(1)))
#define LAS __attribute__((address_space(3)))
typedef unsigned v4u __attribute__((ext_vector_type(4)));
typedef unsigned v2u __attribute__((ext_vector_type(2)));
typedef float f32x4 __attribute__((ext_vector_type(4)));
typedef short s16x4 __attribute__((ext_vector_type(4)));
typedef short bf16x8 __attribute__((ext_vector_type(8)));
constexpr int NWAVES = 8, NTHREADS = 512;
constexpr int LDS_BYTES = 163840;
#define LDS_WAIT() asm volatile("s_waitcnt lgkmcnt(0)" ::: "memory")

struct Params { const float* in[22]; float* out; unsigned char* ws; };

typedef const __attribute__((address_space(4))) Params* KParamsPtr;
__device__ __forceinline__ Params kparams() {
    KParamsPtr p = (KParamsPtr)__builtin_amdgcn_kernarg_segment_ptr();
    asm volatile("" : "+s"(p));
    Params P;
#pragma unroll
    for (int i = 0; i < 22; ++i) P.in[i] = p->in[i];
    P.out = p->out; P.ws = p->ws;
    return P;
}
__device__ __forceinline__ unsigned pk2(float lo, float hi) { return (unsigned)f2bf(lo) | ((unsigned)f2bf(hi) << 16); }

__device__ __forceinline__ void transpose_item(const float* W, int ldw, bf16_t* WT, int ldt, int k0, int n0, int orow0, LAS float* scr, int lane) {
#pragma unroll 8
    for (int i = 0; i < 32; ++i) { const int kk = 2 * i + (lane >> 5); scr[kk * 33 + (lane & 31)] = W[(size_t)(k0 + kk) * ldw + n0 + (lane & 31)]; }
    LDS_WAIT(); asm volatile("" ::: "memory");
    const int c = lane & 7;
#pragma unroll
    for (int j = 0; j < 4; ++j) { const int n = (lane >> 3) + 8 * j; const LAS float* s = scr + (8 * c) * 33 + n;
        v4u o; o.x = pk2(s[0 * 33], s[1 * 33]); o.y = pk2(s[2 * 33], s[3 * 33]); o.z = pk2(s[4 * 33], s[5 * 33]); o.w = pk2(s[6 * 33], s[7 * 33]);
        st16_wt(WT + (size_t)(orow0 + n) * ldt + k0 + 8 * c, o); }
    LDS_WAIT(); asm volatile("" ::: "memory");
}

constexpr int IT_WIN = (D / 64) * (2 * DR / 32);
constexpr int IT_WOUT = (DR / 64) * (D / 32);
constexpr int IT_WQKV = (D / 64) * (QKVD / 32);
constexpr int IT_WO = (D / 64) * (D / 32);
constexpr int IT_W1 = (D / 64) * (DE / 32);
constexpr int IT_W2 = (DE / 64) * (D / 32);
constexpr int IT_MOE_LAYER = NE * (2 * IT_W1 + IT_W2);
constexpr int IT_DENSE = IT_WIN + IT_WOUT + IT_WQKV + IT_WO;

__device__ __forceinline__ void cvt_dense_item(const Params& P, int r, LAS float* scr, int lane) {
    unsigned char* ws = P.ws;
    if (r < IT_WIN) { const int nb = 2 * DR / 32, kb = r / nb, n0 = (r % nb) * 32; transpose_item(P.in[1], 2 * DR, (bf16_t*)(ws + WS_WIN), D, kb * 64, n0, n0, scr, lane); return; } r -= IT_WIN;
    if (r < IT_WOUT) { const int nb = D / 32, kb = r / nb, n0 = (r % nb) * 32; transpose_item(P.in[9], D, (bf16_t*)(ws + WS_WOUT), DR, kb * 64, n0, n0, scr, lane); return; } r -= IT_WOUT;
    if (r < IT_WQKV) { const int nb = QKVD / 32, kb = r / nb, n0 = (r % nb) * 32; transpose_item(P.in[10], QKVD, (bf16_t*)(ws + WS_WQKV), D, kb * 64, n0, n0, scr, lane); return; } r -= IT_WQKV;
    { const int nb = D / 32, kb = r / nb, n0 = (r % nb) * 32; transpose_item(P.in[12], D, (bf16_t*)(ws + WS_WO), D, kb * 64, n0, n0, scr, lane); }
}
__device__ __forceinline__ void cvt_moe_item(const Params& P, int layer, int r, LAS float* scr, int lane) {
    unsigned char* ws = P.ws;
    const int per_e = 2 * IT_W1 + IT_W2, e = r / per_e; int q = r % per_e;
    bf16_t* W13t = (bf16_t*)(ws + WS_W13) + ((size_t)layer * NE + e) * (size_t)(D * D);
    bf16_t* W2t = (bf16_t*)(ws + WS_W2) + ((size_t)layer * NE + e) * (size_t)(D * DE);
    const size_t eoff13 = ((size_t)layer * NE + e) * (size_t)(D * DE);
    if (q < 2 * IT_W1) { const int which = q / IT_W1; q %= IT_W1; const int nb = DE / 32, kb = q / nb, n0 = (q % nb) * 32;
        const int orow0 = (n0 / 128) * 256 + which * 128 + (n0 % 128);
        transpose_item((which ? P.in[18] : P.in[17]) + eoff13, DE, W13t, D, kb * 64, n0, orow0, scr, lane); return; }
    q -= 2 * IT_W1;
    { const int nb = D / 32, kb = q / nb, n0 = (q % nb) * 32; transpose_item(P.in[19] + eoff13, D, W2t, DE, kb * 64, n0, n0, scr, lane); }
}

__device__ __forceinline__ void cvt_gate_frags(const Params& P, int gtid, int gthreads) {
    v2u* GF = (v2u*)(P.ws + WS_GF);
    for (int i = gtid; i < 2 * 16 * 25 * 64; i += gthreads) {
        const int l = i & 63, ks = (i >> 6) % 5, jt = (i / 320) % 5, n = (i / 1600) % 16, mat = i / 25600;
        const float* w = (mat ? P.in[6] : P.in[4]) + (size_t)n * BW * BW;
        const int j = 16 * jt + (l & 15), k = 16 * ks + 4 * (l >> 4);
        v2u o; o.x = pk2(w[(k + 0) * BW + j], w[(k + 1) * BW + j]); o.y = pk2(w[(k + 2) * BW + j], w[(k + 3) * BW + j]);
        GF[i] = o;
    }
}
__device__ __forceinline__ void cvt_x(const Params& P, int gtid, int gthreads) {
    const f32x4* x = (const f32x4*)P.in[0]; v4u* xb = (v4u*)(P.ws + WS_XB);
    for (size_t i = gtid; i < (size_t)T * D / 8; i += gthreads) { const f32x4 a = x[2 * i], b = x[2 * i + 1];
        v4u o; o.x = pk2(a[0], a[1]); o.y = pk2(a[2], a[3]); o.z = pk2(b[0], b[1]); o.w = pk2(b[2], b[3]); st16_wt(xb + i, o); }
}
__device__ __forceinline__ void phase_prologue(LAS unsigned char* lds, const int tid_in, int vcu, int G) {
    const Params P = kparams();
    int tid = tid_in; asm volatile("" : "+v"(tid));
    const int lane = tid & 63, wave = __builtin_amdgcn_readfirstlane(tid >> 6);
    LAS float* scr = (LAS float*)(lds + wave * 16384);
    const int gw = vcu * NWAVES + wave, NGW = G * NWAVES;
    for (int it = gw; it < IT_DENSE; it += NGW) cvt_dense_item(P, it, scr, lane);
    for (int it = gw; it < 2 * IT_MOE_LAYER; it += NGW) cvt_moe_item(P, it / IT_MOE_LAYER, it % IT_MOE_LAYER, scr, lane);
    cvt_gate_frags(P, vcu * NTHREADS + tid, G * NTHREADS);
    cvt_x(P, vcu * NTHREADS + tid, G * NTHREADS);
}

__device__ __forceinline__ void phase_cvt_moe(int layer, LAS unsigned char* lds, const int tid_in, int vcu, int G) {
    const Params P = kparams();
    int tid = tid_in; asm volatile("" : "+v"(tid));
    const int lane = tid & 63, wave = __builtin_amdgcn_readfirstlane(tid >> 6);
    LAS float* scr = (LAS float*)(lds + wave * 16384);
    const int gw = vcu * NWAVES + wave, NGW = G * NWAVES;
    for (int it = gw; it < IT_MOE_LAYER; it += NGW) cvt_moe_item(P, layer, it, scr, lane);
}
#define XB_TMO      128
#define XB_XCNT(j)  (256  + 64 * (j))
#define XB_XSUB(j)  (1280 + 64 * (j))
#define XB_XGEN(j)  (2304 + 64 * (j))
#define XB_TOP      3328
#define XB_TOPGEN   3392
#define XCD_BAR_WORDS 3456
#define XB_SPIN_CAP (1u << 18)

__device__ __forceinline__ unsigned xb_ld(unsigned* p)              { return __hip_atomic_load(p, __ATOMIC_RELAXED, __HIP_MEMORY_SCOPE_AGENT); }
__device__ __forceinline__ unsigned xb_add(unsigned* p, unsigned v) { return __hip_atomic_fetch_add(p, v, __ATOMIC_RELAXED, __HIP_MEMORY_SCOPE_AGENT); }
__device__ __forceinline__ unsigned xb_xcc_id() { return (unsigned)__builtin_amdgcn_s_getreg((3 << 11) | 20) & 0xFu; }
#define XB_SPIN(cond, bar) do { unsigned _sp = 0; while (cond) { __builtin_amdgcn_s_sleep(1); \
    if ((++_sp & 255u) == 0u) { if (xb_ld(&(bar)[XB_TMO])) break; if (_sp > XB_SPIN_CAP) { atomicAdd(&(bar)[XB_TMO], 1u); break; } } } } while (0)

struct XcdBarrier {
    unsigned* bar; unsigned x;
    volatile LAS unsigned* st;
};

__device__ __forceinline__ XcdBarrier xcd_barrier_post(unsigned* bar, volatile LAS unsigned* st, const int xb_tid) {
    XcdBarrier b; b.bar = bar; b.x = xb_xcc_id(); b.st = st;
    if (xb_tid == 0) (void)xb_add(&bar[XB_XCNT(b.x)], 1u);
    return b;
}
__device__ __forceinline__ void xcd_barrier_complete(unsigned* bar, unsigned x, unsigned& nloc, unsigned& nx) {
    const unsigned G = gridDim.x * gridDim.y * gridDim.z;
    unsigned sum, cnt, mine, sp = 0u;
    for (;;) {
        sum = 0u; cnt = 0u; mine = 0u;
#pragma unroll
        for (unsigned j = 0; j < 16; ++j) { const unsigned c = xb_ld(&bar[XB_XCNT(j)]); sum += c; cnt += (c > 0u) ? 1u : 0u; mine = (j == x) ? c : mine; }
        if (sum == G) break;
        __builtin_amdgcn_s_sleep(1);
        if ((++sp & 255u) == 0u) { if (xb_ld(&bar[XB_TMO])) break; if (sp > XB_SPIN_CAP) { atomicAdd(&bar[XB_TMO], 1u); break; } }
    }
    nloc = mine > 0u ? mine : 1u; nx = cnt > 0u ? cnt : 1u;
}

__device__ __forceinline__ void xcd_barrier(const XcdBarrier& b, const int xb_tid) {
    asm volatile("s_waitcnt vmcnt(0)" ::: "memory");
    __syncthreads();
    if (xb_tid == 0) {
        unsigned* bar = b.bar;
        __builtin_amdgcn_s_waitcnt(0);
        unsigned nloc = b.st[0], nx = b.st[1];
        if (nloc == 0u) { xcd_barrier_complete(bar, b.x, nloc, nx); b.st[0] = nloc; b.st[1] = nx; }
        const unsigned old = xb_add(&bar[XB_XSUB(b.x)], 1u);
        const unsigned gen = old / nloc;
        if (old + 1u == (gen + 1u) * nloc) {
            __builtin_amdgcn_fence(__ATOMIC_RELEASE, "agent");
            asm volatile("s_waitcnt vmcnt(0)" ::: "memory");
            const unsigned og = xb_add(&bar[XB_TOP], 1u);
            const unsigned tg = og / nx;
            if (og + 1u == (tg + 1u) * nx) xb_add(&bar[XB_TOPGEN], 1u);
            else XB_SPIN(xb_ld(&bar[XB_TOPGEN]) == tg, bar);
            __builtin_amdgcn_fence(__ATOMIC_ACQUIRE, "agent");
            xb_add(&bar[XB_XGEN(b.x)], 1u);
            asm volatile("s_waitcnt vmcnt(0)" ::: "memory");
        } else {
            XB_SPIN(xb_ld(&bar[XB_XGEN(b.x)]) == gen, bar);
            __builtin_amdgcn_fence(__ATOMIC_ACQUIRE, "agent");
            asm volatile("s_waitcnt vmcnt(0)" ::: "memory");
        }
    }
    __syncthreads();
}
#ifndef WGM_WIN
#define WGM_WIN PG8_WGM
#endif
#ifndef WGM_QKV
#define WGM_QKV PG8_WGM
#endif
#ifndef WGM_WOUT
#define WGM_WOUT PG8_WGM
#endif
#ifndef WGM_WO
#define WGM_WO PG8_WGM
#endif
#ifndef WGM_UP
#define WGM_UP PG8_WGM
#endif
#ifndef WGM_DOWN
#define WGM_DOWN PG8_WGM
#endif
#ifndef PG8_ALIGN
#define PG8_ALIGN true
#endif
enum Phase { PH_PROLOGUE = 0, PH_WIN, PH_RGLRU, PH_WOUT, PH_LN0, PH_ROUTE0, PH_UP0, PH_DOWN0, PH_COMB0, PH_QKV, PH_ATTN, PH_WO, PH_LN1, PH_ROUTE1, PH_UP1, PH_DOWN1, PH_COMB1, PH_COUNT };
__device__ __forceinline__ void phase_gemm_win(LAS unsigned char* lds, const int tid_in, int bid, int G) {
    const Params P = kparams(); unsigned char* ws = P.ws;
    typedef pg8::Order<D, 2 * DR / 256, false, false, 0, WGM_WIN> O;
    const O S{T / 256, G, bid, (const char*)(ws + WS_XB), (const char*)(ws + WS_WIN), nullptr, nullptr, nullptr, 0u, nullptr};
    const pg8::EpiBf16 E{(bf16_t*)(ws + WS_M + M_G), DR, DR, (size_t)(M_XR - M_G) / 2, 1.f};
    pg8::gemm_phase<pg8::EpiBf16, O, PG8_ALIGN>(lds, tid_in, S, E);
}
__device__ __forceinline__ void phase_gemm_qkv(LAS unsigned char* lds, const int tid_in, int bid, int G) {
    const Params P = kparams(); unsigned char* ws = P.ws;
    typedef pg8::Order<D, QKVD / 256, false, false, 0, WGM_QKV> O;
    const O S{T / 256, G, bid, (const char*)(ws + WS_XB), (const char*)(ws + WS_WQKV), nullptr, nullptr, nullptr, 0u, nullptr};
    const pg8::EpiBf16 E{(bf16_t*)(ws + WS_M + M_QKV), QKVD, 1024, 1024, QSCALE};
    pg8::gemm_phase<pg8::EpiBf16, O, PG8_ALIGN>(lds, tid_in, S, E);
}
__device__ __forceinline__ void phase_gemm_wout(LAS unsigned char* lds, const int tid_in, int bid, int G) {
    const Params P = kparams(); unsigned char* ws = P.ws;
    typedef pg8::Order<DR, D / 256, false, false, 0, WGM_WOUT> O;
    const O S{T / 256, G, bid, (const char*)(ws + WS_M + M_G), (const char*)(ws + WS_WOUT), nullptr, nullptr, nullptr, 0u, nullptr};
    const pg8::EpiResidZ<false> E{P.in[0], (bf16_t*)P.out, ALPHA};
    pg8::gemm_phase<pg8::EpiResidZ<false>, O, PG8_ALIGN>(lds, tid_in, S, E);
}
__device__ __forceinline__ void phase_gemm_wo(LAS unsigned char* lds, const int tid_in, int bid, int G) {
    const Params P = kparams(); unsigned char* ws = P.ws;
    typedef pg8::Order<D, D / 256, false, false, 0, WGM_WO> O;
    const O S{T / 256, G, bid, (const char*)(ws + WS_M + M_O), (const char*)(ws + WS_WO), nullptr, nullptr, nullptr, 0u, nullptr};
    const pg8::EpiResidZ<true> E{ws + WS_XB, (bf16_t*)P.out, ALPHA};
    pg8::gemm_phase<pg8::EpiResidZ<true>, O, PG8_ALIGN>(lds, tid_in, S, E);
}
__device__ __forceinline__ void phase_moe_up(int layer, LAS unsigned char* lds, const int tid_in, int bid, int G) {
    const Params P = kparams(); unsigned char* ws = P.ws; const int* ctl = (const int*)(ws + WS_CTL);
    typedef pg8::Order<D, 4, true, true, 1, WGM_UP> O;
    const O S{ctl[97], G, bid, (const char*)(ws + WS_XB), (const char*)(ws + WS_W13) + (size_t)layer * NE * (size_t)(D * D * 2), ctl + 128, (const int*)(ws + WS_ROUTE + 512 * 1024), (unsigned*)(ws + WS_READY + (size_t)layer * READY_BANK), 0u, (const LAS int*)(lds + 131072 + 4096)};
    { int t_ = tid_in; asm volatile("" : "+v"(t_)); S.fill_tokl((LAS int*)(lds + 131072 + 4096), t_); __syncthreads(); }
    const pg8::EpiSwiglu E{(bf16_t*)(ws + WS_M + M_HDN)};
    pg8::gemm_phase<pg8::EpiSwiglu, O, PG8_ALIGN>(lds, tid_in, S, E);
}
__device__ __forceinline__ void phase_moe_down(int layer, LAS unsigned char* lds, const int tid_in, int bid, int G) {
    const Params P = kparams(); unsigned char* ws = P.ws; const int* ctl = (const int*)(ws + WS_CTL);
    typedef pg8::Order<DE, 4, false, true, 2, WGM_DOWN> O;
    const O S{ctl[97], G, G - 1 - bid, (const char*)(ws + WS_M + M_HDN), (const char*)(ws + WS_W2) + (size_t)layer * NE * (size_t)(D * DE * 2), ctl + 128, nullptr, (unsigned*)(ws + WS_READY + (size_t)layer * READY_BANK), 32u, nullptr};
    const pg8::EpiBf16 E{(bf16_t*)(ws + WS_M + M_YS), D, 0, 0, 1.f};
    pg8::gemm_phase<pg8::EpiBf16, O, PG8_ALIGN>(lds, tid_in, S, E);
}

__device__ __forceinline__ void phase_gemm_win_null(LAS unsigned char* lds, const int tid_in, int bid, int G) {
    const Params P = kparams(); unsigned char* ws = P.ws;
    typedef pg8::Order<D, 2 * DR / 256, false, false> O;
    const O S{T / 256, G, bid, (const char*)(ws + WS_XB), (const char*)(ws + WS_WIN), nullptr, nullptr, nullptr, 0u, nullptr};
    const pg8::EpiNull E{};
    pg8::gemm_phase<pg8::EpiNull, O, PG8_ALIGN>(lds, tid_in, S, E);
}
constexpr size_t CTL_CNT = 16384;
constexpr int LN_ROWS = 32, LN_TILES = T / LN_ROWS;
typedef float f32x2v __attribute__((ext_vector_type(2)));

__device__ __forceinline__ float wave_sum(float v) {
#pragma unroll
    for (int o = 1; o < 64; o <<= 1) v += __shfl_xor(v, o);
    return v;
}
__device__ __forceinline__ void split_bf(float x, unsigned& hi, unsigned& lo) { hi = f2bf(x); lo = f2bf(x - __uint_as_float(hi << 16)); }

__device__ __forceinline__ void phase_ln(int layer, LAS unsigned char* lds, const int tid_in, int bid, int G, bool dry = false) {
    const Params P = kparams();
    unsigned char* ws = P.ws;
    const bf16_t* Z = (const bf16_t*)P.out; bf16_t* XB = (bf16_t*)(ws + (dry ? WS_M + 128 * MiB : WS_XB));
    const float* lg = P.in[20] + (size_t)(layer * 2) * D; const float* lb = P.in[21] + (size_t)(layer * 2) * D;
    const float* wg = P.in[13] + (size_t)layer * D * 4; const float* bg = P.in[14] + layer * 4;
    const float* we = P.in[15] + (size_t)layer * D * 32; const float* be = P.in[16] + layer * 32;
    unsigned char* rbase = ws + (dry ? WS_M + 192 * MiB : WS_ROUTE);
    int* EXP = (int*)(rbase); float* GATE = (float*)(rbase + 256 * 1024); int* rowtok = (int*)(rbase + 512 * 1024);
    int* CNT = dry ? (int*)(rbase + 2 * MiB) : (int*)(ws + WS_CTL) + CTL_CNT;
    int tid = tid_in; asm volatile("" : "+v"(tid));
    const int lane = tid & 63, w = __builtin_amdgcn_readfirstlane(tid >> 6), fr = lane & 15, fq = lane >> 4;
    for (int i = bid * NTHREADS + tid; i < NROWS_MAX; i += G * NTHREADS) rowtok[i] = -1;
    LAS float* stat = (LAS float*)lds;
    LAS float* part = (LAS float*)(lds + 2048);
    LAS float* logit = (LAS float*)(lds + 2048 + 49152);
    LAS int* hist = (LAS int*)(lds + 2048 + 49152 + 6144);
    v2u vp[2][4][2];
#define LN_LOAD(tl) do { _Pragma("unroll") for (int rt = 0; rt < 2; ++rt) _Pragma("unroll") for (int s = 0; s < 4; ++s) _Pragma("unroll") for (int hf = 0; hf < 2; ++hf) \
        vp[rt][s][hf] = *(const v2u*)(Z + (size_t)((tl) * LN_ROWS + 16 * rt + fr) * D + 128 * w + 32 * s + 16 * hf + 4 * fq); } while (0)
#define LN_UNPACK(p) ((f32x4){__uint_as_float((p).x << 16), __uint_as_float((p).x & 0xffff0000u), __uint_as_float((p).y << 16), __uint_as_float((p).y & 0xffff0000u)})
    if (bid < LN_TILES) LN_LOAD(bid);
    bf16x8 Bh[4][3];
    LAS bf16x8* Bl = (LAS bf16x8*)(lds + 58368) + (w * 12) * 64 + lane;
    { float wv[4][3][8];
#pragma unroll
      for (int s = 0; s < 4; ++s)
#pragma unroll
          for (int ct = 0; ct < 3; ++ct)
#pragma unroll
              for (int j = 0; j < 8; ++j) {
                  const int col = 128 * w + 32 * s + (j < 4 ? 4 * fq + j : 16 + 4 * fq + (j - 4));
                  wv[s][ct][j] = (ct < 2) ? we[(size_t)col * 32 + 16 * ct + fr] : wg[(size_t)col * 4 + (fr & 3)];
              }
#pragma unroll
      for (int s = 0; s < 4; ++s)
#pragma unroll
          for (int ct = 0; ct < 3; ++ct) {
              unsigned h[8], l[8];
#pragma unroll
              for (int j = 0; j < 8; ++j) split_bf((ct < 2 || fr < 4) ? wv[s][ct][j] : 0.f, h[j], l[j]);
              Bh[s][ct] = __builtin_bit_cast(bf16x8, (v4u){h[0] | (h[1] << 16), h[2] | (h[3] << 16), h[4] | (h[5] << 16), h[6] | (h[7] << 16)});
              Bl[(s * 3 + ct) * 64] = __builtin_bit_cast(bf16x8, (v4u){l[0] | (l[1] << 16), l[2] | (l[3] << 16), l[4] | (l[5] << 16), l[6] | (l[7] << 16)});
          } }
    for (int tile = bid; tile < LN_TILES; tile += G) {
        const int row0 = tile * LN_ROWS;
        if (tid < 32) hist[tid] = 0;
#pragma unroll
        for (int rt = 0; rt < 2; ++rt) {
            float sm = 0.f, sq = 0.f;
#pragma unroll
            for (int s = 0; s < 4; ++s)
#pragma unroll
                for (int hf = 0; hf < 2; ++hf) { const f32x4 x = LN_UNPACK(vp[rt][s][hf]); sm += (x[0] + x[1]) + (x[2] + x[3]); sq += (x[0] * x[0] + x[1] * x[1]) + (x[2] * x[2] + x[3] * x[3]); }
            sm += __shfl_xor(sm, 16); sm += __shfl_xor(sm, 32); sq += __shfl_xor(sq, 16); sq += __shfl_xor(sq, 32);
            if (fq == 0) *(LAS f32x2v*)(stat + ((w * 32) + 16 * rt + fr) * 2) = (f32x2v){sm, sq};
        }
#pragma unroll
        for (int rt = 0; rt < 2; ++rt)
#pragma unroll
            for (int s = 0; s < 4; ++s) asm volatile("" : "+v"(vp[rt][s][0]), "+v"(vp[rt][s][1]));
        __syncthreads();
        float mean[2], rstd[2];
#pragma unroll
        for (int rt = 0; rt < 2; ++rt) { float sm = 0.f, sq = 0.f;
#pragma unroll
            for (int ww = 0; ww < 8; ++ww) { const f32x2v a = *(LAS f32x2v*)(stat + ((ww * 32) + 16 * rt + fr) * 2); sm += a.x; sq += a.y; }
            mean[rt] = sm * (1.f / D); const float var = fmaxf(sq * (1.f / D) - mean[rt] * mean[rt], 0.f); rstd[rt] = 1.f / sqrtf(var + LN_EPS); }
        f32x4 acc[2][3];
#pragma unroll
        for (int rt = 0; rt < 2; ++rt)
#pragma unroll
            for (int ct = 0; ct < 3; ++ct) acc[rt][ct] = (f32x4){0.f, 0.f, 0.f, 0.f};
#pragma unroll
        for (int s = 0; s < 4; ++s) {
            asm volatile("" ::: "memory");
            f32x4 gg[2], bb[2];
#pragma unroll
            for (int hf = 0; hf < 2; ++hf) { gg[hf] = *(const f32x4*)(lg + 128 * w + 32 * s + 16 * hf + 4 * fq); bb[hf] = *(const f32x4*)(lb + 128 * w + 32 * s + 16 * hf + 4 * fq); }
#pragma unroll
            for (int rt = 0; rt < 2; ++rt) {
                unsigned h[8], l[8];
#pragma unroll
                for (int hf = 0; hf < 2; ++hf) {
                    f32x4 y = (LN_UNPACK(vp[rt][s][hf]) - mean[rt]) * rstd[rt] * gg[hf] + bb[hf];
                    const size_t off = (size_t)(row0 + 16 * rt + fr) * D + 128 * w + 32 * s + 16 * hf + 4 * fq;
#pragma unroll
                    for (int j = 0; j < 4; ++j) split_bf(y[j], h[4 * hf + j], l[4 * hf + j]);
                    st8_wt(XB + off, (v2u){h[4 * hf] | (h[4 * hf + 1] << 16), h[4 * hf + 2] | (h[4 * hf + 3] << 16)});
                }
                const bf16x8 Ah = __builtin_bit_cast(bf16x8, (v4u){h[0] | (h[1] << 16), h[2] | (h[3] << 16), h[4] | (h[5] << 16), h[6] | (h[7] << 16)});
                const bf16x8 Al = __builtin_bit_cast(bf16x8, (v4u){l[0] | (l[1] << 16), l[2] | (l[3] << 16), l[4] | (l[5] << 16), l[6] | (l[7] << 16)});
#pragma unroll
                for (int ct = 0; ct < 3; ++ct) {
                    acc[rt][ct] = __builtin_amdgcn_mfma_f32_16x16x32_bf16(Ah, Bh[s][ct], acc[rt][ct], 0, 0, 0);
                    acc[rt][ct] = __builtin_amdgcn_mfma_f32_16x16x32_bf16(Ah, Bl[(s * 3 + ct) * 64], acc[rt][ct], 0, 0, 0);
                    acc[rt][ct] = __builtin_amdgcn_mfma_f32_16x16x32_bf16(Al, Bh[s][ct], acc[rt][ct], 0, 0, 0);
                }
                __builtin_amdgcn_sched_barrier(0);
            }
        }
#pragma unroll
        for (int rt = 0; rt < 2; ++rt)
#pragma unroll
            for (int ct = 0; ct < 3; ++ct) *(LAS f32x4*)(part + (((w * 2 + rt) * 3 + ct) * 64 + lane) * 4) = acc[rt][ct];
        asm volatile("" ::: "memory");
        if (tile + G < LN_TILES) LN_LOAD(tile + G);
        __syncthreads();
#pragma unroll
        for (int k = 0; k < 3; ++k) {
            const int idx = tid + k * NTHREADS, r = idx & 3, ln = (idx >> 2) & 63, t6 = idx >> 8;
            float s = 0.f;
#pragma unroll
            for (int ww = 0; ww < 8; ++ww) s += part[((ww * 6 + t6) * 64 + ln) * 4 + r];
            const int rt = t6 / 3, ct = t6 % 3, row = 16 * rt + 4 * (ln >> 4) + r, col = 16 * ct + (ln & 15);
            logit[row * 48 + col] = s;
        }
        __syncthreads();
        if (tid < 32) {
            const LAS float* L = logit + tid * 48;
            int gi = 0; float gm = L[32] + bg[0];
            for (int o = 1; o < 4; ++o) { const float x = L[32 + o] + bg[o]; if (x > gm) { gm = x; gi = o; } }
            float gs = 0.f;
            for (int o = 0; o < 4; ++o) gs += __expf(L[32 + o] + bg[o] - gm);
            const float ggate = 1.f / gs;
            int i0 = 0; float v0 = L[gi * 8] + be[gi * 8];
            for (int i = 1; i < 8; ++i) { const float x = L[gi * 8 + i] + be[gi * 8 + i]; if (x > v0) { v0 = x; i0 = i; } }
            int i1 = -1; float v1 = -INFINITY;
            for (int i = 0; i < 8; ++i) { const float x = L[gi * 8 + i] + be[gi * 8 + i]; if (i != i0 && x > v1) { v1 = x; i1 = i; } }
            const float w0 = 1.f / (1.f + __expf(v1 - v0)), w1 = 1.f - w0;
            const int row = row0 + tid, e0 = gi * 8 + i0, e1 = gi * 8 + i1;
            EXP[row * 2] = e0; EXP[row * 2 + 1] = e1; GATE[row * 2] = w0 * ggate; GATE[row * 2 + 1] = w1 * ggate;
            __hip_atomic_fetch_add(&hist[e0], 1, __ATOMIC_RELAXED, __HIP_MEMORY_SCOPE_WORKGROUP); __hip_atomic_fetch_add(&hist[e1], 1, __ATOMIC_RELAXED, __HIP_MEMORY_SCOPE_WORKGROUP);
        }
        __syncthreads();
        if (tid < 32) CNT[tile * 32 + tid] = hist[tid];
    }
#undef LN_LOAD
#undef LN_UNPACK
}

__device__ __forceinline__ void phase_route(LAS unsigned char* lds, const int tid_in, int bid, int G) {
    const Params P = kparams();
    unsigned char* ws = P.ws;
    int* ctl = (int*)(ws + WS_CTL); const int* CNT = ctl + CTL_CNT;
    const int* EXP = (const int*)(ws + WS_ROUTE); int* rowtok = (int*)(ws + WS_ROUTE + 512 * 1024); int* slotrow = (int*)(ws + WS_ROUTE + 1024 * 1024);
    int tid = tid_in; asm volatile("" : "+v"(tid));
    const int lane = tid & 63, w = __builtin_amdgcn_readfirstlane(tid >> 6);
    LAS int* tab = (LAS int*)lds;
    LAS int* csum = (LAS int*)(lds + 131072);
    LAS int* cbase = (LAS int*)(lds + 131072 + 2048);
    typedef int i32x4 __attribute__((ext_vector_type(4)));
#pragma unroll 4
    for (int i = tid; i < LN_TILES * 32 / 4; i += NTHREADS) ((LAS i32x4*)tab)[i] = ((const i32x4*)CNT)[i];
    __syncthreads();
    const int e = tid & 31, ch = tid >> 5;
    { int run = 0;
#pragma unroll 8
      for (int t = 0; t < 64; ++t) { LAS int* p = tab + (ch * 64 + t) * 32 + e; const int v = *p; *p = run; run += v; }
      csum[ch * 32 + e] = run; }
    __syncthreads();
    if (tid < 32) { int run = 0; for (int c = 0; c < 16; ++c) { const int v = csum[c * 32 + tid]; cbase[c * 32 + tid] = run; run += v; } csum[tid] = run;   }
    __syncthreads();
    if (tid == 0) { int off = 0; for (int x = 0; x < NE; ++x) { const int p = (csum[x] + MB - 1) / MB * MB; csum[32 + x] = off;
            if (bid == 0) for (int r = off / MB; r < (off + p) / MB; ++r) ctl[128 + r] = x;
            off += p; }
        if (bid == 0) { ctl[96] = off; ctl[97] = off / MB; } }
    __syncthreads();
    for (int tile = bid * NWAVES + w; tile < LN_TILES; tile += G * NWAVES) {
        const int slot = tile * 64 + lane, ex = EXP[slot];
        int rank = 0;
        for (int x = 0; x < NE; ++x) { const unsigned long long m = __ballot(ex == x); if (ex == x) rank = __popcll(m & ((1ull << lane) - 1ull)); }
        const int row = csum[32 + ex] + cbase[(tile >> 6) * 32 + ex] + tab[tile * 32 + ex] + rank;
        rowtok[row] = slot; slotrow[slot] = row;
    }
}

__device__ __forceinline__ void phase_combine(int layer, const int tid_in, int bid, int G, bool dry = false) {
    const Params P = kparams();
    unsigned char* ws = P.ws;
    bf16_t* XB = (bf16_t*)(ws + WS_XB); float* Xo = P.out; const bf16_t* YS = (const bf16_t*)(ws + WS_M + M_YS);
    const float* GATE = (const float*)(ws + WS_ROUTE + 256 * 1024); const int* slotrow = (const int*)(ws + WS_ROUTE + 1024 * 1024);
    const float* g = P.in[20] + (size_t)(layer * 2 + 1) * D; const float* b = P.in[21] + (size_t)(layer * 2 + 1) * D;
    int tid = tid_in; asm volatile("" : "+v"(tid));
    const int lane = tid & 63, w = __builtin_amdgcn_readfirstlane(tid >> 6);
    const int NW = G * NWAVES;
    for (int rowa = bid * NWAVES + w; rowa < T; rowa += 2 * NW) {
        int rows[2]; rows[0] = rowa; rows[1] = rowa + NW;
        f32x4 v[2][4]; float s[2];
#pragma unroll
        for (int q = 0; q < 2; ++q) {
            const int row = rows[q] < T ? rows[q] : rowa;
            const float g0 = GATE[row * 2], g1 = GATE[row * 2 + 1];
            const v2u* xr = (const v2u*)(XB + (size_t)row * D);
            const v2u* y0 = (const v2u*)(YS + (size_t)slotrow[row * 2] * D);
            const v2u* y1 = (const v2u*)(YS + (size_t)slotrow[row * 2 + 1] * D);
            s[q] = 0.f;
#pragma unroll
            for (int j = 0; j < 4; ++j) { const v2u xx = xr[lane + 64 * j], a = y0[lane + 64 * j], c = y1[lane + 64 * j];
                const f32x4 x = {__uint_as_float(xx.x << 16), __uint_as_float(xx.x & 0xffff0000u), __uint_as_float(xx.y << 16), __uint_as_float(xx.y & 0xffff0000u)};
                const f32x4 fa = {__uint_as_float(a.x << 16), __uint_as_float(a.x & 0xffff0000u), __uint_as_float(a.y << 16), __uint_as_float(a.y & 0xffff0000u)};
                const f32x4 fc = {__uint_as_float(c.x << 16), __uint_as_float(c.x & 0xffff0000u), __uint_as_float(c.y << 16), __uint_as_float(c.y & 0xffff0000u)};
                v[q][j] = x * ALPHA + (fa * g0 + fc * g1);
                s[q] += (v[q][j][0] + v[q][j][1]) + (v[q][j][2] + v[q][j][3]); }
        }
#pragma unroll
        for (int q = 0; q < 2; ++q) {
            if (rows[q] >= T) continue;
            const int row = rows[q];
            const float mean = wave_sum(s[q]) * (1.f / D);
            float qq = 0.f;
#pragma unroll
            for (int j = 0; j < 4; ++j) { v[q][j] = v[q][j] - mean; qq += (v[q][j][0] * v[q][j][0] + v[q][j][1] * v[q][j][1]) + (v[q][j][2] * v[q][j][2] + v[q][j][3] * v[q][j][3]); }
            const float rstd = 1.f / sqrtf(wave_sum(qq) * (1.f / D) + LN_EPS);
#pragma unroll
            for (int j = 0; j < 4; ++j) { const f32x4 gg = ((const f32x4*)g)[lane + 64 * j], bb = ((const f32x4*)b)[lane + 64 * j];
                const f32x4 y = v[q][j] * rstd * gg + bb;
                if (layer == 0) ((v2u*)(XB + (size_t)row * D))[lane + 64 * j] = (v2u){pk2(y[0], y[1]), pk2(y[2], y[3])};
                else ((f32x4*)(Xo + (size_t)row * D))[lane + 64 * j] = y; }
        }
    }
}
constexpr int ATT_KSTR = 144;
constexpr int ATT_VSTR = 528;
constexpr int ATT_K_OFF = 0, ATT_V_OFF = 256 * ATT_KSTR;
template <int VAR = 0> __device__ __forceinline__ void phase_attn(LAS unsigned char* lds, const int tid_in, int bid, int G) {
    const Params P = kparams();
    unsigned char* ws = P.ws;
    const bf16_t* QKV = (const bf16_t*)(ws + WS_M + M_QKV); bf16_t* O = (bf16_t*)(ws + WS_M + M_O);
    const float* sinks = P.in[11];
    int tid = tid_in; asm volatile("" : "+v"(tid));
    const int lane = tid & 63, w = __builtin_amdgcn_readfirstlane(tid >> 6), fr = lane & 15, fq = lane >> 4;
    const int g = w >> 1, qh = w & 1;
    const int vcu = (G % 8 == 0) ? (bid % 8) * (G / 8) + bid / 8 : bid;
    LAS unsigned char* Kl = lds + ATT_K_OFF; LAS unsigned char* Vl = lds + ATT_V_OFF;
    const float L2E = 1.4426950408889634f;
    v4u kvr[4], vvr[4];
#pragma unroll
    for (int it = 0; it < 4; ++it) { kvr[it] = (v4u){0u, 0u, 0u, 0u}; vvr[it] = (v4u){0u, 0u, 0u, 0u}; }
    for (int L = vcu * 4; L < BATCH * 4 * 16; L += G * 4) {
      for (int u4 = 0; u4 < 4; ++u4) {
        const int unit = L + u4; if (unit >= BATCH * 4 * 16) break;
        const int nb = unit & 15, kvh = (unit >> 4) & 3, b = unit >> 6;
        const int h = kvh * 4 + g;
        const float slope2 = __builtin_amdgcn_exp2f(-0.5f * (float)(h + 1)) * L2E, sink2 = sinks[h] * L2E;
        const long rowbase = (long)b * SEQ + nb * 128 - 128;
        if (u4 == 0) {
#pragma unroll
            for (int it = 0; it < 4; ++it) {
                const int c = tid + it * NTHREADS, sj = c >> 3, ch = c & 7;
                kvr[it] = (v4u){0u, 0u, 0u, 0u}; vvr[it] = (v4u){0u, 0u, 0u, 0u};
                if (!(VAR & 1) && (nb > 0 || sj >= 128)) { const bf16_t* rp = QKV + (size_t)(rowbase + sj) * QKVD + kvh * 64 + ch * 8; kvr[it] = *(const v4u*)(rp + 1024); vvr[it] = *(const v4u*)(rp + 1280); }
            }
        }
        __syncthreads();
#pragma unroll
        for (int it = 0; it < 4; ++it) {
            const int c = tid + it * NTHREADS, sj = c >> 3, ch = c & 7;
            *(LAS v4u*)(Kl + sj * ATT_KSTR + ch * 16) = kvr[it];
            LAS bf16_t* vt = (LAS bf16_t*)(Vl + (ch * 8) * ATT_VSTR) + (sj ^ (ch << 2));
            const v4u vv = vvr[it];
#pragma unroll
            for (int e = 0; e < 8; ++e) vt[e * (ATT_VSTR / 2)] = (bf16_t)(vv[e >> 1] >> (16 * (e & 1)));
        }
        __syncthreads();
        if (u4 < 3 && unit + 1 < BATCH * 4 * 16) {
            const long rb2 = rowbase + 128;
#pragma unroll
            for (int it = 0; it < 4; ++it) {
                const int c = tid + it * NTHREADS, sj = c >> 3, ch = c & 7;
                const bf16_t* rp = QKV + (size_t)(rb2 + sj) * QKVD + kvh * 64 + ch * 8;
                if (!(VAR & 1)) { kvr[it] = *(const v4u*)(rp + 1024); vvr[it] = *(const v4u*)(rp + 1280); }
            }
        }
#pragma unroll 1
        for (int it = 0; it < 2; ++it) {
            const int kb = 4 * qh + 2 * it;
            const int qrow0 = 64 * qh + 32 * it;
            bf16x8 qf[2][2];
#pragma unroll
            for (int qt = 0; qt < 2; ++qt)
#pragma unroll
                for (int ds = 0; ds < 2; ++ds)
                    qf[qt][ds] = *(const bf16x8*)(QKV + (size_t)(rowbase + 128 + qrow0 + 16 * qt + fr) * QKVD + h * 64 + 32 * ds + 8 * fq);
            f32x4 acc[2][9];
#pragma unroll
            for (int qt = 0; qt < 2; ++qt)
#pragma unroll
                for (int i = 0; i < 9; ++i) acc[qt][i] = (f32x4){0.f, 0.f, 0.f, 0.f};
#pragma unroll
            for (int u = 0; u < 10; ++u)
#pragma unroll
                for (int ds = 0; ds < 2; ++ds) {
                    const bf16x8 kf = *(const LAS bf16x8*)(Kl + (16 * (kb + u) + fr) * ATT_KSTR + ds * 64 + fq * 16);
                    if (u <= 8) acc[0][u] = __builtin_amdgcn_mfma_f32_16x16x32_bf16(kf, qf[0][ds], acc[0][u], 0, 0, 0);
                    if (u >= 1) acc[1][u - 1] = __builtin_amdgcn_mfma_f32_16x16x32_bf16(kf, qf[1][ds], acc[1][u - 1], 0, 0, 0);
                }
#pragma unroll
            for (int qt = 0; qt < 2; ++qt) {
                const int kt0 = kb + qt;
                const int q = qrow0 + 16 * qt + fr;
                float m = -INFINITY;
                const float abias = -slope2 * (float)(fr - 4 * fq);
#pragma unroll
                for (int i = 0; i < 9; ++i)
#pragma unroll
                    for (int r = 0; r < 4; ++r) {
                        const int e = 4 * fq + r;
                        bool ok = (i == 0) ? (e > fr) : (i == 8) ? (e <= fr) : true;
                        if (nb == 0) ok = ok && (kt0 + i >= 8);
                        const float s = (VAR & 2) ? acc[qt][i][r] : (ok ? acc[qt][i][r] + __builtin_fmaf(slope2, (float)(r - 16 * (8 - i)), abias) : -INFINITY);
                        acc[qt][i][r] = s; m = fmaxf(m, s);
                    }
                m = fmaxf(m, __shfl_xor(m, 16)); m = fmaxf(m, __shfl_xor(m, 32));
                m = fmaxf(m, sink2);
                float l = 0.f;
                unsigned pk[10][2];
#pragma unroll
                for (int i = 0; i < 9; ++i) {
                    float p[4];
#pragma unroll
                    for (int r = 0; r < 4; ++r) { p[r] = (VAR & 2) ? acc[qt][i][r] : __builtin_amdgcn_exp2f(acc[qt][i][r] - m); l += p[r]; }
                    pk[i][0] = pg8::cvt_pk_bf16(p[0], p[1]); pk[i][1] = pg8::cvt_pk_bf16(p[2], p[3]);
                }
                pk[9][0] = 0u; pk[9][1] = 0u;
                l += __shfl_xor(l, 16); l += __shfl_xor(l, 32);
                l += __builtin_amdgcn_exp2f(sink2 - m);
                const float rl = 1.f / l;
                f32x4 oacc[4];
#pragma unroll
                for (int dt = 0; dt < 4; ++dt) oacc[dt] = (f32x4){0.f, 0.f, 0.f, 0.f};
#pragma unroll
                for (int c = 0; c < 5; ++c) {
                    const int i0 = 2 * c, i1 = (c < 4) ? 2 * c + 1 : 7;
                    const bf16x8 pf = __builtin_bit_cast(bf16x8, (v4u){pk[i0][0], pk[i0][1], pk[2 * c + 1][0], pk[2 * c + 1][1]});
#pragma unroll
                    for (int dt = 0; dt < 4; ++dt) {
                        const LAS unsigned char* vr = Vl + (16 * dt + fr) * ATT_VSTR;
                        const int vsw = (((16 * dt + fr) >> 3) & 7) << 3;
                        const v2u a0 = *(const LAS v2u*)(vr + ((32 * (kt0 + i0) + 8 * fq) ^ vsw)), a1 = *(const LAS v2u*)(vr + ((32 * (kt0 + i1) + 8 * fq) ^ vsw));
                        const bf16x8 vf = __builtin_bit_cast(bf16x8, (v4u){a0.x, a0.y, a1.x, a1.y});
                        oacc[dt] = __builtin_amdgcn_mfma_f32_16x16x32_bf16(vf, pf, oacc[dt], 0, 0, 0);
                    }
                }
                bf16_t* orow = O + (size_t)(rowbase + 128 + q) * D + h * 64 + 4 * fq;
#pragma unroll
                for (int dt = 0; dt < 4; ++dt) st8_wt(orow + 16 * dt, (v2u){pg8::cvt_pk_bf16(oacc[dt][0] * rl, oacc[dt][1] * rl), pg8::cvt_pk_bf16(oacc[dt][2] * rl, oacc[dt][3] * rl)});
            }
        }
      }
    }
}
constexpr int RG_GF_OFF = 0;
constexpr int RG_C_OFF = 25600;
constexpr int RG_TOT_OFF = 25600 + 2560;
constexpr int RG_RS = 176;
constexpr int RG_X_OFF = 35840, RG_XB = 131 * RG_RS + 48;
constexpr int RG_G_OFF = RG_X_OFF + 2 * RG_XB, RG_GB = 128 * RG_RS;
constexpr int RG_Y_OFF = RG_G_OFF + 2 * RG_GB;
static_assert(RG_Y_OFF + RG_GB <= 163840 - 16, "RG-LRU LDS map");
__device__ __forceinline__ float fast_sigmoid(float x) { return __builtin_amdgcn_rcpf(1.f + __builtin_amdgcn_exp2f(-1.4426950408889634f * x)); }
template <int VAR = 0> __device__ __forceinline__ void phase_rglru(LAS unsigned char* lds, const int tid_in, int bid, int G, bool dry = false) {
    const Params P = kparams();
    unsigned char* ws = P.ws;
    const bf16_t* Gt = (const bf16_t*)(ws + WS_M + M_G); bf16_t* Yo = dry ? (bf16_t*)P.out : (bf16_t*)(ws + WS_M + M_G); const bf16_t* XR = (const bf16_t*)(ws + WS_M + M_XR);
    int tid = tid_in; asm volatile("" : "+v"(tid));
    const int lane = tid & 63, w = __builtin_amdgcn_readfirstlane(tid >> 6), fr = lane & 15, fq = lane >> 4;
    LAS v2u* gfl = (LAS v2u*)(lds + RG_GF_OFF);
    LAS float* cst = (LAS float*)(lds + RG_C_OFF);
    LAS float* tot = (LAS float*)(lds + RG_TOT_OFF);
    LAS float* hinb = (LAS float*)(lds + RG_TOT_OFF + 5120);
    const int vcu = (G % 8 == 0) ? (bid % 8) * (G / 8) + bid / 8 : bid;
    int xro[3], gro[3];
    unsigned xgo[3];
#pragma unroll
    for (int i = 0; i < 3; ++i) { const int idx = tid + i * NTHREADS, rw = idx / 10, ch = idx % 10;
        xro[i] = (idx < 1310) ? rw * RG_RS + ch * 16 : -1; gro[i] = (idx < 1280) ? rw * RG_RS + ch * 16 : -1; xgo[i] = (unsigned)(rw * DR + ch * 8); }
    for (int unit = vcu; unit < BATCH * 16; unit += G) {
        const int b = unit >> 4, n = unit & 15;
        const bf16_t* xbase = XR + ((size_t)b * SEQ) * DR + n * 80; const bf16_t* gbase = Gt + ((size_t)b * SEQ) * DR + n * 80; bf16_t* ybase = Yo + ((size_t)b * SEQ) * DR + n * 80;
#define RG_FETCH(rr) do { _Pragma("unroll") for (int i = 0; i < 3; ++i) { xs[i] = (v4u){0u, 0u, 0u, 0u}; gs[i] = (v4u){0u, 0u, 0u, 0u}; \
            if (xro[i] >= 0 && ((rr) > 0 || xro[i] >= 3 * RG_RS)) xs[i] = *(const v4u*)(xbase + (long)(128 * (rr) - 3) * DR + xgo[i]); \
            if (gro[i] >= 0) gs[i] = *(const v4u*)(gbase + (size_t)(128 * (rr)) * DR + xgo[i]); } } while (0)
#define RG_STASH(bufi) do { _Pragma("unroll") for (int i = 0; i < 3; ++i) { \
            if (xro[i] >= 0) *(LAS v4u*)(lds + RG_X_OFF + (bufi) * RG_XB + xro[i]) = xs[i]; \
            if (gro[i] >= 0) *(LAS v4u*)(lds + RG_G_OFF + (bufi) * RG_GB + gro[i]) = gs[i]; } } while (0)
#define RG_YSTORE(rr) do { _Pragma("unroll") for (int i = 0; i < 3; ++i) { if (gro[i] >= 0) \
            st16_wt(ybase + (size_t)(128 * (rr)) * DR + xgo[i], *(const LAS v4u*)(lds + RG_Y_OFF + gro[i])); } } while (0)
        v4u xs[3], gs[3];
        __syncthreads();
        RG_FETCH(0);
        { const v2u* GF = (const v2u*)(ws + WS_GF);
          for (int i = tid; i < 2 * 1600; i += NTHREADS) { const int mat = i / 1600, rem = i % 1600; gfl[i] = GF[(size_t)(mat * 16 + n) * 1600 + rem]; }
          if (tid < 80) { const int c = n * 80 + tid;
              cst[0 * 80 + tid] = P.in[2][0 * DR + c]; cst[1 * 80 + tid] = P.in[2][1 * DR + c]; cst[2 * 80 + tid] = P.in[2][2 * DR + c]; cst[3 * 80 + tid] = P.in[2][3 * DR + c];
              cst[4 * 80 + tid] = P.in[3][c]; cst[5 * 80 + tid] = P.in[5][c]; cst[6 * 80 + tid] = P.in[7][c];
              cst[7 * 80 + tid] = -8.0f * log1pf(expf(-P.in[8][c])) * 1.4426950408889634f; } }
        RG_STASH(0);
        __syncthreads();
        float hcar = 0.f;
#pragma unroll 1
        for (int r = 0; r < SEQ / 128; ++r) {
            const LAS unsigned char* xb = lds + RG_X_OFF + (r & 1) * RG_XB + (16 * w + fr) * RG_RS + 8 * fq;
            const LAS unsigned char* gb = lds + RG_G_OFF + (r & 1) * RG_GB + (16 * w + fr) * RG_RS + 8 * fq;
            if (!(VAR & 2)) { if (r + 1 < SEQ / 128) RG_FETCH(r + 1); }
            float xc[5][4]; s16x4 bfr[5];
#pragma unroll
            for (int ks = 0; ks < 5; ++ks) {
                const int c0 = 16 * ks + 4 * fq;
                f32x4 s = *(LAS f32x4*)(cst + 4 * 80 + c0);
#pragma unroll
                for (int k = 0; k < 4; ++k) { const f32x4 wv = *(LAS f32x4*)(cst + k * 80 + c0); const v2u x = *(const LAS v2u*)(xb + k * RG_RS + 32 * ks);
                    s[0] += __uint_as_float(x.x << 16) * wv[0]; s[1] += __uint_as_float(x.x & 0xffff0000u) * wv[1]; s[2] += __uint_as_float(x.y << 16) * wv[2]; s[3] += __uint_as_float(x.y & 0xffff0000u) * wv[3]; }
#pragma unroll
                for (int j = 0; j < 4; ++j) xc[ks][j] = s[j];
                bfr[ks] = __builtin_bit_cast(s16x4, (v2u){pg8::cvt_pk_bf16(s[0], s[1]), pg8::cvt_pk_bf16(s[2], s[3])});
            }
            f32x4 ra[5], ia[5];
#pragma unroll
            for (int jt = 0; jt < 5; ++jt) { ra[jt] = (f32x4){0.f, 0.f, 0.f, 0.f}; ia[jt] = (f32x4){0.f, 0.f, 0.f, 0.f};
#pragma unroll
                for (int ks = 0; ks < 5; ++ks) {
                    const s16x4 ar = __builtin_bit_cast(s16x4, gfl[(jt * 5 + ks) * 64 + lane]), ai = __builtin_bit_cast(s16x4, gfl[1600 + (jt * 5 + ks) * 64 + lane]);
                    ra[jt] = __builtin_amdgcn_mfma_f32_16x16x16bf16_1k(ar, bfr[ks], ra[jt], 0, 0, 0);
                    ia[jt] = __builtin_amdgcn_mfma_f32_16x16x16bf16_1k(ai, bfr[ks], ia[jt], 0, 0, 0);
                } }
            float A[5][4], U[5][4];
#pragma unroll
            for (int jt = 0; jt < 5; ++jt) {
                const int c0 = 16 * jt + 4 * fq;
                const f32x4 brv = *(LAS f32x4*)(cst + 5 * 80 + c0), biv = *(LAS f32x4*)(cst + 6 * 80 + c0), cav = *(LAS f32x4*)(cst + 7 * 80 + c0);
#pragma unroll
                for (int j = 0; j < 4; ++j) {
                    const float rg = fast_sigmoid(ra[jt][j] + brv[j]), ig = fast_sigmoid(ia[jt][j] + biv[j]);
                    const float la2 = rg * cav[j];
                    float a = __builtin_amdgcn_exp2f(la2);
                    float u = __builtin_amdgcn_sqrtf(fmaxf(1.f - a * a, 0.f)) * (ig * xc[jt][j]);
                    A[jt][j] = a; U[jt][j] = u;
                }
#define RG_SCAN4(S) asm volatile("s_nop 1\n\t" \
                    "v_fmac_f32_dpp %0, %0, %4 row_shr:" #S " row_mask:0xf bank_mask:0xf\n\tv_fmac_f32_dpp %1, %1, %5 row_shr:" #S " row_mask:0xf bank_mask:0xf\n\t" \
                    "v_fmac_f32_dpp %2, %2, %6 row_shr:" #S " row_mask:0xf bank_mask:0xf\n\tv_fmac_f32_dpp %3, %3, %7 row_shr:" #S " row_mask:0xf bank_mask:0xf\n\t" \
                    "v_mul_f32_dpp %4, %4, %4 row_shr:" #S " row_mask:0xf bank_mask:0xf\n\tv_mul_f32_dpp %5, %5, %5 row_shr:" #S " row_mask:0xf bank_mask:0xf\n\t" \
                    "v_mul_f32_dpp %6, %6, %6 row_shr:" #S " row_mask:0xf bank_mask:0xf\n\tv_mul_f32_dpp %7, %7, %7 row_shr:" #S " row_mask:0xf bank_mask:0xf" \
                    : "+v"(U[jt][0]), "+v"(U[jt][1]), "+v"(U[jt][2]), "+v"(U[jt][3]), "+v"(A[jt][0]), "+v"(A[jt][1]), "+v"(A[jt][2]), "+v"(A[jt][3]))
                RG_SCAN4(1); RG_SCAN4(2); RG_SCAN4(4); RG_SCAN4(8);
#undef RG_SCAN4
            }
            if (fr == 15) {
#pragma unroll
                for (int jt = 0; jt < 5; ++jt)
#pragma unroll
                    for (int j = 0; j < 4; j += 2) *(LAS f32x4*)(tot + w * 160 + (16 * jt + 4 * fq + j) * 2) = (f32x4){A[jt][j], U[jt][j], A[jt][j + 1], U[jt][j + 1]};
            }
            if (!(VAR & 1)) __syncthreads();
            if (tid < 80) {
#pragma unroll
                for (int ww = 0; ww < 8; ++ww) { const f32x2v q = *(LAS f32x2v*)(tot + ww * 160 + tid * 2); hinb[ww * 80 + tid] = hcar; hcar = q.x * hcar + q.y; }
            }
            if (r > 0) RG_YSTORE(r - 1);
            if (!(VAR & 2)) { if (r + 1 < SEQ / 128) RG_STASH((r + 1) & 1); }
            if (!(VAR & 1)) __syncthreads();
#pragma unroll
            for (int jt = 0; jt < 5; ++jt) {
                const f32x4 hq = *(LAS f32x4*)(hinb + w * 80 + 16 * jt + 4 * fq);
                const v2u gv = *(const LAS v2u*)(gb + 32 * jt);
                float y[4];
#pragma unroll
                for (int j = 0; j < 4; ++j) {
                    const float h = A[jt][j] * hq[j] + U[jt][j];
                    const unsigned gw = (j < 2) ? gv.x : gv.y;
                    const float gt = (j & 1) ? __uint_as_float(gw & 0xffff0000u) : __uint_as_float(gw << 16);
                    const float uu = 0.7978845608028654f * (gt + 0.044715f * gt * gt * gt);
                    y[j] = h * gt * __builtin_amdgcn_rcpf(1.f + __builtin_amdgcn_exp2f(-2.885390081777927f * uu));
                }
                *(LAS v2u*)(lds + RG_Y_OFF + (16 * w + fr) * RG_RS + 8 * fq + 32 * jt) = (v2u){pg8::cvt_pk_bf16(y[0], y[1]), pg8::cvt_pk_bf16(y[2], y[3])};
            }
        }
        __syncthreads();
        RG_YSTORE(SEQ / 128 - 1);
#undef RG_FETCH
#undef RG_STASH
#undef RG_YSTORE
    }
}
#ifndef PROBE_MASK
#define PROBE_MASK 0
#endif
#ifndef PROBE_VAR
#define PROBE_VAR 0
#endif
#ifndef PROBE_PFX_NULL
#define PROBE_PFX_NULL 0
#endif
#ifndef PROBE_DRY
#define PROBE_DRY 0
#endif
struct Args { Params P; int ph_lo, ph_hi; };
__device__ __forceinline__ int lane_id_now() { int l; asm volatile("v_mbcnt_lo_u32_b32 %0, -1, 0\n\tv_mbcnt_hi_u32_b32 %0, -1, %0" : "=v"(l)); return l; }
__global__ void __launch_bounds__(NTHREADS, 2) mk_fwd(Args a) {
    extern __shared__ __attribute__((aligned(16))) unsigned char lds_raw[];
    LAS unsigned char* lds = (LAS unsigned char*)lds_raw;
    const int wv = __builtin_amdgcn_readfirstlane(threadIdx.x >> 6);
#define MYTID(wvv) ((wvv) * 64 + lane_id_now())
    volatile LAS unsigned* bst = (volatile LAS unsigned*)(lds + LDS_BYTES - 16);
    { const int t0 = MYTID(wv); if (t0 < 4) bst[t0] = 0u;
      __syncthreads();
      const Params P0 = kparams(); (void)xcd_barrier_post((unsigned*)(P0.ws + WS_BAR), bst, t0); }
#define SEAM(ph) do { if (hi > PH_COUNT) cg::this_grid().sync();   { const Params Pb = kparams(); XcdBarrier xb; xb.bar = (unsigned*)(Pb.ws + WS_BAR); xb.x = xb_xcc_id(); xb.st = bst; xcd_barrier(xb, tid_in); } } while (0)
#define RUN(ph, call) do { if (lo <= (ph) && (ph) < hi) { int bid = blockIdx.x, G = gridDim.x, wvl = wv; asm volatile("" : "+s"(bid), "+s"(G), "+s"(wvl)); const int tid_in = MYTID(wvl); \
        call; if ((PROBE_MASK >> (ph)) & 1) { call; } if ((ph) + 1 < hi && (ph) != PH_UP0 && (ph) != PH_UP1) SEAM(ph); } } while (0)
#define PHASE_PROGRAM \
    RUN(PH_PROLOGUE, phase_prologue(lds, tid_in, bid, G)); \
    RUN(PH_WIN, { if (pfx && PROBE_PFX_NULL) phase_gemm_win_null(lds, tid_in, bid, G); else phase_gemm_win(lds, tid_in, bid, G); }); \
    if ((PROBE_DRY >> PH_RGLRU) & 1) { int bid = blockIdx.x, G = gridDim.x; asm volatile("" : "+s"(bid), "+s"(G)); phase_rglru<PROBE_VAR>(lds, MYTID(wv), bid, G, true); } \
    RUN(PH_RGLRU, phase_rglru(lds, tid_in, bid, G)); \
    RUN(PH_WOUT, phase_gemm_wout(lds, tid_in, bid, G)); \
    RUN(PH_LN0, phase_ln(0, lds, tid_in, bid, G)); \
    RUN(PH_ROUTE0, phase_route(lds, tid_in, bid, G)); \
    RUN(PH_UP0, phase_moe_up(0, lds, tid_in, bid, G)); \
    RUN(PH_DOWN0, phase_moe_down(0, lds, tid_in, bid, G)); \
    RUN(PH_COMB0, phase_combine(0, tid_in, bid, G)); \
    RUN(PH_QKV, phase_gemm_qkv(lds, tid_in, bid, G)); \
    if ((PROBE_DRY >> PH_ATTN) & 1) { int bid = blockIdx.x, G = gridDim.x; asm volatile("" : "+s"(bid), "+s"(G)); phase_attn<PROBE_VAR>(lds, MYTID(wv), bid, G); } \
    RUN(PH_ATTN, phase_attn(lds, tid_in, bid, G)); \
    RUN(PH_WO, phase_gemm_wo(lds, tid_in, bid, G)); \
    RUN(PH_LN1, phase_ln(1, lds, tid_in, bid, G)); \
    RUN(PH_ROUTE1, phase_route(lds, tid_in, bid, G)); \
    RUN(PH_UP1, phase_moe_up(1, lds, tid_in, bid, G)); \
    RUN(PH_DOWN1, phase_moe_down(1, lds, tid_in, bid, G)); \
    RUN(PH_COMB1, phase_combine(1, tid_in, bid, G));
#ifdef PROBE_PREFIX
    { const int lo = 0, hi = PROBE_PREFIX; const bool pfx = true; PHASE_PROGRAM { const int tid_in = MYTID(wv); SEAM(0); } }
#endif
    { const int lo = a.ph_lo, hi = a.ph_hi; const bool pfx = false; PHASE_PROGRAM }
#ifdef PROBE_XBAR
    { const int hi = a.ph_hi; const int tid_in = MYTID(wv); for (int i = 0; i < PROBE_XBAR; ++i) SEAM(PH_COUNT - 1); }
#endif
#undef RUN
#undef SEAM
#undef MYTID
}
static int g_grid = 0;
extern "C" void kernel_launch(void* const* d_in, const int* in_sizes, int n_in, void* d_out, int out_size, void* d_ws, size_t ws_size, hipStream_t stream) {
    if (ws_size < WS_END || n_in < 22) { fprintf(stderr, "kernel_launch: workspace too small (%zu < %zu) or %d inputs\n", ws_size, (size_t)WS_END, n_in); return; }
    if (g_grid == 0) {
        int dev = 0, cus = 0, per_cu = 0;
        (void)hipGetDevice(&dev); (void)hipDeviceGetAttribute(&cus, hipDeviceAttributeMultiprocessorCount, dev);
        if (hipFuncSetAttribute((const void*)mk_fwd, hipFuncAttributeMaxDynamicSharedMemorySize, LDS_BYTES) != hipSuccess) fprintf(stderr, "kernel_launch: hipFuncSetAttribute failed\n");
        if (hipOccupancyMaxActiveBlocksPerMultiprocessor(&per_cu, (const void*)mk_fwd, NTHREADS, LDS_BYTES) != hipSuccess || per_cu < 1) { fprintf(stderr, "kernel_launch: occupancy query says %d blocks per CU\n", per_cu); per_cu = 1; }
        (void)hipGetLastError();
        g_grid = cus;
    }
    (void)hipMemsetAsync((unsigned char*)d_ws + WS_READY, 0, WS_BAR + 16384 - WS_READY, stream);
    Args a{};
    for (int i = 0; i < 22; ++i) a.P.in[i] = (const float*)d_in[i];
    a.P.out = (float*)d_out; a.P.ws = (unsigned char*)d_ws;
    a.ph_lo = 0; a.ph_hi = PH_COUNT;
    void* args[] = {&a};
    hipError_t e = hipLaunchCooperativeKernel((const void*)mk_fwd, dim3(g_grid), dim3(NTHREADS), args, LDS_BYTES, stream);
    if (e != hipSuccess) fprintf(stderr, "kernel_launch: cooperative launch failed: %s (grid %d)\n", hipGetErrorString(e), g_grid);
}
```

```cpp
#include <hip/hip_runtime.h>
#include <stdint.h>
#include <cstdio>
#include <hip/hip_cooperative_groups.h>
namespace cg = cooperative_groups;

typedef unsigned short bf16_t;
constexpr int D = 1024, BATCH = 16, SEQ = 2048, T = BATCH * SEQ;
constexpr int DR = 1280, BW = 80;
constexpr int NH = 16, HD = 64, WIN = 128;
constexpr int QKVD = 1536;
constexpr int NE = 32, DE = 512;
constexpr int MB = 256;
constexpr int TK = T * 2;
constexpr int NROWS_MAX = TK + NE * MB;
constexpr float ALPHA = 1.41421356237309515f;
constexpr float LN_EPS = 1e-5f;
constexpr float QSCALE = 0.125f * 1.4426950408889634f;

constexpr size_t MiB = 1u << 20;
constexpr size_t WS_CTL = 0;
constexpr size_t WS_READY = 256 * 1024, READY_BANK = 128 * 1024;
constexpr size_t WS_BAR = 512 * 1024;
constexpr size_t WS_WIN = 1 * MiB, WS_WOUT = 6 * MiB, WS_WQKV = 8 * MiB + 512 * 1024, WS_WO = 11 * MiB + 512 * 1024, WS_GF = 13 * MiB + 512 * 1024;
constexpr size_t WS_ROUTE = 14 * MiB;
constexpr size_t WS_W13 = 16 * MiB, WS_W2 = 144 * MiB, WS_XB = 208 * MiB, WS_M = 272 * MiB, WS_END = 488 * MiB;
constexpr size_t M_G = 0, M_XR = 80 * MiB, M_TMP = 160 * MiB;
constexpr size_t M_QKV = 0, M_O = 96 * MiB;
constexpr size_t M_HDN = 0, M_YS = 72 * MiB;

__device__ __forceinline__ float bf2f(bf16_t v) { return __uint_as_float((unsigned)v << 16); }
__device__ __forceinline__ bf16_t f2bf(float f) { unsigned u = __float_as_uint(f); return (bf16_t)((u + 0x7fffu + ((u >> 16) & 1u)) >> 16); }


#ifndef WT_STORES
#define WT_STORES 0
#endif
typedef unsigned wt_v4u __attribute__((ext_vector_type(4)));
typedef unsigned wt_v2u __attribute__((ext_vector_type(2)));
__device__ __forceinline__ void st16_wt(void* p, wt_v4u v) {
#if WT_STORES
    asm volatile("global_store_dwordx4 %0, %1, off sc1\n\ts_nop 1" :: "v"(p), "v"(v) : "memory");
#else
    *(wt_v4u*)p = v;
#endif
}
__device__ __forceinline__ void st8_wt(void* p, wt_v2u v) {
#if WT_STORES
    asm volatile("global_store_dwordx2 %0, %1, off sc1\n\ts_nop 0" :: "v"(p), "v"(v) : "memory");
#else
    *(wt_v2u*)p = v;
#endif
}

#ifndef WT_GEMM
#define WT_GEMM 0
#endif
__device__ __forceinline__ void st16_gemm(void* p, wt_v4u v) {
#if WT_GEMM == 1
    asm volatile("global_store_dwordx4 %0, %1, off sc1\n\ts_nop 1" :: "v"(p), "v"(v) : "memory");
#elif WT_GEMM == 2
    asm volatile("global_store_dwordx4 %0, %1, off nt\n\ts_nop 1" :: "v"(p), "v"(v) : "memory");
#elif WT_GEMM == 3
    asm volatile("global_store_dwordx4 %0, %1, off sc0 sc1\n\ts_nop 1" :: "v"(p), "v"(v) : "memory");
#else
    *(wt_v4u*)p = v;
#endif
}

#ifndef NT_STREAMS
#define NT_STREAMS 1
#endif
#if NT_STREAMS
#define NT_LOAD(p) __builtin_nontemporal_load(p)
#else
#define NT_LOAD(p) (*(p))
#endif
#ifndef NT_RECENT
#define NT_RECENT 0
#endif
#if NT_RECENT
#define NT_LOAD_R(p) __builtin_nontemporal_load(p)
#else
#define NT_LOAD_R(p) (*(p))
#endif

#ifndef NT_SEL
#define NT_SEL 1
#endif
#define NT_LOAD_S(bit, p) (((NT_SEL >> (bit)) & 1) ? __builtin_nontemporal_load(p) : *(p))
#ifndef PG8_STAGGER_TICKS
#define PG8_STAGGER_TICKS 0
#endif
#ifndef PG8_CHUNKED
#define PG8_CHUNKED 0
#endif
#ifndef PG8_MOE_AUX_B
#define PG8_MOE_AUX_B 0
#endif
#ifndef PG8_DOWN_AUX
#define PG8_DOWN_AUX 16
#endif
#ifndef PG8_ROWMAJOR
#define PG8_ROWMAJOR 0
#endif
#ifndef PG8_XCDREMAP
#define PG8_XCDREMAP 1
#endif
#ifndef PG8_WGM
#define PG8_WGM 2
#endif
namespace pg8 {
#define PG8_LAS __attribute__((address_space(3)))
typedef short bf16x8 __attribute__((ext_vector_type(8)));
typedef float f32x4 __attribute__((ext_vector_type(4)));
typedef unsigned u32x4 __attribute__((ext_vector_type(4)));
typedef unsigned u32x2 __attribute__((ext_vector_type(2)));
constexpr int BM = 256, BK = 64, HALF = 128, HTB = HALF * BK * 2  , STAGE_BYTES = 8 * HTB, NXCD = 8, WGM = PG8_WGM;

__host__ __device__ __forceinline__ int lds_byte(int r, int c) { const int st = (r >> 4) * 2 + (c >> 5), rr = r & 15, cc = c & 31, ob = rr * 64 + cc * 2; return st * 1024 + (ob ^ (((ob >> 9) & 1) << 5)); }
__host__ __device__ __forceinline__ void stage_rc(int b, int& R, int& C) { const int st = b / 1024, sb = b % 1024, swz = sb ^ (((sb >> 9) & 1) << 5); R = (st >> 1) * 16 + swz / 64; C = (st & 1) * 32 + (swz % 64) / 2; }
__host__ __device__ __forceinline__ int perm32(int rho) { const int n = rho >> 4, i = rho & 15; return 8 * (i >> 2) + 4 * n + (i & 3); }

struct Unit { int pm, pn, li; };

template <int WGM_> __device__ __forceinline__ bool order_at(long L, int nM, int nN, Unit& u) {
    constexpr int WGM = WGM_;
    const int nwg = nM * nN; if (L >= nwg) return false;
    int wgid = (int)L; if (PG8_XCDREMAP) { const int q = nwg / NXCD, r = nwg % NXCD, xcd = wgid % NXCD, off = wgid / NXCD; wgid = (xcd < r ? xcd * (q + 1) : r * (q + 1) + (xcd - r) * q) + off; }
    const int nig = WGM * nN, gid = wgid / nig, fm = gid * WGM, gsz = (nM - fm) < WGM ? (nM - fm) : WGM;
    if (PG8_ROWMAJOR) { u.pm = fm + ((wgid % nig) / nN); u.pn = (wgid % nig) % nN; if (u.pm >= fm + gsz) { const int idx = wgid % nig; u.pm = fm + idx % gsz; u.pn = idx / gsz; } }
    else { u.pm = fm + ((wgid % nig) % gsz); u.pn = (wgid % nig) / gsz; }
    return true;
}
template <int WGM_> __device__ __forceinline__ bool order_next(int i, int G, int c, int nM, int nN, Unit& u) {
#if PG8_CHUNKED
    const int nwg = nM * nN, per = (nwg + G - 1) / G; if (i >= per) return false; return order_at<WGM_>((long)c * per + i, nM, nN, u);
#else
    return order_at<WGM_>((long)i * G + c, nM, nN, u);
#endif
}
template <int K_, int NN_, bool GATHER, bool EXPERT, int DEP = 0, int WGM_ = PG8_WGM>
struct Order {
    static constexpr int K = K_, nN = NN_, AUX_A = (DEP == 2) ? PG8_DOWN_AUX : 0, AUX_B = EXPERT ? PG8_MOE_AUX_B : 0;
    int nM, G, c; const char* A; const char* Bt; const int* block_e; const int* rowtok; unsigned* ready; unsigned need; const PG8_LAS int* tokl;
    __device__ __forceinline__ bool next(int i, Unit& u) const { return order_next<WGM_>(i, G, c, nM, nN, u); }
    __device__ __forceinline__ const char* a_base(const Unit& u) const { return GATHER ? A : A + (size_t)u.pm * BM * K * 2; }
    __device__ __forceinline__ const char* b_base(const Unit& u) const { return Bt + (EXPERT ? (size_t)block_e[u.pm] * (size_t)(nN * BM) * K * 2 : (size_t)0) + (size_t)u.pn * BM * K * 2; }
    __device__ __forceinline__ unsigned a_rowoff(const Unit& u, int r) const {
        if (GATHER) return (unsigned)tokl[u.li * BM + r] * (unsigned)(K * 2);
        return (unsigned)(r * K * 2);
    }
    __device__ __forceinline__ void fill_tokl(PG8_LAS int* dst, int tid) const {
        Unit u;
        for (int i = 0; next(i, u); ++i) if (tid < BM) { const int s = rowtok[u.pm * BM + tid]; dst[i * BM + tid] = s >= 0 ? (s >> 1) : 0; }
    }
    __device__ __forceinline__ void a_ready(const Unit& u, int tid) const {
        if (DEP == 2) {
            if (tid < 64) { unsigned spins = 0;
                while ((unsigned)__builtin_amdgcn_readfirstlane(__hip_atomic_load(ready + 64 * u.pm, __ATOMIC_RELAXED, __HIP_MEMORY_SCOPE_AGENT)) < need) { __builtin_amdgcn_s_sleep(2); if (++spins > (1u << 22)) break; } }
            asm volatile("" ::: "memory"); __builtin_amdgcn_s_barrier(); asm volatile("" ::: "memory");
        }
    }
    __device__ __forceinline__ void done(const Unit& u, int lane) const {
        if (DEP == 1) { asm volatile("s_waitcnt vmcnt(0)" ::: "memory"); if (lane == 0) __hip_atomic_fetch_add(ready + 64 * u.pm, 1u, __ATOMIC_RELAXED, __HIP_MEMORY_SCOPE_AGENT); }
    }
};

__device__ __forceinline__ unsigned cvt_pk_bf16(float lo, float hi) { unsigned r; asm volatile("v_cvt_pk_bf16_f32 %0, %1, %2" : "=v"(r) : "v"(lo), "v"(hi)); return r; }

__device__ __forceinline__ float gelu_tanh_fast(float x) { const float uu = 0.7978845608028654f * (x + 0.044715f * x * x * x); return x * __builtin_amdgcn_rcpf(1.f + __builtin_amdgcn_exp2f(-2.885390081777927f * uu)); }
__device__ __forceinline__ void store_full_lines(bf16_t* grp  , int ldc, int fr, int fq, const u32x4 (&w)[2]) {
    const bool lo = fr < 8;
    u32x4 snd, rcv;
#pragma unroll
    for (int k = 0; k < 4; ++k) { snd[k] = lo ? w[1][k] : w[0][k]; rcv[k] = (unsigned)__builtin_amdgcn_update_dpp(0, (int)snd[k], 0x128  , 0xF, 0xF, false); }
    u32x4 da, db;
#pragma unroll
    for (int k = 0; k < 4; ++k) { da[k] = lo ? w[0][k] : rcv[k]; db[k] = lo ? rcv[k] : w[1][k]; }
    bf16_t* p = grp + (size_t)(fr & 7) * ldc + (lo ? 0 : 32) + 8 * fq;
    *(u32x4*)p = da; *(u32x4*)(p + (size_t)8 * ldc) = db;
}
struct EpiBf16 {
    static constexpr bool PERM = true, FULL = true;
    bf16_t* O; int ldc; int split_cols; size_t split_stride; float scale0;
    __device__ __forceinline__ void operator()(const f32x4 (&acc)[2][2][4][2], const Unit& u, int wr, int wc, int fr, int fq) const {
        int colt = u.pn * BM; bf16_t* base = O;
        float sc = 1.f; if (split_cols) { const int t = colt / split_cols; base += (size_t)t * split_stride; colt -= t * split_cols; if (t == 0) sc = scale0; }
#pragma unroll
        for (int ai = 0; ai < 2; ++ai)
#pragma unroll
            for (int m = 0; m < 4; ++m) { u32x4 w[2];
#pragma unroll
                for (int bj = 0; bj < 2; ++bj) { const f32x4 v0 = acc[ai][bj][m][0] * sc, v1 = acc[ai][bj][m][1] * sc;
                    w[bj].x = cvt_pk_bf16(v0[0], v0[1]); w[bj].y = cvt_pk_bf16(v0[2], v0[3]); w[bj].z = cvt_pk_bf16(v1[0], v1[1]); w[bj].w = cvt_pk_bf16(v1[2], v1[3]); }
                store_full_lines(base + (size_t)(u.pm * BM + wr * 64 + ai * HALF + m * 16) * ldc + colt + wc * 64, ldc, fr, fq, w); }
    }
};
struct EpiNull {
    static constexpr bool PERM = true, FULL = true;
    __device__ __forceinline__ void operator()(const f32x4 (&acc)[2][2][4][2], const Unit&, int, int, int, int) const {
#pragma unroll
        for (int ai = 0; ai < 2; ++ai)
#pragma unroll
            for (int bj = 0; bj < 2; ++bj)
#pragma unroll
                for (int m = 0; m < 4; ++m)
#pragma unroll
                    for (int n = 0; n < 2; ++n) asm volatile("" :: "v"(acc[ai][bj][m][n]));
    }
};
template <bool RES_BF16>
struct EpiResidZ {
    static constexpr bool PERM = true, FULL = true;
    const void* res; bf16_t* Z; float alpha;
    __device__ __forceinline__ void operator()(const f32x4 (&acc)[2][2][4][2], const Unit& u, int wr, int wc, int fr, int fq) const {
        const int row0 = u.pm * BM + wr * 64 + fr, col0 = u.pn * BM + wc * 64 + 8 * fq;
#pragma unroll
        for (int ai = 0; ai < 2; ++ai)
#pragma unroll
            for (int m = 0; m < 4; ++m) { const size_t off = (size_t)(row0 + ai * HALF + m * 16) * 1024 + col0; u32x4 w[2];
#pragma unroll
                for (int bj = 0; bj < 2; ++bj) { f32x4 r0, r1;
                    if (RES_BF16) { const u32x4 rb = *(const u32x4*)((const bf16_t*)res + off + bj * 32);
                        r0 = (f32x4){__uint_as_float(rb.x << 16), __uint_as_float(rb.x & 0xffff0000u), __uint_as_float(rb.y << 16), __uint_as_float(rb.y & 0xffff0000u)};
                        r1 = (f32x4){__uint_as_float(rb.z << 16), __uint_as_float(rb.z & 0xffff0000u), __uint_as_float(rb.w << 16), __uint_as_float(rb.w & 0xffff0000u)}; }
                    else { r0 = NT_LOAD((const f32x4*)((const float*)res + off + bj * 32)); r1 = NT_LOAD((const f32x4*)((const float*)res + off + bj * 32 + 4)); }
                    const f32x4 v0 = r0 * alpha + acc[ai][bj][m][0], v1 = r1 * alpha + acc[ai][bj][m][1];
                    w[bj].x = cvt_pk_bf16(v0[0], v0[1]); w[bj].y = cvt_pk_bf16(v0[2], v0[3]); w[bj].z = cvt_pk_bf16(v1[0], v1[1]); w[bj].w = cvt_pk_bf16(v1[2], v1[3]); }
                store_full_lines(Z + (size_t)(u.pm * BM + wr * 64 + ai * HALF + m * 16) * 1024 + u.pn * BM + wc * 64, 1024, fr, fq, w); }
    }
};
struct EpiSwiglu {
    static constexpr bool PERM = true, FULL = false;
    bf16_t* H;
    __device__ __forceinline__ void operator()(const f32x4 (&acc)[2][2][4][2], const Unit& u, int wr, int wc, int fr, int fq) const {
        const int row0 = u.pm * BM + wr * 64 + fr, col0 = u.pn * HALF + wc * 32 + 8 * fq;
#pragma unroll
        for (int ai = 0; ai < 2; ++ai)
#pragma unroll
            for (int m = 0; m < 4; ++m) { float h[8];
#pragma unroll
                for (int n = 0; n < 2; ++n)
#pragma unroll
                    for (int j = 0; j < 4; ++j) { const float a = acc[ai][0][m][n][j], b = acc[ai][1][m][n][j];
                        h[n * 4 + j] = a * __builtin_amdgcn_rcpf(1.f + __builtin_amdgcn_exp2f(-1.4426950408889634f * a)) * b; }
                u32x4 w; w.x = cvt_pk_bf16(h[0], h[1]); w.y = cvt_pk_bf16(h[2], h[3]); w.z = cvt_pk_bf16(h[4], h[5]); w.w = cvt_pk_bf16(h[6], h[7]);
                asm volatile("global_store_dwordx4 %0, %1, off sc1\n\ts_nop 1" :: "v"(H + (size_t)(row0 + ai * HALF + m * 16) * 512 + col0), "v"(w) : "memory"); }
    }
};

template <class Epi, class Sched, bool ALIGN_EPI>
__device__ __forceinline__ void gemm_phase(PG8_LAS unsigned char* lds, const int tid_in, const Sched& S, const Epi& E) {
    constexpr int K = Sched::K;
    int tid = tid_in; asm volatile("" : "+v"(tid));
    const int wid = __builtin_amdgcn_readfirstlane(tid >> 6), lane = tid & 63, wr = wid >> 2, wc = wid & 3, fr = lane & 15, fq = lane >> 4;
    const int nt = K / BK;
    int Rr[2], Cc[2]; unsigned voffB[2][2];
#pragma unroll
    for (int i = 0; i < 2; ++i) { int R, C; stage_rc(tid * 16 + i * 8192, R, C); Rr[i] = R; Cc[i] = C;
#pragma unroll
        for (int h = 0; h < 2; ++h) {
            const int col = Epi::FULL ? (64 * (R >> 5) + 32 * h + perm32(R & 31)) : (HALF * h + (Epi::PERM ? ((R & ~31) + perm32(R & 31)) : R));
            voffB[h][i] = (unsigned)(col * K + C) * 2u; } }
    const size_t kstep = (size_t)(BK * 2);
    const unsigned ldsw = (unsigned)wid * 1024u;
    const int aoff = lds_byte(wr * 64 + fr, fq * 8), boff = lds_byte(wc * 32 + fr, fq * 8);
#define PG8_SA(b, h) (((b) * 2 + (h)) * HTB)
#define PG8_SB(b, h) ((4 + (b) * 2 + (h)) * HTB)
#define PG8_STAGE(bufoff, gbase, voff) do { _Pragma("unroll") for (int _i = 0; _i < 2; ++_i) \
        __builtin_amdgcn_global_load_lds((const unsigned*)((const char*)(gbase) + (voff)[_i]), (PG8_LAS unsigned*)(lds + (bufoff) + ldsw + _i * 8192), 16, 0, Sched::AUX_B); } while (0)
#define PG8_STAGEA(bufoff, gbase, voff) do { _Pragma("unroll") for (int _i = 0; _i < 2; ++_i) \
        __builtin_amdgcn_global_load_lds((const unsigned*)((const char*)(gbase) + (voff)[_i]), (PG8_LAS unsigned*)(lds + (bufoff) + ldsw + _i * 8192), 16, 0, Sched::AUX_A); } while (0)
#define PG8_LDA(dst, b, h) do { _Pragma("unroll") for (int m = 0; m < 4; ++m) _Pragma("unroll") for (int k = 0; k < 2; ++k) dst[m][k] = *(const PG8_LAS bf16x8*)(lds + PG8_SA(b, h) + aoff + m * 2048 + k * 1024); } while (0)
#define PG8_LDB(dst, b, h) do { _Pragma("unroll") for (int n = 0; n < 2; ++n) _Pragma("unroll") for (int k = 0; k < 2; ++k) dst[n][k] = *(const PG8_LAS bf16x8*)(lds + PG8_SB(b, h) + boff + n * 2048 + k * 1024); } while (0)
#define PG8_MMA(ai, bj, At, Bt) do { __builtin_amdgcn_s_setprio(1); _Pragma("unroll") for (int m = 0; m < 4; ++m) _Pragma("unroll") for (int n = 0; n < 2; ++n) _Pragma("unroll") for (int k = 0; k < 2; ++k) \
        acc[ai][bj][m][n] = __builtin_amdgcn_mfma_f32_16x16x32_bf16(Bt[n][k], At[m][k], acc[ai][bj][m][n], 0, 0, 0); __builtin_amdgcn_s_setprio(0); } while (0)
#define PG8_WAIT_V(n) asm volatile("s_waitcnt vmcnt(" #n ")" ::: "memory")
#define PG8_WAIT_L(n) asm volatile("s_waitcnt lgkmcnt(" #n ")" ::: "memory")
#define PG8_BAR __builtin_amdgcn_s_barrier()
#define PG8_SCHED __builtin_amdgcn_sched_barrier(0)
#define PG8_VOFF(dst, u) do { _Pragma("unroll") for (int _h = 0; _h < 2; ++_h) _Pragma("unroll") for (int _i = 0; _i < 2; ++_i) dst[_h][_i] = S.a_rowoff(u, _h * HALF + Rr[_i]) + (unsigned)(Cc[_i] * 2); } while (0)
    Unit cur, nxt; int ui = 0;
    if (!S.next(0, cur)) return;
    cur.li = 0;
#if PG8_STAGGER_TICKS
    if (S.c & 1) { const unsigned long long t0 = __builtin_amdgcn_s_memrealtime(); while (__builtin_amdgcn_s_memrealtime() - t0 < (unsigned long long)PG8_STAGGER_TICKS) __builtin_amdgcn_s_sleep(16); }
#endif
    f32x4 acc[2][2][4][2];
#pragma unroll
    for (int a = 0; a < 2; ++a)
#pragma unroll
        for (int b = 0; b < 2; ++b)
#pragma unroll
            for (int m = 0; m < 4; ++m)
#pragma unroll
                for (int n = 0; n < 2; ++n) acc[a][b][m][n] = (f32x4){0.f, 0.f, 0.f, 0.f};
    bf16x8 At[4][2], B0[2][2], B1[2][2];
    unsigned vC[2][2], vN[2][2];
    PG8_VOFF(vC, cur);
    const char* cA = S.a_base(cur); const char* cB = S.b_base(cur);
    S.a_ready(cur, tid);
    PG8_STAGE(PG8_SB(0, 0), cB, voffB[0]); PG8_STAGE(PG8_SB(0, 1), cB, voffB[1]); PG8_STAGEA(PG8_SA(0, 0), cA, vC[0]); PG8_STAGEA(PG8_SA(0, 1), cA, vC[1]);
    if (wr == 1) PG8_BAR;
    PG8_WAIT_V(2); PG8_BAR;
    PG8_STAGE(PG8_SB(1, 0), cB + kstep, voffB[0]); PG8_STAGEA(PG8_SA(1, 0), cA + kstep, vC[0]); PG8_STAGE(PG8_SB(1, 1), cB + kstep, voffB[1]);
    PG8_WAIT_V(6); PG8_BAR;
    for (;;) {
        const bool has_next = S.next(ui + 1, nxt); nxt.li = ui + 1;
        const char* nA = cA; const char* nB = cB;
#pragma unroll
        for (int h = 0; h < 2; ++h)
#pragma unroll
            for (int i = 0; i < 2; ++i) vN[h][i] = vC[h][i];
        if (has_next) { nA = S.a_base(nxt); nB = S.b_base(nxt); PG8_VOFF(vN, nxt); }
        for (int t = 0; t < nt; t += 2) {
            const bool last = (t == nt - 2);
            if (last && has_next) S.a_ready(nxt, tid);
            const char* a1 = cA + (size_t)(t + 1) * kstep;
            const char* a2 = last ? nA : cA + (size_t)(t + 2) * kstep; const char* b2 = last ? nB : cB + (size_t)(t + 2) * kstep;
            const char* a3 = a2 + kstep; const char* b3 = b2 + kstep;
            unsigned v2[2][2];
#pragma unroll
            for (int h = 0; h < 2; ++h)
#pragma unroll
                for (int i = 0; i < 2; ++i) v2[h][i] = last ? vN[h][i] : vC[h][i];
            PG8_LDB(B0, 0, 0); PG8_LDB(B1, 0, 1); PG8_SCHED; PG8_LDA(At, 0, 0); PG8_STAGEA(PG8_SA(1, 1), a1, vC[1]);
            PG8_WAIT_V(8); PG8_WAIT_L(0); PG8_BAR; PG8_MMA(0, 0, At, B0); PG8_MMA(0, 1, At, B1); PG8_BAR; PG8_SCHED;
            PG8_LDA(At, 0, 1); PG8_STAGE(PG8_SB(0, 0), b2, voffB[0]); PG8_STAGE(PG8_SB(0, 1), b2, voffB[1]); PG8_STAGEA(PG8_SA(0, 0), a2, v2[0]);
            PG8_WAIT_V(8); PG8_WAIT_L(0); PG8_BAR; PG8_MMA(1, 0, At, B0); PG8_MMA(1, 1, At, B1); PG8_BAR; PG8_SCHED;
            PG8_LDB(B0, 1, 0); PG8_LDB(B1, 1, 1); PG8_SCHED; PG8_LDA(At, 1, 0); PG8_STAGEA(PG8_SA(0, 1), a2, v2[1]);
            PG8_WAIT_V(8); PG8_WAIT_L(0); PG8_BAR; PG8_MMA(0, 0, At, B0); PG8_MMA(0, 1, At, B1); PG8_BAR; PG8_SCHED;
            PG8_LDA(At, 1, 1); PG8_STAGE(PG8_SB(1, 0), b3, voffB[0]); PG8_STAGE(PG8_SB(1, 1), b3, voffB[1]); PG8_STAGEA(PG8_SA(1, 0), a3, v2[0]);
            PG8_WAIT_V(8); PG8_WAIT_L(0); PG8_BAR; PG8_MMA(1, 0, At, B0); PG8_MMA(1, 1, At, B1); PG8_BAR; PG8_SCHED;
        }
        if constexpr (ALIGN_EPI) { if (wr == 0) PG8_BAR; }
        E(acc, cur, wr, wc, fr, fq); S.done(cur, lane);
        if (!has_next) break;
#pragma unroll
        for (int a = 0; a < 2; ++a)
#pragma unroll
            for (int b = 0; b < 2; ++b)
#pragma unroll
                for (int m = 0; m < 4; ++m)
#pragma unroll
                    for (int n = 0; n < 2; ++n) acc[a][b][m][n] = (f32x4){0.f, 0.f, 0.f, 0.f};
        cur = nxt; cA = nA; cB = nB; ++ui;
#pragma unroll
        for (int h = 0; h < 2; ++h)
#pragma unroll
            for (int i = 0; i < 2; ++i) vC[h][i] = vN[h][i];
        if constexpr (ALIGN_EPI) { if (wr == 1) PG8_BAR; }
    }
    PG8_WAIT_V(0);
    if constexpr (!ALIGN_EPI) { if (wr == 0) PG8_BAR; }
    PG8_BAR;
#undef PG8_SA
#undef PG8_SB
#undef PG8_STAGE
#undef PG8_STAGEA
#undef PG8_LDA
#undef PG8_LDB
#undef PG8_MMA
#undef PG8_WAIT_V
#undef PG8_WAIT_L
#undef PG8_BAR
#undef PG8_SCHED
#undef PG8_VOFF
}
}
#define GAS __attribute__((address_space(1)))
#define LAS __attribute__((address_space(3)))
typedef unsigned v4u __attribute__((ext_vector_type(4)));
typedef unsigned v2u __attribute__((ext_vector_type(2)));
typedef float f32x4 __attribute__((ext_vector_type(4)));
typedef short s16x4 __attribute__((ext_vector_type(4)));
typedef short bf16x8 __attribute__((ext_vector_type(8)));
constexpr int NWAVES = 8, NTHREADS = 512;
constexpr int LDS_BYTES = 163840;
#define LDS_WAIT() asm volatile("s_waitcnt lgkmcnt(0)" ::: "memory")

#ifndef PRO_SKIP_L0
#define PRO_SKIP_L0 0
#endif
#ifndef PRO_NTST
#define PRO_NTST 1
#endif
#if PRO_NTST
#define PRO_STORE(p, v) __builtin_nontemporal_store(v, p)
#else
#define PRO_STORE(p, v) (*(p) = (v))
#endif
#ifndef PRO_NT
#define PRO_NT 1
#endif
#if PRO_NT
#define PRO_LOAD(p) __builtin_nontemporal_load(p)
#else
#define PRO_LOAD(p) (*(p))
#endif
struct Params { const float* in[22]; float* out; unsigned char* ws; };

typedef const __attribute__((address_space(4))) Params* KParamsPtr;
__device__ __forceinline__ Params kparams() {
    KParamsPtr p = (KParamsPtr)__builtin_amdgcn_kernarg_segment_ptr();
    asm volatile("" : "+s"(p));
    Params P;
#pragma unroll
    for (int i = 0; i < 22; ++i) P.in[i] = p->in[i];
    P.out = p->out; P.ws = p->ws;
    return P;
}
__device__ __forceinline__ unsigned pk2(float lo, float hi) { return (unsigned)f2bf(lo) | ((unsigned)f2bf(hi) << 16); }

__device__ __forceinline__ void transpose_item(const float* W, int ldw, bf16_t* WT, int ldt, int k0, int n0, int orow0, LAS float* scr, int lane) {
    f32x4 wv[8];
#pragma unroll
    for (int i = 0; i < 8; ++i) wv[i] = PRO_LOAD((const f32x4*)(W + (size_t)(k0 + 8 * i + (lane >> 3)) * ldw + n0 + 4 * (lane & 7)));
#pragma unroll
    for (int i = 0; i < 8; ++i) { LAS float* d = scr + (8 * i + (lane >> 3)) * 33 + 4 * (lane & 7); d[0] = wv[i][0]; d[1] = wv[i][1]; d[2] = wv[i][2]; d[3] = wv[i][3]; }
    LDS_WAIT(); asm volatile("" ::: "memory");
    const int c = lane & 7;
#pragma unroll
    for (int j = 0; j < 4; ++j) { const int n = (lane >> 3) + 8 * j; const LAS float* s = scr + (8 * c) * 33 + n;
        v4u o; o.x = pk2(s[0 * 33], s[1 * 33]); o.y = pk2(s[2 * 33], s[3 * 33]); o.z = pk2(s[4 * 33], s[5 * 33]); o.w = pk2(s[6 * 33], s[7 * 33]);
        PRO_STORE((v4u*)(WT + (size_t)(orow0 + n) * ldt + k0 + 8 * c), o); }
    LDS_WAIT(); asm volatile("" ::: "memory");
}

constexpr int IT_WIN = (D / 64) * (2 * DR / 32);
constexpr int IT_WOUT = (DR / 64) * (D / 32);
constexpr int IT_WQKV = (D / 64) * (QKVD / 32);
constexpr int IT_WO = (D / 64) * (D / 32);
constexpr int IT_W1 = (D / 64) * (DE / 32);
constexpr int IT_W2 = (DE / 64) * (D / 32);
constexpr int IT_MOE_LAYER = NE * (2 * IT_W1 + IT_W2);
constexpr int IT_DENSE = IT_WIN + IT_WOUT + IT_WQKV + IT_WO;

__device__ __forceinline__ void cvt_dense_item(const Params& P, int r, LAS float* scr, int lane) {
    unsigned char* ws = P.ws;
    if (r < IT_WIN) { const int nb = 2 * DR / 32, kb = r / nb, n0 = (r % nb) * 32; transpose_item(P.in[1], 2 * DR, (bf16_t*)(ws + WS_WIN), D, kb * 64, n0, n0, scr, lane); return; } r -= IT_WIN;
    if (r < IT_WOUT) { const int nb = D / 32, kb = r / nb, n0 = (r % nb) * 32; transpose_item(P.in[9], D, (bf16_t*)(ws + WS_WOUT), DR, kb * 64, n0, n0, scr, lane); return; } r -= IT_WOUT;
    if (r < IT_WQKV) { const int nb = QKVD / 32, kb = r / nb, n0 = (r % nb) * 32; transpose_item(P.in[10], QKVD, (bf16_t*)(ws + WS_WQKV), D, kb * 64, n0, n0, scr, lane); return; } r -= IT_WQKV;
    { const int nb = D / 32, kb = r / nb, n0 = (r % nb) * 32; transpose_item(P.in[12], D, (bf16_t*)(ws + WS_WO), D, kb * 64, n0, n0, scr, lane); }
}
__device__ __forceinline__ void cvt_moe_item(const Params& P, int layer, int r, LAS float* scr, int lane) {
    unsigned char* ws = P.ws;
    const int per_e = 2 * IT_W1 + IT_W2, e = r / per_e; int q = r % per_e;
    bf16_t* W13t = (bf16_t*)(ws + WS_W13) + ((size_t)layer * NE + e) * (size_t)(D * D);
    bf16_t* W2t = (bf16_t*)(ws + WS_W2) + ((size_t)layer * NE + e) * (size_t)(D * DE);
    const size_t eoff13 = ((size_t)layer * NE + e) * (size_t)(D * DE);
    if (q < 2 * IT_W1) { const int which = q / IT_W1; q %= IT_W1; const int nb = DE / 32, kb = q / nb, n0 = (q % nb) * 32;
        const int orow0 = (n0 / 128) * 256 + which * 128 + (n0 % 128);
        transpose_item((which ? P.in[18] : P.in[17]) + eoff13, DE, W13t, D, kb * 64, n0, orow0, scr, lane); return; }
    q -= 2 * IT_W1;
    { const int nb = D / 32, kb = q / nb, n0 = (q % nb) * 32; transpose_item(P.in[19] + eoff13, D, W2t, DE, kb * 64, n0, n0, scr, lane); }
}

__device__ __forceinline__ void cvt_gate_frags(const Params& P, int gtid, int gthreads) {
    v2u* GF = (v2u*)(P.ws + WS_GF);
    for (int i = gtid; i < 2 * 16 * 25 * 64; i += gthreads) {
        const int l = i & 63, ks = (i >> 6) % 5, jt = (i / 320) % 5, n = (i / 1600) % 16, mat = i / 25600;
        const float* w = (mat ? P.in[6] : P.in[4]) + (size_t)n * BW * BW;
        const int j = 16 * jt + (l & 15), k = 16 * ks + 4 * (l >> 4);
        v2u o; o.x = pk2(w[(k + 0) * BW + j], w[(k + 1) * BW + j]); o.y = pk2(w[(k + 2) * BW + j], w[(k + 3) * BW + j]);
        GF[i] = o;
    }
}
__device__ __forceinline__ void cvt_x(const Params& P, int gtid, int gthreads) {
    const f32x4* x = (const f32x4*)P.in[0]; v4u* xb = (v4u*)(P.ws + WS_XB);
    for (size_t i = gtid; i < (size_t)T * D / 8; i += gthreads) { const f32x4 a = PRO_LOAD(x + 2 * i), b = PRO_LOAD(x + 2 * i + 1);
        v4u o; o.x = pk2(a[0], a[1]); o.y = pk2(a[2], a[3]); o.z = pk2(b[0], b[1]); o.w = pk2(b[2], b[3]); st16_wt(xb + i, o); }
}
__device__ __forceinline__ void phase_prologue(LAS unsigned char* lds, const int tid_in, int vcu, int G) {
    const Params P = kparams();
    int tid = tid_in; asm volatile("" : "+v"(tid));
    const int lane = tid & 63, wave = __builtin_amdgcn_readfirstlane(tid >> 6);
    LAS float* scr = (LAS float*)(lds + wave * 16384);
    const int gw = vcu * NWAVES + wave, NGW = G * NWAVES;
    for (int it = gw + (PRO_SKIP_L0 ? IT_MOE_LAYER : 0); it < 2 * IT_MOE_LAYER; it += NGW) cvt_moe_item(P, it / IT_MOE_LAYER, it % IT_MOE_LAYER, scr, lane);
    for (int it = gw; it < IT_DENSE; it += NGW) cvt_dense_item(P, it, scr, lane);
    cvt_gate_frags(P, vcu * NTHREADS + tid, G * NTHREADS);
    cvt_x(P, vcu * NTHREADS + tid, G * NTHREADS);
}

__device__ __forceinline__ void phase_cvt_moe(int layer, LAS unsigned char* lds, const int tid_in, int vcu, int G) {
    const Params P = kparams();
    int tid = tid_in; asm volatile("" : "+v"(tid));
    const int lane = tid & 63, wave = __builtin_amdgcn_readfirstlane(tid >> 6);
    LAS float* scr = (LAS float*)(lds + wave * 16384);
    const int gw = vcu * NWAVES + wave, NGW = G * NWAVES;
    for (int it = gw; it < IT_MOE_LAYER; it += NGW) cvt_moe_item(P, layer, it, scr, lane);
}
#define XB_TMO      128
#define XB_XCNT(j)  (256  + 64 * (j))
#define XB_XSUB(j)  (1280 + 64 * (j))
#define XB_XGEN(j)  (2304 + 64 * (j))
#define XB_TOP      3328
#define XB_TOPGEN   3392
#define XCD_BAR_WORDS 3456
#define XB_SPIN_CAP (1u << 18)

__device__ __forceinline__ unsigned xb_ld(unsigned* p)              { return __hip_atomic_load(p, __ATOMIC_RELAXED, __HIP_MEMORY_SCOPE_AGENT); }
__device__ __forceinline__ unsigned xb_add(unsigned* p, unsigned v) { return __hip_atomic_fetch_add(p, v, __ATOMIC_RELAXED, __HIP_MEMORY_SCOPE_AGENT); }
__device__ __forceinline__ unsigned xb_xcc_id() { return (unsigned)__builtin_amdgcn_s_getreg((3 << 11) | 20) & 0xFu; }
#define XB_SPIN(cond, bar) do { unsigned _sp = 0; while (cond) { __builtin_amdgcn_s_sleep(1); \
    if ((++_sp & 255u) == 0u) { if (xb_ld(&(bar)[XB_TMO])) break; if (_sp > XB_SPIN_CAP) { atomicAdd(&(bar)[XB_TMO], 1u); break; } } } } while (0)

struct XcdBarrier {
    unsigned* bar; unsigned x;
    volatile LAS unsigned* st;
};

__device__ __forceinline__ XcdBarrier xcd_barrier_post(unsigned* bar, volatile LAS unsigned* st, const int xb_tid) {
    XcdBarrier b; b.bar = bar; b.x = xb_xcc_id(); b.st = st;
    if (xb_tid == 0) (void)xb_add(&bar[XB_XCNT(b.x)], 1u);
    return b;
}
__device__ __forceinline__ void xcd_barrier_complete(unsigned* bar, unsigned x, unsigned& nloc, unsigned& nx) {
    const unsigned G = gridDim.x * gridDim.y * gridDim.z;
    unsigned sum, cnt, mine, sp = 0u;
    for (;;) {
        sum = 0u; cnt = 0u; mine = 0u;
#pragma unroll
        for (unsigned j = 0; j < 16; ++j) { const unsigned c = xb_ld(&bar[XB_XCNT(j)]); sum += c; cnt += (c > 0u) ? 1u : 0u; mine = (j == x) ? c : mine; }
        if (sum == G) break;
        __builtin_amdgcn_s_sleep(1);
        if ((++sp & 255u) == 0u) { if (xb_ld(&bar[XB_TMO])) break; if (sp > XB_SPIN_CAP) { atomicAdd(&bar[XB_TMO], 1u); break; } }
    }
    nloc = mine > 0u ? mine : 1u; nx = cnt > 0u ? cnt : 1u;
}

__device__ __forceinline__ void xcd_barrier(const XcdBarrier& b, const int xb_tid) {
    asm volatile("s_waitcnt vmcnt(0)" ::: "memory");
    __syncthreads();
    if (xb_tid == 0) {
        unsigned* bar = b.bar;
        __builtin_amdgcn_s_waitcnt(0);
        unsigned nloc = b.st[0], nx = b.st[1];
        if (nloc == 0u) { xcd_barrier_complete(bar, b.x, nloc, nx); b.st[0] = nloc; b.st[1] = nx; }
        const unsigned old = xb_add(&bar[XB_XSUB(b.x)], 1u);
        const unsigned gen = old / nloc;
        if (old + 1u == (gen + 1u) * nloc) {
            __builtin_amdgcn_fence(__ATOMIC_RELEASE, "agent");
            asm volatile("s_waitcnt vmcnt(0)" ::: "memory");
            const unsigned og = xb_add(&bar[XB_TOP], 1u);
            const unsigned tg = og / nx;
            if (og + 1u == (tg + 1u) * nx) xb_add(&bar[XB_TOPGEN], 1u);
            else XB_SPIN(xb_ld(&bar[XB_TOPGEN]) == tg, bar);
            __builtin_amdgcn_fence(__ATOMIC_ACQUIRE, "agent");
            xb_add(&bar[XB_XGEN(b.x)], 1u);
            asm volatile("s_waitcnt vmcnt(0)" ::: "memory");
        } else {
            XB_SPIN(xb_ld(&bar[XB_XGEN(b.x)]) == gen, bar);
            __builtin_amdgcn_fence(__ATOMIC_ACQUIRE, "agent");
            asm volatile("s_waitcnt vmcnt(0)" ::: "memory");
        }
    }
    __syncthreads();
}
#ifndef WGM_WIN
#define WGM_WIN PG8_WGM
#endif
#ifndef WGM_QKV
#define WGM_QKV PG8_WGM
#endif
#ifndef WGM_WOUT
#define WGM_WOUT PG8_WGM
#endif
#ifndef WGM_WO
#define WGM_WO PG8_WGM
#endif
#ifndef WGM_UP
#define WGM_UP PG8_WGM
#endif
#ifndef WGM_DOWN
#define WGM_DOWN PG8_WGM
#endif
#ifndef PG8_ALIGN
#define PG8_ALIGN true
#endif
enum Phase { PH_PROLOGUE = 0, PH_WIN, PH_RGLRU, PH_WOUT, PH_LN0, PH_ROUTE0, PH_UP0, PH_DOWN0, PH_COMB0, PH_QKV, PH_ATTN, PH_WO, PH_LN1, PH_ROUTE1, PH_UP1, PH_DOWN1, PH_COMB1, PH_COUNT };
__device__ __forceinline__ void phase_gemm_win(LAS unsigned char* lds, const int tid_in, int bid, int G) {
    const Params P = kparams(); unsigned char* ws = P.ws;
    typedef pg8::Order<D, 2 * DR / 256, false, false, 0, WGM_WIN> O;
    const O S{T / 256, G, bid, (const char*)(ws + WS_XB), (const char*)(ws + WS_WIN), nullptr, nullptr, nullptr, 0u, nullptr};
    const pg8::EpiBf16 E{(bf16_t*)(ws + WS_M + M_G), DR, DR, (size_t)(M_XR - M_G) / 2, 1.f};
    pg8::gemm_phase<pg8::EpiBf16, O, PG8_ALIGN>(lds, tid_in, S, E);
}
__device__ __forceinline__ void phase_gemm_qkv(LAS unsigned char* lds, const int tid_in, int bid, int G) {
    const Params P = kparams(); unsigned char* ws = P.ws;
    typedef pg8::Order<D, QKVD / 256, false, false, 0, WGM_QKV> O;
    const O S{T / 256, G, bid, (const char*)(ws + WS_XB), (const char*)(ws + WS_WQKV), nullptr, nullptr, nullptr, 0u, nullptr};
    const pg8::EpiBf16 E{(bf16_t*)(ws + WS_M + M_QKV), QKVD, 1024, 1024, QSCALE};
    pg8::gemm_phase<pg8::EpiBf16, O, PG8_ALIGN>(lds, tid_in, S, E);
}
__device__ __forceinline__ void phase_gemm_wout(LAS unsigned char* lds, const int tid_in, int bid, int G) {
    const Params P = kparams(); unsigned char* ws = P.ws;
    typedef pg8::Order<DR, D / 256, false, false, 0, WGM_WOUT> O;
    const O S{T / 256, G, bid, (const char*)(ws + WS_M + M_G), (const char*)(ws + WS_WOUT), nullptr, nullptr, nullptr, 0u, nullptr};
    const pg8::EpiResidZ<false> E{P.in[0], (bf16_t*)P.out, ALPHA};
    pg8::gemm_phase<pg8::EpiResidZ<false>, O, PG8_ALIGN>(lds, tid_in, S, E);
}
__device__ __forceinline__ void phase_gemm_wo(LAS unsigned char* lds, const int tid_in, int bid, int G) {
    const Params P = kparams(); unsigned char* ws = P.ws;
    typedef pg8::Order<D, D / 256, false, false, 0, WGM_WO> O;
    const O S{T / 256, G, bid, (const char*)(ws + WS_M + M_O), (const char*)(ws + WS_WO), nullptr, nullptr, nullptr, 0u, nullptr};
    const pg8::EpiResidZ<true> E{ws + WS_XB, (bf16_t*)P.out, ALPHA};
    pg8::gemm_phase<pg8::EpiResidZ<true>, O, PG8_ALIGN>(lds, tid_in, S, E);
}
__device__ __forceinline__ void phase_moe_up(int layer, LAS unsigned char* lds, const int tid_in, int bid, int G) {
    const Params P = kparams(); unsigned char* ws = P.ws; const int* ctl = (const int*)(ws + WS_CTL);
    typedef pg8::Order<D, 4, true, true, 1, WGM_UP> O;
    const O S{ctl[97], G, bid, (const char*)(ws + WS_XB), (const char*)(ws + WS_W13) + (size_t)layer * NE * (size_t)(D * D * 2), ctl + 128, (const int*)(ws + WS_ROUTE + 512 * 1024), (unsigned*)(ws + WS_READY + (size_t)layer * READY_BANK), 0u, (const LAS int*)(lds + 131072 + 4096)};
    { int t_ = tid_in; asm volatile("" : "+v"(t_)); S.fill_tokl((LAS int*)(lds + 131072 + 4096), t_); __syncthreads(); }
    const pg8::EpiSwiglu E{(bf16_t*)(ws + WS_M + M_HDN)};
    pg8::gemm_phase<pg8::EpiSwiglu, O, PG8_ALIGN>(lds, tid_in, S, E);
}
__device__ __forceinline__ void phase_moe_down(int layer, LAS unsigned char* lds, const int tid_in, int bid, int G) {
    const Params P = kparams(); unsigned char* ws = P.ws; const int* ctl = (const int*)(ws + WS_CTL);
    typedef pg8::Order<DE, 4, false, true, 2, WGM_DOWN> O;
    const O S{ctl[97], G, G - 1 - bid, (const char*)(ws + WS_M + M_HDN), (const char*)(ws + WS_W2) + (size_t)layer * NE * (size_t)(D * DE * 2), ctl + 128, nullptr, (unsigned*)(ws + WS_READY + (size_t)layer * READY_BANK), 32u, nullptr};
    const pg8::EpiBf16 E{(bf16_t*)(ws + WS_M + M_YS), D, 0, 0, 1.f};
    pg8::gemm_phase<pg8::EpiBf16, O, PG8_ALIGN>(lds, tid_in, S, E);
}

__device__ __forceinline__ void phase_gemm_win_null(LAS unsigned char* lds, const int tid_in, int bid, int G) {
    const Params P = kparams(); unsigned char* ws = P.ws;
    typedef pg8::Order<D, 2 * DR / 256, false, false> O;
    const O S{T / 256, G, bid, (const char*)(ws + WS_XB), (const char*)(ws + WS_WIN), nullptr, nullptr, nullptr, 0u, nullptr};
    const pg8::EpiNull E{};
    pg8::gemm_phase<pg8::EpiNull, O, PG8_ALIGN>(lds, tid_in, S, E);
}

template <int VARD> __device__ __forceinline__ void phase_moe_down_var(int layer, LAS unsigned char* lds, const int tid_in, int bid, int G) {
    const Params P = kparams(); unsigned char* ws = P.ws; const int* ctl = (const int*)(ws + WS_CTL);
    typedef pg8::Order<DE, 4, false, true, (VARD & 2) ? 0 : 2, WGM_DOWN> O;
    const O S{ctl[97], G, G - 1 - bid, (const char*)(ws + WS_M + M_HDN), (const char*)(ws + WS_W2) + (size_t)layer * NE * (size_t)(D * DE * 2), ctl + 128, nullptr, (unsigned*)(ws + WS_READY + (size_t)layer * READY_BANK), 32u, nullptr};
    if (VARD & 1) { const pg8::EpiNull E{}; pg8::gemm_phase<pg8::EpiNull, O, PG8_ALIGN>(lds, tid_in, S, E); }
    else { const pg8::EpiBf16 E{(bf16_t*)(ws + WS_M + M_YS), D, 0, 0, 1.f}; pg8::gemm_phase<pg8::EpiBf16, O, PG8_ALIGN>(lds, tid_in, S, E); }
}

template <bool GATH> __device__ __forceinline__ void phase_moe_up_null(int layer, LAS unsigned char* lds, const int tid_in, int bid, int G) {
    const Params P = kparams(); unsigned char* ws = P.ws; const int* ctl = (const int*)(ws + WS_CTL);
    typedef pg8::Order<D, 4, GATH, true, 0, WGM_UP> O;
    const O S{ctl[97] < 128 ? ctl[97] : 128, G, bid, (const char*)(ws + WS_XB), (const char*)(ws + WS_W13) + (size_t)layer * NE * (size_t)(D * D * 2), ctl + 128, (const int*)(ws + WS_ROUTE + 512 * 1024), nullptr, 0u, (const LAS int*)(lds + 131072 + 4096)};
    if (GATH) { int t_ = tid_in; asm volatile("" : "+v"(t_)); S.fill_tokl((LAS int*)(lds + 131072 + 4096), t_); __syncthreads(); }
    const pg8::EpiNull E{};
    pg8::gemm_phase<pg8::EpiNull, O, PG8_ALIGN>(lds, tid_in, S, E);
}
constexpr size_t CTL_CNT = 16384;
constexpr int LN_ROWS = 32, LN_TILES = T / LN_ROWS;
typedef float f32x2v __attribute__((ext_vector_type(2)));

__device__ __forceinline__ float wave_sum(float v) {
#pragma unroll
    for (int o = 1; o < 64; o <<= 1) v += __shfl_xor(v, o);
    return v;
}
__device__ __forceinline__ void split_bf(float x, unsigned& hi, unsigned& lo) { hi = f2bf(x); lo = f2bf(x - __uint_as_float(hi << 16)); }

__device__ __forceinline__ void phase_ln(int layer, LAS unsigned char* lds, const int tid_in, int bid, int G, bool dry = false) {
    const Params P = kparams();
    unsigned char* ws = P.ws;
    const bf16_t* Z = (const bf16_t*)P.out; bf16_t* XB = (bf16_t*)(ws + (dry ? WS_M + 128 * MiB : WS_XB));
    const float* lg = P.in[20] + (size_t)(layer * 2) * D; const float* lb = P.in[21] + (size_t)(layer * 2) * D;
    const float* wg = P.in[13] + (size_t)layer * D * 4; const float* bg = P.in[14] + layer * 4;
    const float* we = P.in[15] + (size_t)layer * D * 32; const float* be = P.in[16] + layer * 32;
    unsigned char* rbase = ws + (dry ? WS_M + 192 * MiB : WS_ROUTE);
    int* EXP = (int*)(rbase); float* GATE = (float*)(rbase + 256 * 1024); int* rowtok = (int*)(rbase + 512 * 1024);
    int* CNT = dry ? (int*)(rbase + 2 * MiB) : (int*)(ws + WS_CTL) + CTL_CNT;
    int tid = tid_in; asm volatile("" : "+v"(tid));
    const int lane = tid & 63, w = __builtin_amdgcn_readfirstlane(tid >> 6), fr = lane & 15, fq = lane >> 4;
    for (int i = bid * NTHREADS + tid; i < NROWS_MAX; i += G * NTHREADS) rowtok[i] = -1;
    LAS float* stat = (LAS float*)lds;
    LAS float* part = (LAS float*)(lds + 2048);
    LAS float* logit = (LAS float*)(lds + 2048 + 49152);
    LAS int* hist = (LAS int*)(lds + 2048 + 49152 + 6144);
    v2u vp[2][4][2];
#define LN_LOAD(tl) do { _Pragma("unroll") for (int rt = 0; rt < 2; ++rt) _Pragma("unroll") for (int s = 0; s < 4; ++s) _Pragma("unroll") for (int hf = 0; hf < 2; ++hf) \
        vp[rt][s][hf] = NT_LOAD_S(0, (const v2u*)(Z + (size_t)((tl) * LN_ROWS + 16 * rt + fr) * D + 128 * w + 32 * s + 16 * hf + 4 * fq)); } while (0)
#define LN_UNPACK(p) ((f32x4){__uint_as_float((p).x << 16), __uint_as_float((p).x & 0xffff0000u), __uint_as_float((p).y << 16), __uint_as_float((p).y & 0xffff0000u)})
    if (bid < LN_TILES) LN_LOAD(bid);
    bf16x8 Bh[4][3];
    LAS bf16x8* Bl = (LAS bf16x8*)(lds + 58368) + (w * 12) * 64 + lane;
    { float wv[4][3][8];
#pragma unroll
      for (int s = 0; s < 4; ++s)
#pragma unroll
          for (int ct = 0; ct < 3; ++ct)
#pragma unroll
              for (int j = 0; j < 8; ++j) {
                  const int col = 128 * w + 32 * s + (j < 4 ? 4 * fq + j : 16 + 4 * fq + (j - 4));
                  wv[s][ct][j] = (ct < 2) ? we[(size_t)col * 32 + 16 * ct + fr] : wg[(size_t)col * 4 + (fr & 3)];
              }
#pragma unroll
      for (int s = 0; s < 4; ++s)
#pragma unroll
          for (int ct = 0; ct < 3; ++ct) {
              unsigned h[8], l[8];
#pragma unroll
              for (int j = 0; j < 8; ++j) split_bf((ct < 2 || fr < 4) ? wv[s][ct][j] : 0.f, h[j], l[j]);
              Bh[s][ct] = __builtin_bit_cast(bf16x8, (v4u){h[0] | (h[1] << 16), h[2] | (h[3] << 16), h[4] | (h[5] << 16), h[6] | (h[7] << 16)});
              Bl[(s * 3 + ct) * 64] = __builtin_bit_cast(bf16x8, (v4u){l[0] | (l[1] << 16), l[2] | (l[3] << 16), l[4] | (l[5] << 16), l[6] | (l[7] << 16)});
          } }
    for (int tile = bid; tile < LN_TILES; tile += G) {
        const int row0 = tile * LN_ROWS;
        if (tid < 32) hist[tid] = 0;
#pragma unroll
        for (int rt = 0; rt < 2; ++rt) {
            float sm = 0.f, sq = 0.f;
#pragma unroll
            for (int s = 0; s < 4; ++s)
#pragma unroll
                for (int hf = 0; hf < 2; ++hf) { const f32x4 x = LN_UNPACK(vp[rt][s][hf]); sm += (x[0] + x[1]) + (x[2] + x[3]); sq += (x[0] * x[0] + x[1] * x[1]) + (x[2] * x[2] + x[3] * x[3]); }
            sm += __shfl_xor(sm, 16); sm += __shfl_xor(sm, 32); sq += __shfl_xor(sq, 16); sq += __shfl_xor(sq, 32);
            if (fq == 0) *(LAS f32x2v*)(stat + ((w * 32) + 16 * rt + fr) * 2) = (f32x2v){sm, sq};
        }
#pragma unroll
        for (int rt = 0; rt < 2; ++rt)
#pragma unroll
            for (int s = 0; s < 4; ++s) asm volatile("" : "+v"(vp[rt][s][0]), "+v"(vp[rt][s][1]));
        __syncthreads();
        float mean[2], rstd[2];
#pragma unroll
        for (int rt = 0; rt < 2; ++rt) { float sm = 0.f, sq = 0.f;
#pragma unroll
            for (int ww = 0; ww < 8; ++ww) { const f32x2v a = *(LAS f32x2v*)(stat + ((ww * 32) + 16 * rt + fr) * 2); sm += a.x; sq += a.y; }
            mean[rt] = sm * (1.f / D); const float var = fmaxf(sq * (1.f / D) - mean[rt] * mean[rt], 0.f); rstd[rt] = 1.f / sqrtf(var + LN_EPS); }
        f32x4 acc[2][3];
#pragma unroll
        for (int rt = 0; rt < 2; ++rt)
#pragma unroll
            for (int ct = 0; ct < 3; ++ct) acc[rt][ct] = (f32x4){0.f, 0.f, 0.f, 0.f};
#pragma unroll
        for (int s = 0; s < 4; ++s) {
            asm volatile("" ::: "memory");
            f32x4 gg[2], bb[2];
#pragma unroll
            for (int hf = 0; hf < 2; ++hf) { gg[hf] = *(const f32x4*)(lg + 128 * w + 32 * s + 16 * hf + 4 * fq); bb[hf] = *(const f32x4*)(lb + 128 * w + 32 * s + 16 * hf + 4 * fq); }
#pragma unroll
            for (int rt = 0; rt < 2; ++rt) {
                unsigned hp[4], lp[4];
#pragma unroll
                for (int hf = 0; hf < 2; ++hf) {
                    f32x4 y = (LN_UNPACK(vp[rt][s][hf]) - mean[rt]) * rstd[rt] * gg[hf] + bb[hf];
                    const size_t off = (size_t)(row0 + 16 * rt + fr) * D + 128 * w + 32 * s + 16 * hf + 4 * fq;
#pragma unroll
                    for (int q = 0; q < 2; ++q) { const unsigned hh = pg8::cvt_pk_bf16(y[2 * q], y[2 * q + 1]);
                        hp[2 * hf + q] = hh; lp[2 * hf + q] = pg8::cvt_pk_bf16(y[2 * q] - __uint_as_float(hh << 16), y[2 * q + 1] - __uint_as_float(hh & 0xffff0000u)); }
                    st8_wt(XB + off, (v2u){hp[2 * hf], hp[2 * hf + 1]});
                }
                const bf16x8 Ah = __builtin_bit_cast(bf16x8, (v4u){hp[0], hp[1], hp[2], hp[3]});
                const bf16x8 Al = __builtin_bit_cast(bf16x8, (v4u){lp[0], lp[1], lp[2], lp[3]});
#pragma unroll
                for (int ct = 0; ct < 3; ++ct) {
                    acc[rt][ct] = __builtin_amdgcn_mfma_f32_16x16x32_bf16(Ah, Bh[s][ct], acc[rt][ct], 0, 0, 0);
                    acc[rt][ct] = __builtin_amdgcn_mfma_f32_16x16x32_bf16(Ah, Bl[(s * 3 + ct) * 64], acc[rt][ct], 0, 0, 0);
                    acc[rt][ct] = __builtin_amdgcn_mfma_f32_16x16x32_bf16(Al, Bh[s][ct], acc[rt][ct], 0, 0, 0);
                }
                __builtin_amdgcn_sched_barrier(0);
            }
        }
#pragma unroll
        for (int rt = 0; rt < 2; ++rt)
#pragma unroll
            for (int ct = 0; ct < 3; ++ct) *(LAS f32x4*)(part + (((w * 2 + rt) * 3 + ct) * 64 + lane) * 4) = acc[rt][ct];
        asm volatile("" ::: "memory");
        if (tile + G < LN_TILES) LN_LOAD(tile + G);
        __syncthreads();
#pragma unroll
        for (int k = 0; k < 3; ++k) {
            const int idx = tid + k * NTHREADS, r = idx & 3, ln = (idx >> 2) & 63, t6 = idx >> 8;
            float s = 0.f;
#pragma unroll
            for (int ww = 0; ww < 8; ++ww) s += part[((ww * 6 + t6) * 64 + ln) * 4 + r];
            const int rt = t6 / 3, ct = t6 % 3, row = 16 * rt + 4 * (ln >> 4) + r, col = 16 * ct + (ln & 15);
            logit[row * 48 + col] = s;
        }
        __syncthreads();
        if (tid < 32) {
            const LAS float* L = logit + tid * 48;
            int gi = 0; float gm = L[32] + bg[0];
            for (int o = 1; o < 4; ++o) { const float x = L[32 + o] + bg[o]; if (x > gm) { gm = x; gi = o; } }
            float gs = 0.f;
            for (int o = 0; o < 4; ++o) gs += __expf(L[32 + o] + bg[o] - gm);
            const float ggate = 1.f / gs;
            int i0 = 0; float v0 = L[gi * 8] + be[gi * 8];
            for (int i = 1; i < 8; ++i) { const float x = L[gi * 8 + i] + be[gi * 8 + i]; if (x > v0) { v0 = x; i0 = i; } }
            int i1 = -1; float v1 = -INFINITY;
            for (int i = 0; i < 8; ++i) { const float x = L[gi * 8 + i] + be[gi * 8 + i]; if (i != i0 && x > v1) { v1 = x; i1 = i; } }
            const float w0 = 1.f / (1.f + __expf(v1 - v0)), w1 = 1.f - w0;
            const int row = row0 + tid, e0 = gi * 8 + i0, e1 = gi * 8 + i1;
            EXP[row * 2] = e0; EXP[row * 2 + 1] = e1; GATE[row * 2] = w0 * ggate; GATE[row * 2 + 1] = w1 * ggate;
            __hip_atomic_fetch_add(&hist[e0], 1, __ATOMIC_RELAXED, __HIP_MEMORY_SCOPE_WORKGROUP); __hip_atomic_fetch_add(&hist[e1], 1, __ATOMIC_RELAXED, __HIP_MEMORY_SCOPE_WORKGROUP);
        }
        __syncthreads();
        if (tid < 32) CNT[tile * 32 + tid] = hist[tid];
    }
#undef LN_LOAD
#undef LN_UNPACK
}

__device__ __forceinline__ void phase_route(LAS unsigned char* lds, const int tid_in, int bid, int G) {
    const Params P = kparams();
    unsigned char* ws = P.ws;
    int* ctl = (int*)(ws + WS_CTL); const int* CNT = ctl + CTL_CNT;
    const int* EXP = (const int*)(ws + WS_ROUTE); int* rowtok = (int*)(ws + WS_ROUTE + 512 * 1024); int* slotrow = (int*)(ws + WS_ROUTE + 1024 * 1024);
    int tid = tid_in; asm volatile("" : "+v"(tid));
    const int lane = tid & 63, w = __builtin_amdgcn_readfirstlane(tid >> 6);
    LAS int* tab = (LAS int*)lds;
    LAS int* csum = (LAS int*)(lds + 131072);
    LAS int* cbase = (LAS int*)(lds + 131072 + 2048);
    typedef int i32x4 __attribute__((ext_vector_type(4)));
#pragma unroll 4
    for (int i = tid; i < LN_TILES * 32 / 4; i += NTHREADS) ((LAS i32x4*)tab)[i] = ((const i32x4*)CNT)[i];
    __syncthreads();
    const int e = tid & 31, ch = tid >> 5;
    { int run = 0;
#pragma unroll 8
      for (int t = 0; t < 64; ++t) { LAS int* p = tab + (ch * 64 + t) * 32 + e; const int v = *p; *p = run; run += v; }
      csum[ch * 32 + e] = run; }
    __syncthreads();
    if (tid < 32) { int run = 0; for (int c = 0; c < 16; ++c) { const int v = csum[c * 32 + tid]; cbase[c * 32 + tid] = run; run += v; } csum[tid] = run;   }
    __syncthreads();
    if (tid == 0) { int off = 0; for (int x = 0; x < NE; ++x) { const int p = (csum[x] + MB - 1) / MB * MB; csum[32 + x] = off;
            if (bid == 0) for (int r = off / MB; r < (off + p) / MB; ++r) ctl[128 + r] = x;
            off += p; }
        if (bid == 0) { ctl[96] = off; ctl[97] = off / MB; } }
    __syncthreads();
    for (int tile = bid * NWAVES + w; tile < LN_TILES; tile += G * NWAVES) {
        const int slot = tile * 64 + lane, ex = EXP[slot];
        int rank = 0;
        for (int x = 0; x < NE; ++x) { const unsigned long long m = __ballot(ex == x); if (ex == x) rank = __popcll(m & ((1ull << lane) - 1ull)); }
        const int row = csum[32 + ex] + cbase[(tile >> 6) * 32 + ex] + tab[tile * 32 + ex] + rank;
        rowtok[row] = slot; slotrow[slot] = row;
    }
}

__device__ __forceinline__ void phase_combine(int layer, const int tid_in, int bid, int G, bool dry = false) {
    const Params P = kparams();
    unsigned char* ws = P.ws;
    bf16_t* XB = (bf16_t*)(ws + WS_XB); float* Xo = P.out; const bf16_t* YS = (const bf16_t*)(ws + WS_M + M_YS);
    const float* GATE = (const float*)(ws + WS_ROUTE + 256 * 1024); const int* slotrow = (const int*)(ws + WS_ROUTE + 1024 * 1024);
    const float* g = P.in[20] + (size_t)(layer * 2 + 1) * D; const float* b = P.in[21] + (size_t)(layer * 2 + 1) * D;
    int tid = tid_in; asm volatile("" : "+v"(tid));
    const int lane = tid & 63, w = __builtin_amdgcn_readfirstlane(tid >> 6);
    const int NW = G * NWAVES;
    for (int rowa = bid * NWAVES + w; rowa < T; rowa += 2 * NW) {
        int rows[2]; rows[0] = rowa; rows[1] = rowa + NW;
        f32x4 v[2][4]; float s[2];
#pragma unroll
        for (int q = 0; q < 2; ++q) {
            const int row = rows[q] < T ? rows[q] : rowa;
            const float g0 = GATE[row * 2], g1 = GATE[row * 2 + 1];
            const v2u* xr = (const v2u*)(XB + (size_t)row * D);
            const v2u* y0 = (const v2u*)(YS + (size_t)slotrow[row * 2] * D);
            const v2u* y1 = (const v2u*)(YS + (size_t)slotrow[row * 2 + 1] * D);
            s[q] = 0.f;
#pragma unroll
            for (int j = 0; j < 4; ++j) { const v2u xx = NT_LOAD_S(1, xr + lane + 64 * j), a = NT_LOAD_S(1, y0 + lane + 64 * j), c = NT_LOAD_S(1, y1 + lane + 64 * j);
                const f32x4 x = {__uint_as_float(xx.x << 16), __uint_as_float(xx.x & 0xffff0000u), __uint_as_float(xx.y << 16), __uint_as_float(xx.y & 0xffff0000u)};
                const f32x4 fa = {__uint_as_float(a.x << 16), __uint_as_float(a.x & 0xffff0000u), __uint_as_float(a.y << 16), __uint_as_float(a.y & 0xffff0000u)};
                const f32x4 fc = {__uint_as_float(c.x << 16), __uint_as_float(c.x & 0xffff0000u), __uint_as_float(c.y << 16), __uint_as_float(c.y & 0xffff0000u)};
                v[q][j] = x * ALPHA + (fa * g0 + fc * g1);
                s[q] += (v[q][j][0] + v[q][j][1]) + (v[q][j][2] + v[q][j][3]); }
        }
#pragma unroll
        for (int q = 0; q < 2; ++q) {
            if (rows[q] >= T) continue;
            const int row = rows[q];
            const float mean = wave_sum(s[q]) * (1.f / D);
            float qq = 0.f;
#pragma unroll
            for (int j = 0; j < 4; ++j) { v[q][j] = v[q][j] - mean; qq += (v[q][j][0] * v[q][j][0] + v[q][j][1] * v[q][j][1]) + (v[q][j][2] * v[q][j][2] + v[q][j][3] * v[q][j][3]); }
            const float rstd = 1.f / sqrtf(wave_sum(qq) * (1.f / D) + LN_EPS);
#pragma unroll
            for (int j = 0; j < 4; ++j) { const f32x4 gg = ((const f32x4*)g)[lane + 64 * j], bb = ((const f32x4*)b)[lane + 64 * j];
                const f32x4 y = v[q][j] * rstd * gg + bb;
                if (layer == 0) ((v2u*)(XB + (size_t)row * D))[lane + 64 * j] = (v2u){pk2(y[0], y[1]), pk2(y[2], y[3])};
                else __builtin_nontemporal_store(y, (f32x4*)(Xo + (size_t)row * D) + lane + 64 * j); }
        }
    }
}
constexpr int ATT_KSTR = 144;
constexpr int ATT_VSTR = 528;
constexpr int ATT_K_OFF = 0, ATT_V_OFF = 256 * ATT_KSTR;
template <int VAR = 0> __device__ __forceinline__ void phase_attn(LAS unsigned char* lds, const int tid_in, int bid, int G) {
    const Params P = kparams();
    unsigned char* ws = P.ws;
    const bf16_t* QKV = (const bf16_t*)(ws + WS_M + M_QKV); bf16_t* O = (bf16_t*)(ws + WS_M + M_O);
    const float* sinks = P.in[11];
    int tid = tid_in; asm volatile("" : "+v"(tid));
    const int lane = tid & 63, w = __builtin_amdgcn_readfirstlane(tid >> 6), fr = lane & 15, fq = lane >> 4;
    const int g = w >> 1, qh = w & 1;
    const int vcu = (G % 8 == 0) ? (bid % 8) * (G / 8) + bid / 8 : bid;
    LAS unsigned char* Kl = lds + ATT_K_OFF; LAS unsigned char* Vl = lds + ATT_V_OFF;
    const float L2E = 1.4426950408889634f;
    v4u kvr[4], vvr[4];
#pragma unroll
    for (int it = 0; it < 4; ++it) { kvr[it] = (v4u){0u, 0u, 0u, 0u}; vvr[it] = (v4u){0u, 0u, 0u, 0u}; }
    for (int L = vcu * 4; L < BATCH * 4 * 16; L += G * 4) {
      for (int u4 = 0; u4 < 4; ++u4) {
        const int unit = L + u4; if (unit >= BATCH * 4 * 16) break;
        const int nb = unit & 15, kvh = (unit >> 4) & 3, b = unit >> 6;
        const int h = kvh * 4 + g;
        const float slope2 = __builtin_amdgcn_exp2f(-0.5f * (float)(h + 1)) * L2E, sink2 = sinks[h] * L2E;
        const long rowbase = (long)b * SEQ + nb * 128 - 128;
        if (u4 == 0) {
#pragma unroll
            for (int it = 0; it < 4; ++it) {
                const int c = tid + it * NTHREADS, sj = c >> 3, ch = c & 7;
                kvr[it] = (v4u){0u, 0u, 0u, 0u}; vvr[it] = (v4u){0u, 0u, 0u, 0u};
                if (!(VAR & 1) && (nb > 0 || sj >= 128)) { const bf16_t* rp = QKV + (size_t)(rowbase + sj) * QKVD + kvh * 64 + ch * 8; kvr[it] = *(const v4u*)(rp + 1024); vvr[it] = *(const v4u*)(rp + 1280); }
            }
        }
        __syncthreads();
#pragma unroll
        for (int it = 0; it < 4; ++it) {
            const int c = tid + it * NTHREADS, sj = c >> 3, ch = c & 7;
            *(LAS v4u*)(Kl + sj * ATT_KSTR + ch * 16) = kvr[it];
            LAS bf16_t* vt = (LAS bf16_t*)(Vl + (ch * 8) * ATT_VSTR) + (sj ^ (ch << 2));
            const v4u vv = vvr[it];
#pragma unroll
            for (int e = 0; e < 8; ++e) vt[e * (ATT_VSTR / 2)] = (bf16_t)(vv[e >> 1] >> (16 * (e & 1)));
        }
        __syncthreads();
        if (u4 < 3 && unit + 1 < BATCH * 4 * 16) {
            const long rb2 = rowbase + 128;
#pragma unroll
            for (int it = 0; it < 4; ++it) {
                const int c = tid + it * NTHREADS, sj = c >> 3, ch = c & 7;
                const bf16_t* rp = QKV + (size_t)(rb2 + sj) * QKVD + kvh * 64 + ch * 8;
                if (!(VAR & 1)) { kvr[it] = *(const v4u*)(rp + 1024); vvr[it] = *(const v4u*)(rp + 1280); }
            }
        }
#pragma unroll 1
        for (int it = 0; it < 2; ++it) {
            const int kb = 4 * qh + 2 * it;
            const int qrow0 = 64 * qh + 32 * it;
            bf16x8 qf[2][2];
#pragma unroll
            for (int qt = 0; qt < 2; ++qt)
#pragma unroll
                for (int ds = 0; ds < 2; ++ds)
                    qf[qt][ds] = NT_LOAD_S(3, (const bf16x8*)(QKV + (size_t)(rowbase + 128 + qrow0 + 16 * qt + fr) * QKVD + h * 64 + 32 * ds + 8 * fq));
            f32x4 acc[2][9];
#pragma unroll
            for (int qt = 0; qt < 2; ++qt)
#pragma unroll
                for (int i = 0; i < 9; ++i) acc[qt][i] = (f32x4){0.f, 0.f, 0.f, 0.f};
#pragma unroll
            for (int u = 0; u < 10; ++u)
#pragma unroll
                for (int ds = 0; ds < 2; ++ds) {
                    const bf16x8 kf = *(const LAS bf16x8*)(Kl + (16 * (kb + u) + fr) * ATT_KSTR + ds * 64 + fq * 16);
                    if (u <= 8) acc[0][u] = __builtin_amdgcn_mfma_f32_16x16x32_bf16(kf, qf[0][ds], acc[0][u], 0, 0, 0);
                    if (u >= 1) acc[1][u - 1] = __builtin_amdgcn_mfma_f32_16x16x32_bf16(kf, qf[1][ds], acc[1][u - 1], 0, 0, 0);
                }
#pragma unroll
            for (int qt = 0; qt < 2; ++qt) {
                const int kt0 = kb + qt;
                const int q = qrow0 + 16 * qt + fr;
                float m = -INFINITY;
                const float abias = -slope2 * (float)(fr - 4 * fq);
#pragma unroll
                for (int i = 0; i < 9; ++i)
#pragma unroll
                    for (int r = 0; r < 4; ++r) {
                        const int e = 4 * fq + r;
                        bool ok = (i == 0) ? (e > fr) : (i == 8) ? (e <= fr) : true;
                        if (nb == 0) ok = ok && (kt0 + i >= 8);
                        const float s = (VAR & 2) ? acc[qt][i][r] : (ok ? acc[qt][i][r] + __builtin_fmaf(slope2, (float)(r - 16 * (8 - i)), abias) : -INFINITY);
                        acc[qt][i][r] = s; m = fmaxf(m, s);
                    }
                m = fmaxf(m, __shfl_xor(m, 16)); m = fmaxf(m, __shfl_xor(m, 32));
                m = fmaxf(m, sink2);
                float l = 0.f;
                unsigned pk[10][2];
#pragma unroll
                for (int i = 0; i < 9; ++i) {
                    float p[4];
#pragma unroll
                    for (int r = 0; r < 4; ++r) { p[r] = (VAR & 2) ? acc[qt][i][r] : __builtin_amdgcn_exp2f(acc[qt][i][r] - m); l += p[r]; }
                    pk[i][0] = pg8::cvt_pk_bf16(p[0], p[1]); pk[i][1] = pg8::cvt_pk_bf16(p[2], p[3]);
                }
                pk[9][0] = 0u; pk[9][1] = 0u;
                l += __shfl_xor(l, 16); l += __shfl_xor(l, 32);
                l += __builtin_amdgcn_exp2f(sink2 - m);
                const float rl = 1.f / l;
                f32x4 oacc[4];
#pragma unroll
                for (int dt = 0; dt < 4; ++dt) oacc[dt] = (f32x4){0.f, 0.f, 0.f, 0.f};
#pragma unroll
                for (int c = 0; c < 5; ++c) {
                    const int i0 = 2 * c, i1 = (c < 4) ? 2 * c + 1 : 7;
                    const bf16x8 pf = __builtin_bit_cast(bf16x8, (v4u){pk[i0][0], pk[i0][1], pk[2 * c + 1][0], pk[2 * c + 1][1]});
#pragma unroll
                    for (int dt = 0; dt < 4; ++dt) {
                        const LAS unsigned char* vr = Vl + (16 * dt + fr) * ATT_VSTR;
                        const int vsw = (((16 * dt + fr) >> 3) & 7) << 3;
                        const v2u a0 = *(const LAS v2u*)(vr + ((32 * (kt0 + i0) + 8 * fq) ^ vsw)), a1 = *(const LAS v2u*)(vr + ((32 * (kt0 + i1) + 8 * fq) ^ vsw));
                        const bf16x8 vf = __builtin_bit_cast(bf16x8, (v4u){a0.x, a0.y, a1.x, a1.y});
                        oacc[dt] = __builtin_amdgcn_mfma_f32_16x16x32_bf16(vf, pf, oacc[dt], 0, 0, 0);
                    }
                }
                bf16_t* orow = O + (size_t)(rowbase + 128 + q) * D + h * 64 + 4 * fq;
#pragma unroll
                for (int dt = 0; dt < 4; ++dt) st8_wt(orow + 16 * dt, (v2u){pg8::cvt_pk_bf16(oacc[dt][0] * rl, oacc[dt][1] * rl), pg8::cvt_pk_bf16(oacc[dt][2] * rl, oacc[dt][3] * rl)});
            }
        }
      }
    }
}
constexpr int RG_GF_OFF = 0;
constexpr int RG_C_OFF = 25600;
constexpr int RG_TOT_OFF = 25600 + 2560;
constexpr int RG_RS = 176;
constexpr int RG_X_OFF = 35840, RG_XB = 131 * RG_RS + 48;
constexpr int RG_G_OFF = RG_X_OFF + 2 * RG_XB, RG_GB = 128 * RG_RS;
constexpr int RG_Y_OFF = RG_G_OFF + 2 * RG_GB;
static_assert(RG_Y_OFF + RG_GB <= 163840 - 16, "RG-LRU LDS map");
#ifndef BG_IN_RGLRU
#define BG_IN_RGLRU 0
#endif
#ifndef BG_NTST
#define BG_NTST 0
#endif
#if BG_NTST
#define BG_ST(v, p) __builtin_nontemporal_store(v, p)
#else
#define BG_ST(v, p) (*(p) = (v))
#endif
constexpr int BG_CHUNKS = 3 * NE * 512;
struct BgChunk { const float* src; bf16_t* dst; int nstride; };
__device__ __forceinline__ BgChunk bg_decode(const Params& P, int layer, int id, int lane) {
    const int me = id >> 9, q = id & 511, mat = me % 3, e = me / 3;
    BgChunk c;
    if (mat < 2) { const int nb = q >> 6, kb = q & 63, n = nb * 64 + lane;
        c.src = (mat ? P.in[18] : P.in[17]) + ((size_t)layer * NE + e) * (size_t)(D * DE) + (size_t)(kb * 16) * DE + n; c.nstride = DE;
        c.dst = (bf16_t*)(P.ws + WS_W13) + ((size_t)layer * NE + e) * (size_t)(D * D) + (size_t)((n >> 7) * 256 + mat * 128 + (n & 127)) * D + kb * 16; }
    else { const int nb = q >> 5, kb = q & 31, n = nb * 64 + lane;
        c.src = P.in[19] + ((size_t)layer * NE + e) * (size_t)(D * DE) + (size_t)(kb * 16) * D + n; c.nstride = D;
        c.dst = (bf16_t*)(P.ws + WS_W2) + ((size_t)layer * NE + e) * (size_t)(D * DE) + (size_t)n * DE + kb * 16; }
    return c;
}
__device__ __forceinline__ float fast_sigmoid(float x) { return __builtin_amdgcn_rcpf(1.f + __builtin_amdgcn_exp2f(-1.4426950408889634f * x)); }
template <int VAR = 0> __device__ __forceinline__ void phase_rglru(LAS unsigned char* lds, const int tid_in, int bid, int G, bool dry = false) {
    const Params P = kparams();
    unsigned char* ws = P.ws;
    const bf16_t* Gt = (const bf16_t*)(ws + WS_M + M_G); bf16_t* Yo = dry ? (bf16_t*)P.out : (bf16_t*)(ws + WS_M + M_G); const bf16_t* XR = (const bf16_t*)(ws + WS_M + M_XR);
    int tid = tid_in; asm volatile("" : "+v"(tid));
    const int lane = tid & 63, w = __builtin_amdgcn_readfirstlane(tid >> 6), fr = lane & 15, fq = lane >> 4;
    LAS v2u* gfl = (LAS v2u*)(lds + RG_GF_OFF);
    LAS float* cst = (LAS float*)(lds + RG_C_OFF);
    LAS float* tot = (LAS float*)(lds + RG_TOT_OFF);
    LAS float* hinb = (LAS float*)(lds + RG_TOT_OFF + 5120);
    const int vcu = (G % 8 == 0) ? (bid % 8) * (G / 8) + bid / 8 : bid;
    int xro[3], gro[3];
    unsigned xgo[3];
#pragma unroll
    for (int i = 0; i < 3; ++i) { const int idx = tid + i * NTHREADS, rw = idx / 10, ch = idx % 10;
        xro[i] = (idx < 1310) ? rw * RG_RS + ch * 16 : -1; gro[i] = (idx < 1280) ? rw * RG_RS + ch * 16 : -1; xgo[i] = (unsigned)(rw * DR + ch * 8); }
    const int bg_cpw = (BG_CHUNKS + G * NWAVES - 1) / (G * NWAVES);
    int bg_next = (bid * NWAVES + w) * bg_cpw, bg_end = bg_next + bg_cpw; if (bg_end > BG_CHUNKS) bg_end = BG_CHUNKS; if (!BG_IN_RGLRU || dry) bg_next = bg_end;
    float bgv[2][16]; bf16_t* bgd[2]; bool bgh[2];
#pragma unroll
    for (int s = 0; s < 2; ++s) { bgd[s] = nullptr; bgh[s] = false;
#pragma unroll
        for (int k = 0; k < 16; ++k) bgv[s][k] = 0.f; }
#define BG_ISSUE(s) do { bgh[s] = bg_next < bg_end; if (bgh[s]) { const BgChunk c_ = bg_decode(P, 0, bg_next, lane); ++bg_next; bgd[s] = c_.dst; \
        _Pragma("unroll") for (int k = 0; k < 16; ++k) bgv[s][k] = __builtin_nontemporal_load(c_.src + (size_t)k * c_.nstride); } } while (0)
#define BG_FINISH(s) do { if (bgh[s]) { v4u o0_, o1_; \
        o0_.x = pg8::cvt_pk_bf16(bgv[s][0], bgv[s][1]); o0_.y = pg8::cvt_pk_bf16(bgv[s][2], bgv[s][3]); o0_.z = pg8::cvt_pk_bf16(bgv[s][4], bgv[s][5]); o0_.w = pg8::cvt_pk_bf16(bgv[s][6], bgv[s][7]); \
        o1_.x = pg8::cvt_pk_bf16(bgv[s][8], bgv[s][9]); o1_.y = pg8::cvt_pk_bf16(bgv[s][10], bgv[s][11]); o1_.z = pg8::cvt_pk_bf16(bgv[s][12], bgv[s][13]); o1_.w = pg8::cvt_pk_bf16(bgv[s][14], bgv[s][15]); \
        BG_ST(o0_, (v4u*)bgd[s]); BG_ST(o1_, (v4u*)bgd[s] + 1); bgh[s] = false; } } while (0)
    for (int unit = vcu; unit < BATCH * 16; unit += G) {
        const int b = unit >> 4, n = unit & 15;
        const bf16_t* xbase = XR + ((size_t)b * SEQ) * DR + n * 80; const bf16_t* gbase = Gt + ((size_t)b * SEQ) * DR + n * 80; bf16_t* ybase = Yo + ((size_t)b * SEQ) * DR + n * 80;
#define RG_FETCH(rr) do { _Pragma("unroll") for (int i = 0; i < 3; ++i) { xs[i] = (v4u){0u, 0u, 0u, 0u}; gs[i] = (v4u){0u, 0u, 0u, 0u}; \
            if (xro[i] >= 0 && ((rr) > 0 || xro[i] >= 3 * RG_RS)) xs[i] = NT_LOAD_S(2, (const v4u*)(xbase + (long)(128 * (rr) - 3) * DR + xgo[i])); \
            if (gro[i] >= 0) gs[i] = NT_LOAD_S(2, (const v4u*)(gbase + (size_t)(128 * (rr)) * DR + xgo[i])); } } while (0)
#define RG_STASH(bufi) do { _Pragma("unroll") for (int i = 0; i < 3; ++i) { \
            if (xro[i] >= 0) *(LAS v4u*)(lds + RG_X_OFF + (bufi) * RG_XB + xro[i]) = xs[i]; \
            if (gro[i] >= 0) *(LAS v4u*)(lds + RG_G_OFF + (bufi) * RG_GB + gro[i]) = gs[i]; } } while (0)
#define RG_YSTORE(rr) do { _Pragma("unroll") for (int i = 0; i < 3; ++i) { if (gro[i] >= 0) \
            st16_wt(ybase + (size_t)(128 * (rr)) * DR + xgo[i], *(const LAS v4u*)(lds + RG_Y_OFF + gro[i])); } } while (0)
        v4u xs[3], gs[3];
        __syncthreads();
        RG_FETCH(0);
        { const v2u* GF = (const v2u*)(ws + WS_GF);
          for (int i = tid; i < 2 * 1600; i += NTHREADS) { const int mat = i / 1600, rem = i % 1600; gfl[i] = GF[(size_t)(mat * 16 + n) * 1600 + rem]; }
          if (tid < 80) { const int c = n * 80 + tid;
              cst[0 * 80 + tid] = P.in[2][0 * DR + c]; cst[1 * 80 + tid] = P.in[2][1 * DR + c]; cst[2 * 80 + tid] = P.in[2][2 * DR + c]; cst[3 * 80 + tid] = P.in[2][3 * DR + c];
              cst[4 * 80 + tid] = P.in[3][c]; cst[5 * 80 + tid] = P.in[5][c]; cst[6 * 80 + tid] = P.in[7][c];
              cst[7 * 80 + tid] = -8.0f * log1pf(expf(-P.in[8][c])) * 1.4426950408889634f; } }
        RG_STASH(0);
        __syncthreads();
        float hcar = 0.f;
#pragma unroll 1
        for (int r = 0; r < SEQ / 128; ++r) {
            const LAS unsigned char* xb = lds + RG_X_OFF + (r & 1) * RG_XB + (16 * w + fr) * RG_RS + 8 * fq;
            const LAS unsigned char* gb = lds + RG_G_OFF + (r & 1) * RG_GB + (16 * w + fr) * RG_RS + 8 * fq;
            if (!(VAR & 2)) { if (r + 1 < SEQ / 128) RG_FETCH(r + 1); }
            BG_FINISH(0); BG_FINISH(1); BG_ISSUE(0); BG_ISSUE(1);
            float xc[5][4]; s16x4 bfr[5];
#pragma unroll
            for (int ks = 0; ks < 5; ++ks) {
                const int c0 = 16 * ks + 4 * fq;
                f32x4 s = *(LAS f32x4*)(cst + 4 * 80 + c0);
#pragma unroll
                for (int k = 0; k < 4; ++k) { const f32x4 wv = *(LAS f32x4*)(cst + k * 80 + c0); const v2u x = *(const LAS v2u*)(xb + k * RG_RS + 32 * ks);
                    s[0] += __uint_as_float(x.x << 16) * wv[0]; s[1] += __uint_as_float(x.x & 0xffff0000u) * wv[1]; s[2] += __uint_as_float(x.y << 16) * wv[2]; s[3] += __uint_as_float(x.y & 0xffff0000u) * wv[3]; }
#pragma unroll
                for (int j = 0; j < 4; ++j) xc[ks][j] = s[j];
                bfr[ks] = __builtin_bit_cast(s16x4, (v2u){pg8::cvt_pk_bf16(s[0], s[1]), pg8::cvt_pk_bf16(s[2], s[3])});
            }
            f32x4 ra[5], ia[5];
#pragma unroll
            for (int jt = 0; jt < 5; ++jt) { ra[jt] = (f32x4){0.f, 0.f, 0.f, 0.f}; ia[jt] = (f32x4){0.f, 0.f, 0.f, 0.f};
#pragma unroll
                for (int ks = 0; ks < 5; ++ks) {
                    const s16x4 ar = __builtin_bit_cast(s16x4, gfl[(jt * 5 + ks) * 64 + lane]), ai = __builtin_bit_cast(s16x4, gfl[1600 + (jt * 5 + ks) * 64 + lane]);
                    ra[jt] = __builtin_amdgcn_mfma_f32_16x16x16bf16_1k(ar, bfr[ks], ra[jt], 0, 0, 0);
                    ia[jt] = __builtin_amdgcn_mfma_f32_16x16x16bf16_1k(ai, bfr[ks], ia[jt], 0, 0, 0);
                } }
            float A[5][4], U[5][4];
#pragma unroll
            for (int jt = 0; jt < 5; ++jt) {
                const int c0 = 16 * jt + 4 * fq;
                const f32x4 brv = *(LAS f32x4*)(cst + 5 * 80 + c0), biv = *(LAS f32x4*)(cst + 6 * 80 + c0), cav = *(LAS f32x4*)(cst + 7 * 80 + c0);
#pragma unroll
                for (int j = 0; j < 4; ++j) {
                    const float rg = fast_sigmoid(ra[jt][j] + brv[j]), ig = fast_sigmoid(ia[jt][j] + biv[j]);
                    const float la2 = rg * cav[j];
                    float a = __builtin_amdgcn_exp2f(la2);
                    float u = __builtin_amdgcn_sqrtf(fmaxf(1.f - a * a, 0.f)) * (ig * xc[jt][j]);
                    A[jt][j] = a; U[jt][j] = u;
                }
#define RG_SCAN4(S) asm volatile("s_nop 1\n\t" \
                    "v_fmac_f32_dpp %0, %0, %4 row_shr:" #S " row_mask:0xf bank_mask:0xf\n\tv_fmac_f32_dpp %1, %1, %5 row_shr:" #S " row_mask:0xf bank_mask:0xf\n\t" \
                    "v_fmac_f32_dpp %2, %2, %6 row_shr:" #S " row_mask:0xf bank_mask:0xf\n\tv_fmac_f32_dpp %3, %3, %7 row_shr:" #S " row_mask:0xf bank_mask:0xf\n\t" \
                    "v_mul_f32_dpp %4, %4, %4 row_shr:" #S " row_mask:0xf bank_mask:0xf\n\tv_mul_f32_dpp %5, %5, %5 row_shr:" #S " row_mask:0xf bank_mask:0xf\n\t" \
                    "v_mul_f32_dpp %6, %6, %6 row_shr:" #S " row_mask:0xf bank_mask:0xf\n\tv_mul_f32_dpp %7, %7, %7 row_shr:" #S " row_mask:0xf bank_mask:0xf" \
                    : "+v"(U[jt][0]), "+v"(U[jt][1]), "+v"(U[jt][2]), "+v"(U[jt][3]), "+v"(A[jt][0]), "+v"(A[jt][1]), "+v"(A[jt][2]), "+v"(A[jt][3]))
                RG_SCAN4(1); RG_SCAN4(2); RG_SCAN4(4); RG_SCAN4(8);
#undef RG_SCAN4
            }
            if (fr == 15) {
#pragma unroll
                for (int jt = 0; jt < 5; ++jt)
#pragma unroll
                    for (int j = 0; j < 4; j += 2) *(LAS f32x4*)(tot + w * 160 + (16 * jt + 4 * fq + j) * 2) = (f32x4){A[jt][j], U[jt][j], A[jt][j + 1], U[jt][j + 1]};
            }
            if (!(VAR & 1)) __syncthreads();
            if (tid < 80) {
#pragma unroll
                for (int ww = 0; ww < 8; ++ww) { const f32x2v q = *(LAS f32x2v*)(tot + ww * 160 + tid * 2); hinb[ww * 80 + tid] = hcar; hcar = q.x * hcar + q.y; }
            }
            if (r > 0) RG_YSTORE(r - 1);
            if (!(VAR & 2)) { if (r + 1 < SEQ / 128) RG_STASH((r + 1) & 1); }
            if (!(VAR & 1)) __syncthreads();
#pragma unroll
            for (int jt = 0; jt < 5; ++jt) {
                const f32x4 hq = *(LAS f32x4*)(hinb + w * 80 + 16 * jt + 4 * fq);
                const v2u gv = *(const LAS v2u*)(gb + 32 * jt);
                float y[4];
#pragma unroll
                for (int j = 0; j < 4; ++j) {
                    const float h = A[jt][j] * hq[j] + U[jt][j];
                    const unsigned gw = (j < 2) ? gv.x : gv.y;
                    const float gt = (j & 1) ? __uint_as_float(gw & 0xffff0000u) : __uint_as_float(gw << 16);
                    const float uu = 0.7978845608028654f * (gt + 0.044715f * gt * gt * gt);
                    y[j] = h * gt * __builtin_amdgcn_rcpf(1.f + __builtin_amdgcn_exp2f(-2.885390081777927f * uu));
                }
                *(LAS v2u*)(lds + RG_Y_OFF + (16 * w + fr) * RG_RS + 8 * fq + 32 * jt) = (v2u){pg8::cvt_pk_bf16(y[0], y[1]), pg8::cvt_pk_bf16(y[2], y[3])};
            }
        }
        __syncthreads();
        RG_YSTORE(SEQ / 128 - 1);
#undef RG_FETCH
#undef RG_STASH
#undef RG_YSTORE
    }
    BG_FINISH(0); BG_FINISH(1);
    while (bg_next < bg_end) { BG_ISSUE(0); BG_FINISH(0); }
#undef BG_ISSUE
#undef BG_FINISH
}
#ifndef PROBE_MASK
#define PROBE_MASK 0
#endif
#ifndef PROBE_VAR
#define PROBE_VAR 0
#endif
#ifndef PROBE_PFX_NULL
#define PROBE_PFX_NULL 0
#endif
#ifndef PROBE_DOWNVAR
#define PROBE_DOWNVAR 0
#endif
#if PROBE_DOWNVAR
#define DOWNVAR_CALL phase_moe_down_var<PROBE_DOWNVAR>(0, lds, tid_in, bid, G);
#else
#define DOWNVAR_CALL
#endif
#ifndef PROBE_UPVAR
#define PROBE_UPVAR 0
#endif
#if PROBE_UPVAR == 1
#define UPVAR_CALL phase_moe_up_null<true>(0, lds, tid_in, bid, G);
#elif PROBE_UPVAR == 2
#define UPVAR_CALL phase_moe_up_null<false>(0, lds, tid_in, bid, G);
#else
#define UPVAR_CALL
#endif
#ifndef PROBE_HALFLN
#define PROBE_HALFLN 0
#endif
#ifndef PROBE_DRY
#define PROBE_DRY 0
#endif
struct Args { Params P; int ph_lo, ph_hi; };
__device__ __forceinline__ int lane_id_now() { int l; asm volatile("v_mbcnt_lo_u32_b32 %0, -1, 0\n\tv_mbcnt_hi_u32_b32 %0, -1, %0" : "=v"(l)); return l; }
__global__ void __launch_bounds__(NTHREADS, 2) mk_fwd(Args a) {
    extern __shared__ __attribute__((aligned(16))) unsigned char lds_raw[];
    LAS unsigned char* lds = (LAS unsigned char*)lds_raw;
    const int wv = __builtin_amdgcn_readfirstlane(threadIdx.x >> 6);
#define MYTID(wvv) ((wvv) * 64 + lane_id_now())
    volatile LAS unsigned* bst = (volatile LAS unsigned*)(lds + LDS_BYTES - 16);
    { const int t0 = MYTID(wv); if (t0 < 4) bst[t0] = 0u;
      __syncthreads();
      const Params P0 = kparams(); (void)xcd_barrier_post((unsigned*)(P0.ws + WS_BAR), bst, t0); }
#define SEAM(ph) do { if (hi > PH_COUNT) cg::this_grid().sync();   { const Params Pb = kparams(); XcdBarrier xb; xb.bar = (unsigned*)(Pb.ws + WS_BAR); xb.x = xb_xcc_id(); xb.st = bst; xcd_barrier(xb, tid_in); } } while (0)
#define RUN(ph, call) do { if (lo <= (ph) && (ph) < hi) { int bid = blockIdx.x, G = gridDim.x, wvl = wv; asm volatile("" : "+s"(bid), "+s"(G), "+s"(wvl)); const int tid_in = MYTID(wvl); \
        call; if ((PROBE_MASK >> (ph)) & 1) { call; } if ((ph) + 1 < hi && (ph) != PH_UP0 && (ph) != PH_UP1) SEAM(ph); } } while (0)
#define PHASE_PROGRAM \
    RUN(PH_PROLOGUE, phase_prologue(lds, tid_in, bid, G)); \
    RUN(PH_WIN, { if (pfx && PROBE_PFX_NULL) phase_gemm_win_null(lds, tid_in, bid, G); else phase_gemm_win(lds, tid_in, bid, G); }); \
    if ((PROBE_DRY >> PH_RGLRU) & 1) { int bid = blockIdx.x, G = gridDim.x; asm volatile("" : "+s"(bid), "+s"(G)); phase_rglru<PROBE_VAR>(lds, MYTID(wv), bid, G, true); } \
    RUN(PH_RGLRU, phase_rglru(lds, tid_in, bid, G)); \
    RUN(PH_WOUT, phase_gemm_wout(lds, tid_in, bid, G)); \
    RUN(PH_LN0, { if (PROBE_HALFLN == 1) phase_ln(0, lds, tid_in, bid, G, true); else if (PROBE_HALFLN == 2) { if ((bid & 7) < 4) phase_ln(0, lds, tid_in, (bid >> 3) * 4 + (bid & 7), G / 2, true); } phase_ln(0, lds, tid_in, bid, G); }); \
    RUN(PH_ROUTE0, phase_route(lds, tid_in, bid, G)); \
    RUN(PH_UP0, { UPVAR_CALL phase_moe_up(0, lds, tid_in, bid, G); }); \
    RUN(PH_DOWN0, { DOWNVAR_CALL phase_moe_down(0, lds, tid_in, bid, G); }); \
    RUN(PH_COMB0, phase_combine(0, tid_in, bid, G)); \
    RUN(PH_QKV, phase_gemm_qkv(lds, tid_in, bid, G)); \
    if ((PROBE_DRY >> PH_ATTN) & 1) { int bid = blockIdx.x, G = gridDim.x; asm volatile("" : "+s"(bid), "+s"(G)); phase_attn<PROBE_VAR>(lds, MYTID(wv), bid, G); } \
    RUN(PH_ATTN, phase_attn(lds, tid_in, bid, G)); \
    RUN(PH_WO, phase_gemm_wo(lds, tid_in, bid, G)); \
    RUN(PH_LN1, phase_ln(1, lds, tid_in, bid, G)); \
    RUN(PH_ROUTE1, phase_route(lds, tid_in, bid, G)); \
    RUN(PH_UP1, phase_moe_up(1, lds, tid_in, bid, G)); \
    RUN(PH_DOWN1, phase_moe_down(1, lds, tid_in, bid, G)); \
    RUN(PH_COMB1, phase_combine(1, tid_in, bid, G));
#ifdef PROBE_PREFIX
    { const int lo = 0, hi = PROBE_PREFIX; const bool pfx = true; PHASE_PROGRAM { const int tid_in = MYTID(wv); SEAM(0); } }
#endif
    { const int lo = a.ph_lo, hi = a.ph_hi; const bool pfx = false; PHASE_PROGRAM }
#ifdef PROBE_XBAR
    { const int hi = a.ph_hi; const int tid_in = MYTID(wv); for (int i = 0; i < PROBE_XBAR; ++i) SEAM(PH_COUNT - 1); }
#endif
#undef RUN
#undef SEAM
#undef MYTID
}
static int g_grid = 0;
extern "C" void kernel_launch(void* const* d_in, const int* in_sizes, int n_in, void* d_out, int out_size, void* d_ws, size_t ws_size, hipStream_t stream) {
    if (ws_size < WS_END || n_in < 22) { fprintf(stderr, "kernel_launch: workspace too small (%zu < %zu) or %d inputs\n", ws_size, (size_t)WS_END, n_in); return; }
    if (g_grid == 0) {
        int dev = 0, cus = 0, per_cu = 0;
        (void)hipGetDevice(&dev); (void)hipDeviceGetAttribute(&cus, hipDeviceAttributeMultiprocessorCount, dev);
        if (hipFuncSetAttribute((const void*)mk_fwd, hipFuncAttributeMaxDynamicSharedMemorySize, LDS_BYTES) != hipSuccess) fprintf(stderr, "kernel_launch: hipFuncSetAttribute failed\n");
        if (hipOccupancyMaxActiveBlocksPerMultiprocessor(&per_cu, (const void*)mk_fwd, NTHREADS, LDS_BYTES) != hipSuccess || per_cu < 1) { fprintf(stderr, "kernel_launch: occupancy query says %d blocks per CU\n", per_cu); per_cu = 1; }
        (void)hipGetLastError();
        g_grid = cus;
    }
    (void)hipMemsetAsync((unsigned char*)d_ws + WS_READY, 0, WS_BAR + 16384 - WS_READY, stream);
    Args a{};
    for (int i = 0; i < 22; ++i) a.P.in[i] = (const float*)d_in[i];
    a.P.out = (float*)d_out; a.P.ws = (unsigned char*)d_ws;
    a.ph_lo = 0; a.ph_hi = PH_COUNT;
    void* args[] = {&a};
    hipError_t e = hipLaunchCooperativeKernel((const void*)mk_fwd, dim3(g_grid), dim3(NTHREADS), args, LDS_BYTES, stream);
    if (e != hipSuccess) fprintf(stderr, "kernel_launch: cooperative launch failed: %s (grid %d)\n", hipGetErrorString(e), g_grid);
}
```

```cpp
#include <hip/hip_runtime.h>
#include <stdint.h>
#include <cstdio>
#include <hip/hip_cooperative_groups.h>
namespace cg = cooperative_groups;

typedef unsigned short bf16_t;
constexpr int D = 1024, BATCH = 16, SEQ = 2048, T = BATCH * SEQ;
constexpr int DR = 1280, BW = 80;
constexpr int NH = 16, HD = 64, WIN = 128;
constexpr int QKVD = 1536;
constexpr int NE = 32, DE = 512;
constexpr int MB = 256;
constexpr int TK = T * 2;
constexpr int NROWS_MAX = TK + NE * MB;
constexpr float ALPHA = 1.41421356237309515f;
constexpr float LN_EPS = 1e-5f;
constexpr float QSCALE = 0.125f * 1.4426950408889634f;

constexpr size_t MiB = 1u << 20;
constexpr size_t WS_CTL = 0;
constexpr size_t WS_READY = 256 * 1024, READY_BANK = 128 * 1024;
constexpr size_t WS_BAR = 512 * 1024;
constexpr size_t WS_WIN = 1 * MiB, WS_WOUT = 6 * MiB, WS_WQKV = 8 * MiB + 512 * 1024, WS_WO = 11 * MiB + 512 * 1024, WS_GF = 13 * MiB + 512 * 1024;
constexpr size_t WS_ROUTE = 14 * MiB;
constexpr int RF_BYTES = 147456;
constexpr size_t WS_RF = 15 * MiB + 512 * 1024, WS_RC = WS_RF + 2 * (size_t)RF_BYTES;
constexpr size_t WS_W13 = 16 * MiB, WS_W2 = 144 * MiB, WS_XB = 208 * MiB, WS_M = 272 * MiB, WS_END = 488 * MiB;
constexpr size_t M_G = 0, M_XR = 80 * MiB, M_TMP = 160 * MiB;
constexpr size_t M_QKV = 0, M_O = 96 * MiB;
constexpr size_t M_HDN = 0, M_YS = 72 * MiB;

__device__ __forceinline__ float bf2f(bf16_t v) { return __uint_as_float((unsigned)v << 16); }
__device__ __forceinline__ bf16_t f2bf(float f) { unsigned u = __float_as_uint(f); return (bf16_t)((u + 0x7fffu + ((u >> 16) & 1u)) >> 16); }


#ifndef WT_STORES
#define WT_STORES 0
#endif
typedef unsigned wt_v4u __attribute__((ext_vector_type(4)));
typedef unsigned wt_v2u __attribute__((ext_vector_type(2)));
__device__ __forceinline__ void st16_wt(void* p, wt_v4u v) {
#if WT_STORES
    asm volatile("global_store_dwordx4 %0, %1, off sc1\n\ts_nop 1" :: "v"(p), "v"(v) : "memory");
#else
    *(wt_v4u*)p = v;
#endif
}
__device__ __forceinline__ void st8_wt(void* p, wt_v2u v) {
#if WT_STORES
    asm volatile("global_store_dwordx2 %0, %1, off sc1\n\ts_nop 0" :: "v"(p), "v"(v) : "memory");
#else
    *(wt_v2u*)p = v;
#endif
}

#ifndef WT_GEMM
#define WT_GEMM 0
#endif
__device__ __forceinline__ void st16_gemm(void* p, wt_v4u v) {
#if WT_GEMM == 1
    asm volatile("global_store_dwordx4 %0, %1, off sc1\n\ts_nop 1" :: "v"(p), "v"(v) : "memory");
#elif WT_GEMM == 2
    asm volatile("global_store_dwordx4 %0, %1, off nt\n\ts_nop 1" :: "v"(p), "v"(v) : "memory");
#elif WT_GEMM == 3
    asm volatile("global_store_dwordx4 %0, %1, off sc0 sc1\n\ts_nop 1" :: "v"(p), "v"(v) : "memory");
#else
    *(wt_v4u*)p = v;
#endif
}

#ifndef NT_STREAMS
#define NT_STREAMS 1
#endif
#if NT_STREAMS
#define NT_LOAD(p) __builtin_nontemporal_load(p)
#else
#define NT_LOAD(p) (*(p))
#endif
#ifndef NT_RECENT
#define NT_RECENT 0
#endif
#if NT_RECENT
#define NT_LOAD_R(p) __builtin_nontemporal_load(p)
#else
#define NT_LOAD_R(p) (*(p))
#endif

#ifndef NT_SEL
#define NT_SEL 1
#endif
#define NT_LOAD_S(bit, p) (((NT_SEL >> (bit)) & 1) ? __builtin_nontemporal_load(p) : *(p))
#ifndef PG8_STAGGER_TICKS
#define PG8_STAGGER_TICKS 0
#endif
#ifndef PG8_CHUNKED
#define PG8_CHUNKED 0
#endif
#ifndef PG8_MOE_AUX_B
#define PG8_MOE_AUX_B 0
#endif
#ifndef PG8_DOWN_AUX
#define PG8_DOWN_AUX 16
#endif
#ifndef PG8_ROWMAJOR
#define PG8_ROWMAJOR 0
#endif
#ifndef PG8_XCDREMAP
#define PG8_XCDREMAP 1
#endif
#ifndef PG8_WGM
#define PG8_WGM 2
#endif
namespace pg8 {
#define PG8_LAS __attribute__((address_space(3)))
typedef short bf16x8 __attribute__((ext_vector_type(8)));
typedef float f32x4 __attribute__((ext_vector_type(4)));
typedef unsigned u32x4 __attribute__((ext_vector_type(4)));
typedef unsigned u32x2 __attribute__((ext_vector_type(2)));
constexpr int BM = 256, BK = 64, HALF = 128, HTB = HALF * BK * 2  , STAGE_BYTES = 8 * HTB, NXCD = 8, WGM = PG8_WGM;

__host__ __device__ __forceinline__ int lds_byte(int r, int c) { const int st = (r >> 4) * 2 + (c >> 5), rr = r & 15, cc = c & 31, ob = rr * 64 + cc * 2; return st * 1024 + (ob ^ (((ob >> 9) & 1) << 5)); }
__host__ __device__ __forceinline__ void stage_rc(int b, int& R, int& C) { const int st = b / 1024, sb = b % 1024, swz = sb ^ (((sb >> 9) & 1) << 5); R = (st >> 1) * 16 + swz / 64; C = (st & 1) * 32 + (swz % 64) / 2; }
__host__ __device__ __forceinline__ int perm32(int rho) { const int n = rho >> 4, i = rho & 15; return 8 * (i >> 2) + 4 * n + (i & 3); }

struct Unit { int pm, pn, li; };

template <int WGM_> __device__ __forceinline__ bool order_at(long L, int nM, int nN, Unit& u) {
    constexpr int WGM = WGM_;
    const int nwg = nM * nN; if (L >= nwg) return false;
    int wgid = (int)L; if (PG8_XCDREMAP) { const int q = nwg / NXCD, r = nwg % NXCD, xcd = wgid % NXCD, off = wgid / NXCD; wgid = (xcd < r ? xcd * (q + 1) : r * (q + 1) + (xcd - r) * q) + off; }
    const int nig = WGM * nN, gid = wgid / nig, fm = gid * WGM, gsz = (nM - fm) < WGM ? (nM - fm) : WGM;
    if (PG8_ROWMAJOR) { u.pm = fm + ((wgid % nig) / nN); u.pn = (wgid % nig) % nN; if (u.pm >= fm + gsz) { const int idx = wgid % nig; u.pm = fm + idx % gsz; u.pn = idx / gsz; } }
    else { u.pm = fm + ((wgid % nig) % gsz); u.pn = (wgid % nig) / gsz; }
    return true;
}
template <int WGM_> __device__ __forceinline__ bool order_next(int i, int G, int c, int nM, int nN, Unit& u) {
#if PG8_CHUNKED
    const int nwg = nM * nN, per = (nwg + G - 1) / G; if (i >= per) return false; return order_at<WGM_>((long)c * per + i, nM, nN, u);
#else
    return order_at<WGM_>((long)i * G + c, nM, nN, u);
#endif
}
template <int K_, int NN_, bool GATHER, bool EXPERT, int DEP = 0, int WGM_ = PG8_WGM>
struct Order {
    static constexpr int K = K_, nN = NN_, AUX_A = (DEP == 2) ? PG8_DOWN_AUX : 0, AUX_B = EXPERT ? PG8_MOE_AUX_B : 0;
    int nM, G, c; const char* A; const char* Bt; const int* block_e; const int* rowtok; unsigned* ready; unsigned need; const PG8_LAS int* tokl;
    __device__ __forceinline__ bool next(int i, Unit& u) const { return order_next<WGM_>(i, G, c, nM, nN, u); }
    __device__ __forceinline__ const char* a_base(const Unit& u) const { return GATHER ? A : A + (size_t)u.pm * BM * K * 2; }
    __device__ __forceinline__ const char* b_base(const Unit& u) const { return Bt + (EXPERT ? (size_t)block_e[u.pm] * (size_t)(nN * BM) * K * 2 : (size_t)0) + (size_t)u.pn * BM * K * 2; }
    __device__ __forceinline__ unsigned a_rowoff(const Unit& u, int r) const {
        if (GATHER) return (unsigned)tokl[u.li * BM + r] * (unsigned)(K * 2);
        return (unsigned)(r * K * 2);
    }
    __device__ __forceinline__ void fill_tokl(PG8_LAS int* dst, int tid) const {
        Unit u;
        for (int i = 0; next(i, u); ++i) if (tid < BM) { const int s = rowtok[u.pm * BM + tid]; dst[i * BM + tid] = s >= 0 ? (s >> 1) : 0; }
    }
    __device__ __forceinline__ void a_ready(const Unit& u, int tid) const {
        if (DEP == 2) {
            if (tid < 64) { unsigned spins = 0;
                while ((unsigned)__builtin_amdgcn_readfirstlane(__hip_atomic_load(ready + 64 * u.pm, __ATOMIC_RELAXED, __HIP_MEMORY_SCOPE_AGENT)) < need) { __builtin_amdgcn_s_sleep(2); if (++spins > (1u << 22)) break; } }
            asm volatile("" ::: "memory"); __builtin_amdgcn_s_barrier(); asm volatile("" ::: "memory");
        }
    }
    __device__ __forceinline__ void done(const Unit& u, int lane) const {
        if (DEP == 1) { asm volatile("s_waitcnt vmcnt(0)" ::: "memory"); if (lane == 0) __hip_atomic_fetch_add(ready + 64 * u.pm, 1u, __ATOMIC_RELAXED, __HIP_MEMORY_SCOPE_AGENT); }
    }
};

__device__ __forceinline__ unsigned cvt_pk_bf16(float lo, float hi) { unsigned r; asm volatile("v_cvt_pk_bf16_f32 %0, %1, %2" : "=v"(r) : "v"(lo), "v"(hi)); return r; }

__device__ __forceinline__ float gelu_tanh_fast(float x) { const float uu = 0.7978845608028654f * (x + 0.044715f * x * x * x); return x * __builtin_amdgcn_rcpf(1.f + __builtin_amdgcn_exp2f(-2.885390081777927f * uu)); }
__device__ __forceinline__ void store_full_lines(bf16_t* grp  , int ldc, int fr, int fq, const u32x4 (&w)[2]) {
    const bool lo = fr < 8;
    u32x4 snd, rcv;
#pragma unroll
    for (int k = 0; k < 4; ++k) { snd[k] = lo ? w[1][k] : w[0][k]; rcv[k] = (unsigned)__builtin_amdgcn_update_dpp(0, (int)snd[k], 0x128  , 0xF, 0xF, false); }
    u32x4 da, db;
#pragma unroll
    for (int k = 0; k < 4; ++k) { da[k] = lo ? w[0][k] : rcv[k]; db[k] = lo ? rcv[k] : w[1][k]; }
    bf16_t* p = grp + (size_t)(fr & 7) * ldc + (lo ? 0 : 32) + 8 * fq;
    *(u32x4*)p = da; *(u32x4*)(p + (size_t)8 * ldc) = db;
}
struct EpiBf16 {
    static constexpr bool PERM = true, FULL = true;
    bf16_t* O; int ldc; int split_cols; size_t split_stride; float scale0;
    __device__ __forceinline__ void operator()(const f32x4 (&acc)[2][2][4][2], const Unit& u, int wr, int wc, int fr, int fq) const {
        int colt = u.pn * BM; bf16_t* base = O;
        float sc = 1.f; if (split_cols) { const int t = colt / split_cols; base += (size_t)t * split_stride; colt -= t * split_cols; if (t == 0) sc = scale0; }
#pragma unroll
        for (int ai = 0; ai < 2; ++ai)
#pragma unroll
            for (int m = 0; m < 4; ++m) { u32x4 w[2];
#pragma unroll
                for (int bj = 0; bj < 2; ++bj) { const f32x4 v0 = acc[ai][bj][m][0] * sc, v1 = acc[ai][bj][m][1] * sc;
                    w[bj].x = cvt_pk_bf16(v0[0], v0[1]); w[bj].y = cvt_pk_bf16(v0[2], v0[3]); w[bj].z = cvt_pk_bf16(v1[0], v1[1]); w[bj].w = cvt_pk_bf16(v1[2], v1[3]); }
                store_full_lines(base + (size_t)(u.pm * BM + wr * 64 + ai * HALF + m * 16) * ldc + colt + wc * 64, ldc, fr, fq, w); }
    }
};
struct EpiNull {
    static constexpr bool PERM = true, FULL = true;
    __device__ __forceinline__ void operator()(const f32x4 (&acc)[2][2][4][2], const Unit&, int, int, int, int) const {
#pragma unroll
        for (int ai = 0; ai < 2; ++ai)
#pragma unroll
            for (int bj = 0; bj < 2; ++bj)
#pragma unroll
                for (int m = 0; m < 4; ++m)
#pragma unroll
                    for (int n = 0; n < 2; ++n) asm volatile("" :: "v"(acc[ai][bj][m][n]));
    }
};
template <bool RES_BF16>
struct EpiResidZ {
    static constexpr bool PERM = true, FULL = true;
    const void* res; bf16_t* Z; float alpha;
    __device__ __forceinline__ void operator()(const f32x4 (&acc)[2][2][4][2], const Unit& u, int wr, int wc, int fr, int fq) const {
        const int row0 = u.pm * BM + wr * 64 + fr, col0 = u.pn * BM + wc * 64 + 8 * fq;
#pragma unroll
        for (int ai = 0; ai < 2; ++ai)
#pragma unroll
            for (int m = 0; m < 4; ++m) { const size_t off = (size_t)(row0 + ai * HALF + m * 16) * 1024 + col0; u32x4 w[2];
#pragma unroll
                for (int bj = 0; bj < 2; ++bj) { f32x4 r0, r1;
                    if (RES_BF16) { const u32x4 rb = *(const u32x4*)((const bf16_t*)res + off + bj * 32);
                        r0 = (f32x4){__uint_as_float(rb.x << 16), __uint_as_float(rb.x & 0xffff0000u), __uint_as_float(rb.y << 16), __uint_as_float(rb.y & 0xffff0000u)};
                        r1 = (f32x4){__uint_as_float(rb.z << 16), __uint_as_float(rb.z & 0xffff0000u), __uint_as_float(rb.w << 16), __uint_as_float(rb.w & 0xffff0000u)}; }
                    else { r0 = NT_LOAD((const f32x4*)((const float*)res + off + bj * 32)); r1 = NT_LOAD((const f32x4*)((const float*)res + off + bj * 32 + 4)); }
                    const f32x4 v0 = r0 * alpha + acc[ai][bj][m][0], v1 = r1 * alpha + acc[ai][bj][m][1];
                    w[bj].x = cvt_pk_bf16(v0[0], v0[1]); w[bj].y = cvt_pk_bf16(v0[2], v0[3]); w[bj].z = cvt_pk_bf16(v1[0], v1[1]); w[bj].w = cvt_pk_bf16(v1[2], v1[3]); }
                store_full_lines(Z + (size_t)(u.pm * BM + wr * 64 + ai * HALF + m * 16) * 1024 + u.pn * BM + wc * 64, 1024, fr, fq, w); }
    }
};
struct EpiSwiglu {
    static constexpr bool PERM = true, FULL = false;
    bf16_t* H;
    __device__ __forceinline__ void operator()(const f32x4 (&acc)[2][2][4][2], const Unit& u, int wr, int wc, int fr, int fq) const {
        const int row0 = u.pm * BM + wr * 64 + fr, col0 = u.pn * HALF + wc * 32 + 8 * fq;
#pragma unroll
        for (int ai = 0; ai < 2; ++ai)
#pragma unroll
            for (int m = 0; m < 4; ++m) { float h[8];
#pragma unroll
                for (int n = 0; n < 2; ++n)
#pragma unroll
                    for (int j = 0; j < 4; ++j) { const float a = acc[ai][0][m][n][j], b = acc[ai][1][m][n][j];
                        h[n * 4 + j] = a * __builtin_amdgcn_rcpf(1.f + __builtin_amdgcn_exp2f(-1.4426950408889634f * a)) * b; }
                u32x4 w; w.x = cvt_pk_bf16(h[0], h[1]); w.y = cvt_pk_bf16(h[2], h[3]); w.z = cvt_pk_bf16(h[4], h[5]); w.w = cvt_pk_bf16(h[6], h[7]);
                asm volatile("global_store_dwordx4 %0, %1, off sc1\n\ts_nop 1" :: "v"(H + (size_t)(row0 + ai * HALF + m * 16) * 512 + col0), "v"(w) : "memory"); }
    }
};

template <class Epi, class Sched, bool ALIGN_EPI>
__device__ __forceinline__ void gemm_phase(PG8_LAS unsigned char* lds, const int tid_in, const Sched& S, const Epi& E) {
    constexpr int K = Sched::K;
    int tid = tid_in; asm volatile("" : "+v"(tid));
    const int wid = __builtin_amdgcn_readfirstlane(tid >> 6), lane = tid & 63, wr = wid >> 2, wc = wid & 3, fr = lane & 15, fq = lane >> 4;
    const int nt = K / BK;
    int Rr[2], Cc[2]; unsigned voffB[2][2];
#pragma unroll
    for (int i = 0; i < 2; ++i) { int R, C; stage_rc(tid * 16 + i * 8192, R, C); Rr[i] = R; Cc[i] = C;
#pragma unroll
        for (int h = 0; h < 2; ++h) {
            const int col = Epi::FULL ? (64 * (R >> 5) + 32 * h + perm32(R & 31)) : (HALF * h + (Epi::PERM ? ((R & ~31) + perm32(R & 31)) : R));
            voffB[h][i] = (unsigned)(col * K + C) * 2u; } }
    const size_t kstep = (size_t)(BK * 2);
    const unsigned ldsw = (unsigned)wid * 1024u;
    const int aoff = lds_byte(wr * 64 + fr, fq * 8), boff = lds_byte(wc * 32 + fr, fq * 8);
#define PG8_SA(b, h) (((b) * 2 + (h)) * HTB)
#define PG8_SB(b, h) ((4 + (b) * 2 + (h)) * HTB)
#define PG8_STAGE(bufoff, gbase, voff) do { _Pragma("unroll") for (int _i = 0; _i < 2; ++_i) \
        __builtin_amdgcn_global_load_lds((const unsigned*)((const char*)(gbase) + (voff)[_i]), (PG8_LAS unsigned*)(lds + (bufoff) + ldsw + _i * 8192), 16, 0, Sched::AUX_B); } while (0)
#define PG8_STAGEA(bufoff, gbase, voff) do { _Pragma("unroll") for (int _i = 0; _i < 2; ++_i) \
        __builtin_amdgcn_global_load_lds((const unsigned*)((const char*)(gbase) + (voff)[_i]), (PG8_LAS unsigned*)(lds + (bufoff) + ldsw + _i * 8192), 16, 0, Sched::AUX_A); } while (0)
#define PG8_LDA(dst, b, h) do { _Pragma("unroll") for (int m = 0; m < 4; ++m) _Pragma("unroll") for (int k = 0; k < 2; ++k) dst[m][k] = *(const PG8_LAS bf16x8*)(lds + PG8_SA(b, h) + aoff + m * 2048 + k * 1024); } while (0)
#define PG8_LDB(dst, b, h) do { _Pragma("unroll") for (int n = 0; n < 2; ++n) _Pragma("unroll") for (int k = 0; k < 2; ++k) dst[n][k] = *(const PG8_LAS bf16x8*)(lds + PG8_SB(b, h) + boff + n * 2048 + k * 1024); } while (0)
#define PG8_MMA(ai, bj, At, Bt) do { __builtin_amdgcn_s_setprio(1); _Pragma("unroll") for (int m = 0; m < 4; ++m) _Pragma("unroll") for (int n = 0; n < 2; ++n) _Pragma("unroll") for (int k = 0; k < 2; ++k) \
        acc[ai][bj][m][n] = __builtin_amdgcn_mfma_f32_16x16x32_bf16(Bt[n][k], At[m][k], acc[ai][bj][m][n], 0, 0, 0); __builtin_amdgcn_s_setprio(0); } while (0)
#define PG8_WAIT_V(n) asm volatile("s_waitcnt vmcnt(" #n ")" ::: "memory")
#define PG8_WAIT_L(n) asm volatile("s_waitcnt lgkmcnt(" #n ")" ::: "memory")
#define PG8_BAR __builtin_amdgcn_s_barrier()
#define PG8_SCHED __builtin_amdgcn_sched_barrier(0)
#define PG8_VOFF(dst, u) do { _Pragma("unroll") for (int _h = 0; _h < 2; ++_h) _Pragma("unroll") for (int _i = 0; _i < 2; ++_i) dst[_h][_i] = S.a_rowoff(u, _h * HALF + Rr[_i]) + (unsigned)(Cc[_i] * 2); } while (0)
    Unit cur, nxt; int ui = 0;
    if (!S.next(0, cur)) return;
    cur.li = 0;
#if PG8_STAGGER_TICKS
    if (S.c & 1) { const unsigned long long t0 = __builtin_amdgcn_s_memrealtime(); while (__builtin_amdgcn_s_memrealtime() - t0 < (unsigned long long)PG8_STAGGER_TICKS) __builtin_amdgcn_s_sleep(16); }
#endif
    f32x4 acc[2][2][4][2];
#pragma unroll
    for (int a = 0; a < 2; ++a)
#pragma unroll
        for (int b = 0; b < 2; ++b)
#pragma unroll
            for (int m = 0; m < 4; ++m)
#pragma unroll
                for (int n = 0; n < 2; ++n) acc[a][b][m][n] = (f32x4){0.f, 0.f, 0.f, 0.f};
    bf16x8 At[4][2], B0[2][2], B1[2][2];
    unsigned vC[2][2], vN[2][2];
    PG8_VOFF(vC, cur);
    const char* cA = S.a_base(cur); const char* cB = S.b_base(cur);
    S.a_ready(cur, tid);
    PG8_STAGE(PG8_SB(0, 0), cB, voffB[0]); PG8_STAGE(PG8_SB(0, 1), cB, voffB[1]); PG8_STAGEA(PG8_SA(0, 0), cA, vC[0]); PG8_STAGEA(PG8_SA(0, 1), cA, vC[1]);
    if (wr == 1) PG8_BAR;
    PG8_WAIT_V(2); PG8_BAR;
    PG8_STAGE(PG8_SB(1, 0), cB + kstep, voffB[0]); PG8_STAGEA(PG8_SA(1, 0), cA + kstep, vC[0]); PG8_STAGE(PG8_SB(1, 1), cB + kstep, voffB[1]);
    PG8_WAIT_V(6); PG8_BAR;
    for (;;) {
        const bool has_next = S.next(ui + 1, nxt); nxt.li = ui + 1;
        const char* nA = cA; const char* nB = cB;
#pragma unroll
        for (int h = 0; h < 2; ++h)
#pragma unroll
            for (int i = 0; i < 2; ++i) vN[h][i] = vC[h][i];
        if (has_next) { nA = S.a_base(nxt); nB = S.b_base(nxt); PG8_VOFF(vN, nxt); }
        for (int t = 0; t < nt; t += 2) {
            const bool last = (t == nt - 2);
            if (last && has_next) S.a_ready(nxt, tid);
            const char* a1 = cA + (size_t)(t + 1) * kstep;
            const char* a2 = last ? nA : cA + (size_t)(t + 2) * kstep; const char* b2 = last ? nB : cB + (size_t)(t + 2) * kstep;
            const char* a3 = a2 + kstep; const char* b3 = b2 + kstep;
            unsigned v2[2][2];
#pragma unroll
            for (int h = 0; h < 2; ++h)
#pragma unroll
                for (int i = 0; i < 2; ++i) v2[h][i] = last ? vN[h][i] : vC[h][i];
            PG8_LDB(B0, 0, 0); PG8_LDB(B1, 0, 1); PG8_SCHED; PG8_LDA(At, 0, 0); PG8_STAGEA(PG8_SA(1, 1), a1, vC[1]);
            PG8_WAIT_V(8); PG8_WAIT_L(0); PG8_BAR; PG8_MMA(0, 0, At, B0); PG8_MMA(0, 1, At, B1); PG8_BAR; PG8_SCHED;
            PG8_LDA(At, 0, 1); PG8_STAGE(PG8_SB(0, 0), b2, voffB[0]); PG8_STAGE(PG8_SB(0, 1), b2, voffB[1]); PG8_STAGEA(PG8_SA(0, 0), a2, v2[0]);
            PG8_WAIT_V(8); PG8_WAIT_L(0); PG8_BAR; PG8_MMA(1, 0, At, B0); PG8_MMA(1, 1, At, B1); PG8_BAR; PG8_SCHED;
            PG8_LDB(B0, 1, 0); PG8_LDB(B1, 1, 1); PG8_SCHED; PG8_LDA(At, 1, 0); PG8_STAGEA(PG8_SA(0, 1), a2, v2[1]);
            PG8_WAIT_V(8); PG8_WAIT_L(0); PG8_BAR; PG8_MMA(0, 0, At, B0); PG8_MMA(0, 1, At, B1); PG8_BAR; PG8_SCHED;
            PG8_LDA(At, 1, 1); PG8_STAGE(PG8_SB(1, 0), b3, voffB[0]); PG8_STAGE(PG8_SB(1, 1), b3, voffB[1]); PG8_STAGEA(PG8_SA(1, 0), a3, v2[0]);
            PG8_WAIT_V(8); PG8_WAIT_L(0); PG8_BAR; PG8_MMA(1, 0, At, B0); PG8_MMA(1, 1, At, B1); PG8_BAR; PG8_SCHED;
        }
        if constexpr (ALIGN_EPI) { if (wr == 0) PG8_BAR; }
        E(acc, cur, wr, wc, fr, fq); S.done(cur, lane);
        if (!has_next) break;
#pragma unroll
        for (int a = 0; a < 2; ++a)
#pragma unroll
            for (int b = 0; b < 2; ++b)
#pragma unroll
                for (int m = 0; m < 4; ++m)
#pragma unroll
                    for (int n = 0; n < 2; ++n) acc[a][b][m][n] = (f32x4){0.f, 0.f, 0.f, 0.f};
        cur = nxt; cA = nA; cB = nB; ++ui;
#pragma unroll
        for (int h = 0; h < 2; ++h)
#pragma unroll
            for (int i = 0; i < 2; ++i) vC[h][i] = vN[h][i];
        if constexpr (ALIGN_EPI) { if (wr == 1) PG8_BAR; }
    }
    PG8_WAIT_V(0);
    if constexpr (!ALIGN_EPI) { if (wr == 0) PG8_BAR; }
    PG8_BAR;
#undef PG8_SA
#undef PG8_SB
#undef PG8_STAGE
#undef PG8_STAGEA
#undef PG8_LDA
#undef PG8_LDB
#undef PG8_MMA
#undef PG8_WAIT_V
#undef PG8_WAIT_L
#undef PG8_BAR
#undef PG8_SCHED
#undef PG8_VOFF
}
}
#define GAS __attribute__((address_space(1)))
#define LAS __attribute__((address_space(3)))
typedef unsigned v4u __attribute__((ext_vector_type(4)));
typedef unsigned v2u __attribute__((ext_vector_type(2)));
typedef float f32x4 __attribute__((ext_vector_type(4)));
typedef short s16x4 __attribute__((ext_vector_type(4)));
typedef short bf16x8 __attribute__((ext_vector_type(8)));
constexpr int NWAVES = 8, NTHREADS = 512;
constexpr int LDS_BYTES = 163840;
#define LDS_WAIT() asm volatile("s_waitcnt lgkmcnt(0)" ::: "memory")

#ifndef PRO_SKIP_L0
#define PRO_SKIP_L0 0
#endif
#ifndef PRO_NTST
#define PRO_NTST 1
#endif
#if PRO_NTST
#define PRO_STORE(p, v) __builtin_nontemporal_store(v, p)
#else
#define PRO_STORE(p, v) (*(p) = (v))
#endif
#ifndef PRO_NT
#define PRO_NT 1
#endif
#if PRO_NT
#define PRO_LOAD(p) __builtin_nontemporal_load(p)
#else
#define PRO_LOAD(p) (*(p))
#endif
struct Params { const float* in[22]; float* out; unsigned char* ws; };

typedef const __attribute__((address_space(4))) Params* KParamsPtr;
__device__ __forceinline__ Params kparams() {
    KParamsPtr p = (KParamsPtr)__builtin_amdgcn_kernarg_segment_ptr();
    asm volatile("" : "+s"(p));
    Params P;
#pragma unroll
    for (int i = 0; i < 22; ++i) P.in[i] = p->in[i];
    P.out = p->out; P.ws = p->ws;
    return P;
}
__device__ __forceinline__ unsigned pk2(float lo, float hi) { return (unsigned)f2bf(lo) | ((unsigned)f2bf(hi) << 16); }

__device__ __forceinline__ void transpose_item(const float* W, int ldw, bf16_t* WT, int ldt, int k0, int n0, int orow0, LAS float* scr, int lane) {
    f32x4 wv[8];
#pragma unroll
    for (int i = 0; i < 8; ++i) wv[i] = PRO_LOAD((const f32x4*)(W + (size_t)(k0 + 8 * i + (lane >> 3)) * ldw + n0 + 4 * (lane & 7)));
#pragma unroll
    for (int i = 0; i < 8; ++i) { LAS float* d = scr + (8 * i + (lane >> 3)) * 33 + 4 * (lane & 7); d[0] = wv[i][0]; d[1] = wv[i][1]; d[2] = wv[i][2]; d[3] = wv[i][3]; }
    LDS_WAIT(); asm volatile("" ::: "memory");
    const int c = lane & 7;
#pragma unroll
    for (int j = 0; j < 4; ++j) { const int n = (lane >> 3) + 8 * j; const LAS float* s = scr + (8 * c) * 33 + n;
        v4u o; o.x = pk2(s[0 * 33], s[1 * 33]); o.y = pk2(s[2 * 33], s[3 * 33]); o.z = pk2(s[4 * 33], s[5 * 33]); o.w = pk2(s[6 * 33], s[7 * 33]);
        PRO_STORE((v4u*)(WT + (size_t)(orow0 + n) * ldt + k0 + 8 * c), o); }
    LDS_WAIT(); asm volatile("" ::: "memory");
}

constexpr int IT_WIN = (D / 64) * (2 * DR / 32);
constexpr int IT_WOUT = (DR / 64) * (D / 32);
constexpr int IT_WQKV = (D / 64) * (QKVD / 32);
constexpr int IT_WO = (D / 64) * (D / 32);
constexpr int IT_W1 = (D / 64) * (DE / 32);
constexpr int IT_W2 = (DE / 64) * (D / 32);
constexpr int IT_MOE_LAYER = NE * (2 * IT_W1 + IT_W2);
constexpr int IT_DENSE = IT_WIN + IT_WOUT + IT_WQKV + IT_WO;

__device__ __forceinline__ void cvt_dense_item(const Params& P, int r, LAS float* scr, int lane) {
    unsigned char* ws = P.ws;
    if (r < IT_WIN) { const int nb = 2 * DR / 32, kb = r / nb, n0 = (r % nb) * 32; transpose_item(P.in[1], 2 * DR, (bf16_t*)(ws + WS_WIN), D, kb * 64, n0, n0, scr, lane); return; } r -= IT_WIN;
    if (r < IT_WOUT) { const int nb = D / 32, kb = r / nb, n0 = (r % nb) * 32; transpose_item(P.in[9], D, (bf16_t*)(ws + WS_WOUT), DR, kb * 64, n0, n0, scr, lane); return; } r -= IT_WOUT;
    if (r < IT_WQKV) { const int nb = QKVD / 32, kb = r / nb, n0 = (r % nb) * 32; transpose_item(P.in[10], QKVD, (bf16_t*)(ws + WS_WQKV), D, kb * 64, n0, n0, scr, lane); return; } r -= IT_WQKV;
    { const int nb = D / 32, kb = r / nb, n0 = (r % nb) * 32; transpose_item(P.in[12], D, (bf16_t*)(ws + WS_WO), D, kb * 64, n0, n0, scr, lane); }
}
__device__ __forceinline__ void cvt_moe_item(const Params& P, int layer, int r, LAS float* scr, int lane) {
    unsigned char* ws = P.ws;
    const int per_e = 2 * IT_W1 + IT_W2, e = r / per_e; int q = r % per_e;
    bf16_t* W13t = (bf16_t*)(ws + WS_W13) + ((size_t)layer * NE + e) * (size_t)(D * D);
    bf16_t* W2t = (bf16_t*)(ws + WS_W2) + ((size_t)layer * NE + e) * (size_t)(D * DE);
    const size_t eoff13 = ((size_t)layer * NE + e) * (size_t)(D * DE);
    if (q < 2 * IT_W1) { const int which = q / IT_W1; q %= IT_W1; const int nb = DE / 32, kb = q / nb, n0 = (q % nb) * 32;
        const int orow0 = (n0 / 128) * 256 + which * 128 + (n0 % 128);
        transpose_item((which ? P.in[18] : P.in[17]) + eoff13, DE, W13t, D, kb * 64, n0, orow0, scr, lane); return; }
    q -= 2 * IT_W1;
    { const int nb = D / 32, kb = q / nb, n0 = (q % nb) * 32; transpose_item(P.in[19] + eoff13, D, W2t, DE, kb * 64, n0, n0, scr, lane); }
}

__device__ __forceinline__ void cvt_gate_frags(const Params& P, int gtid, int gthreads) {
    v2u* GF = (v2u*)(P.ws + WS_GF);
    for (int i = gtid; i < 2 * 16 * 25 * 64; i += gthreads) {
        const int l = i & 63, ks = (i >> 6) % 5, jt = (i / 320) % 5, n = (i / 1600) % 16, mat = i / 25600;
        const float* w = (mat ? P.in[6] : P.in[4]) + (size_t)n * BW * BW;
        const int j = 16 * jt + (l & 15), k = 16 * ks + 4 * (l >> 4);
        v2u o; o.x = pk2(w[(k + 0) * BW + j], w[(k + 1) * BW + j]); o.y = pk2(w[(k + 2) * BW + j], w[(k + 3) * BW + j]);
        GF[i] = o;
    }
}
__device__ __forceinline__ void cvt_router(const Params& P, int gw, int NGW, int lane) {
    const int fr = lane & 15, fq = lane >> 4;
    for (int it = gw; it < 2 * 96 + 2 * 36; it += NGW) {
        if (it < 192) {
            const int layer = it / 96, s = (it % 96) / 3, ct = it % 3;
            const float* lg = P.in[20] + (size_t)(layer * 2) * D;
            const float* we = P.in[15] + (size_t)layer * D * 32; const float* wg = P.in[13] + (size_t)layer * D * 4;
            unsigned h[8], l[8];
#pragma unroll
            for (int j = 0; j < 8; ++j) { const int k = 32 * s + 8 * fq + j; const float v = lg[k] * ((ct < 2) ? we[(size_t)k * 32 + 16 * ct + fr] : wg[(size_t)k * 4 + (fr & 3)]);
                const bf16_t hh = f2bf(v); h[j] = hh; l[j] = f2bf(v - bf2f(hh)); }
            const v4u H = {h[0] | (h[1] << 16), h[2] | (h[3] << 16), h[4] | (h[5] << 16), h[6] | (h[7] << 16)}, L = {l[0] | (l[1] << 16), l[2] | (l[3] << 16), l[4] | (l[5] << 16), l[6] | (l[7] << 16)};
            unsigned char* rf = P.ws + WS_RF + (size_t)layer * RF_BYTES;
            if (ct < 2) { *(v4u*)(rf + ((s * 2 + ct) * 2 + 0) * 1024 + lane * 16) = H; *(v4u*)(rf + ((s * 2 + ct) * 2 + 1) * 1024 + lane * 16) = L; }
            else if (fr < 4) { *(v4u*)(rf + 131072 + (s * 2 + 0) * 256 + (fr + 4 * fq) * 16) = H; *(v4u*)(rf + 131072 + (s * 2 + 1) * 256 + (fr + 4 * fq) * 16) = L; }
        } else {
            const int q = it - 192, layer = q / 36, n = q % 36;
            const float* lg = P.in[20] + (size_t)(layer * 2) * D; const float* lb = P.in[21] + (size_t)(layer * 2) * D;
            const float* we = P.in[15] + (size_t)layer * D * 32; const float* wg = P.in[13] + (size_t)layer * D * 4;
            float a2 = 0.f, a3 = 0.f;
            for (int i = 0; i < 16; ++i) { const int k = lane + 64 * i; const float wv = (n < 32) ? we[(size_t)k * 32 + n] : wg[(size_t)k * 4 + (n - 32)]; const float v = lg[k] * wv;
                const bf16_t hh = f2bf(v); a2 += bf2f(hh) + bf2f(f2bf(v - bf2f(hh))); a3 += lb[k] * wv; }
#pragma unroll
            for (int o = 1; o < 64; o <<= 1) { a2 += __shfl_xor(a2, o); a3 += __shfl_xor(a3, o); }
            float* rc = (float*)(P.ws + WS_RC) + layer * 96;
            if (lane == 0) { rc[n] = a2; rc[48 + n] = a3 + ((n < 32) ? P.in[16][layer * 32 + n] : P.in[14][layer * 4 + (n - 32)]); }
        }
    }
}
__device__ __forceinline__ void cvt_x(const Params& P, int gtid, int gthreads) {
    const f32x4* x = (const f32x4*)P.in[0]; v4u* xb = (v4u*)(P.ws + WS_XB);
    for (size_t i = gtid; i < (size_t)T * D / 8; i += gthreads) { const f32x4 a = PRO_LOAD(x + 2 * i), b = PRO_LOAD(x + 2 * i + 1);
        v4u o; o.x = pk2(a[0], a[1]); o.y = pk2(a[2], a[3]); o.z = pk2(b[0], b[1]); o.w = pk2(b[2], b[3]); st16_wt(xb + i, o); }
}
__device__ __forceinline__ void phase_prologue(LAS unsigned char* lds, const int tid_in, int vcu, int G) {
    const Params P = kparams();
    int tid = tid_in; asm volatile("" : "+v"(tid));
    const int lane = tid & 63, wave = __builtin_amdgcn_readfirstlane(tid >> 6);
    LAS float* scr = (LAS float*)(lds + wave * 16384);
    const int gw = vcu * NWAVES + wave, NGW = G * NWAVES;
    for (int it = gw + (PRO_SKIP_L0 ? IT_MOE_LAYER : 0); it < 2 * IT_MOE_LAYER; it += NGW) cvt_moe_item(P, it / IT_MOE_LAYER, it % IT_MOE_LAYER, scr, lane);
    for (int it = gw; it < IT_DENSE; it += NGW) cvt_dense_item(P, it, scr, lane);
    cvt_router(P, NGW - 1 - gw, NGW, lane);
    cvt_gate_frags(P, vcu * NTHREADS + tid, G * NTHREADS);
    cvt_x(P, vcu * NTHREADS + tid, G * NTHREADS);
}

__device__ __forceinline__ void phase_cvt_moe(int layer, LAS unsigned char* lds, const int tid_in, int vcu, int G) {
    const Params P = kparams();
    int tid = tid_in; asm volatile("" : "+v"(tid));
    const int lane = tid & 63, wave = __builtin_amdgcn_readfirstlane(tid >> 6);
    LAS float* scr = (LAS float*)(lds + wave * 16384);
    const int gw = vcu * NWAVES + wave, NGW = G * NWAVES;
    for (int it = gw; it < IT_MOE_LAYER; it += NGW) cvt_moe_item(P, layer, it, scr, lane);
}
#define XB_TMO      128
#define XB_XCNT(j)  (256  + 64 * (j))
#define XB_XSUB(j)  (1280 + 64 * (j))
#define XB_XGEN(j)  (2304 + 64 * (j))
#define XB_TOP      3328
#define XB_TOPGEN   3392
#define XCD_BAR_WORDS 3456
#define XB_SPIN_CAP (1u << 18)

__device__ __forceinline__ unsigned xb_ld(unsigned* p)              { return __hip_atomic_load(p, __ATOMIC_RELAXED, __HIP_MEMORY_SCOPE_AGENT); }
__device__ __forceinline__ unsigned xb_add(unsigned* p, unsigned v) { return __hip_atomic_fetch_add(p, v, __ATOMIC_RELAXED, __HIP_MEMORY_SCOPE_AGENT); }
__device__ __forceinline__ unsigned xb_xcc_id() { return (unsigned)__builtin_amdgcn_s_getreg((3 << 11) | 20) & 0xFu; }
#define XB_SPIN(cond, bar) do { unsigned _sp = 0; while (cond) { __builtin_amdgcn_s_sleep(1); \
    if ((++_sp & 255u) == 0u) { if (xb_ld(&(bar)[XB_TMO])) break; if (_sp > XB_SPIN_CAP) { atomicAdd(&(bar)[XB_TMO], 1u); break; } } } } while (0)

struct XcdBarrier {
    unsigned* bar; unsigned x;
    volatile LAS unsigned* st;
};

__device__ __forceinline__ XcdBarrier xcd_barrier_post(unsigned* bar, volatile LAS unsigned* st, const int xb_tid) {
    XcdBarrier b; b.bar = bar; b.x = xb_xcc_id(); b.st = st;
    if (xb_tid == 0) (void)xb_add(&bar[XB_XCNT(b.x)], 1u);
    return b;
}
__device__ __forceinline__ void xcd_barrier_complete(unsigned* bar, unsigned x, unsigned& nloc, unsigned& nx) {
    const unsigned G = gridDim.x * gridDim.y * gridDim.z;
    unsigned sum, cnt, mine, sp = 0u;
    for (;;) {
        sum = 0u; cnt = 0u; mine = 0u;
#pragma unroll
        for (unsigned j = 0; j < 16; ++j) { const unsigned c = xb_ld(&bar[XB_XCNT(j)]); sum += c; cnt += (c > 0u) ? 1u : 0u; mine = (j == x) ? c : mine; }
        if (sum == G) break;
        __builtin_amdgcn_s_sleep(1);
        if ((++sp & 255u) == 0u) { if (xb_ld(&bar[XB_TMO])) break; if (sp > XB_SPIN_CAP) { atomicAdd(&bar[XB_TMO], 1u); break; } }
    }
    nloc = mine > 0u ? mine : 1u; nx = cnt > 0u ? cnt : 1u;
}

__device__ __forceinline__ void xcd_barrier(const XcdBarrier& b, const int xb_tid) {
    asm volatile("s_waitcnt vmcnt(0)" ::: "memory");
    __syncthreads();
    if (xb_tid == 0) {
        unsigned* bar = b.bar;
        __builtin_amdgcn_s_waitcnt(0);
        unsigned nloc = b.st[0], nx = b.st[1];
        if (nloc == 0u) { xcd_barrier_complete(bar, b.x, nloc, nx); b.st[0] = nloc; b.st[1] = nx; }
        const unsigned old = xb_add(&bar[XB_XSUB(b.x)], 1u);
        const unsigned gen = old / nloc;
        if (old + 1u == (gen + 1u) * nloc) {
            __builtin_amdgcn_fence(__ATOMIC_RELEASE, "agent");
            asm volatile("s_waitcnt vmcnt(0)" ::: "memory");
            const unsigned og = xb_add(&bar[XB_TOP], 1u);
            const unsigned tg = og / nx;
            if (og + 1u == (tg + 1u) * nx) xb_add(&bar[XB_TOPGEN], 1u);
            else XB_SPIN(xb_ld(&bar[XB_TOPGEN]) == tg, bar);
            __builtin_amdgcn_fence(__ATOMIC_ACQUIRE, "agent");
            xb_add(&bar[XB_XGEN(b.x)], 1u);
            asm volatile("s_waitcnt vmcnt(0)" ::: "memory");
        } else {
            XB_SPIN(xb_ld(&bar[XB_XGEN(b.x)]) == gen, bar);
            __builtin_amdgcn_fence(__ATOMIC_ACQUIRE, "agent");
            asm volatile("s_waitcnt vmcnt(0)" ::: "memory");
        }
    }
    __syncthreads();
}
#ifndef WGM_WIN
#define WGM_WIN PG8_WGM
#endif
#ifndef WGM_QKV
#define WGM_QKV PG8_WGM
#endif
#ifndef WGM_WOUT
#define WGM_WOUT PG8_WGM
#endif
#ifndef WGM_WO
#define WGM_WO PG8_WGM
#endif
#ifndef WGM_UP
#define WGM_UP PG8_WGM
#endif
#ifndef WGM_DOWN
#define WGM_DOWN PG8_WGM
#endif
#ifndef PG8_ALIGN
#define PG8_ALIGN true
#endif
enum Phase { PH_PROLOGUE = 0, PH_WIN, PH_RGLRU, PH_WOUT, PH_LN0, PH_ROUTE0, PH_UP0, PH_DOWN0, PH_COMB0, PH_QKV, PH_ATTN, PH_WO, PH_LN1, PH_ROUTE1, PH_UP1, PH_DOWN1, PH_COMB1, PH_COUNT };
__device__ __forceinline__ void phase_gemm_win(LAS unsigned char* lds, const int tid_in, int bid, int G) {
    const Params P = kparams(); unsigned char* ws = P.ws;
    typedef pg8::Order<D, 2 * DR / 256, false, false, 0, WGM_WIN> O;
    const O S{T / 256, G, bid, (const char*)(ws + WS_XB), (const char*)(ws + WS_WIN), nullptr, nullptr, nullptr, 0u, nullptr};
    const pg8::EpiBf16 E{(bf16_t*)(ws + WS_M + M_G), DR, DR, (size_t)(M_XR - M_G) / 2, 1.f};
    pg8::gemm_phase<pg8::EpiBf16, O, PG8_ALIGN>(lds, tid_in, S, E);
}
__device__ __forceinline__ void phase_gemm_qkv(LAS unsigned char* lds, const int tid_in, int bid, int G) {
    const Params P = kparams(); unsigned char* ws = P.ws;
    typedef pg8::Order<D, QKVD / 256, false, false, 0, WGM_QKV> O;
    const O S{T / 256, G, bid, (const char*)(ws + WS_XB), (const char*)(ws + WS_WQKV), nullptr, nullptr, nullptr, 0u, nullptr};
    const pg8::EpiBf16 E{(bf16_t*)(ws + WS_M + M_QKV), QKVD, 1024, 1024, QSCALE};
    pg8::gemm_phase<pg8::EpiBf16, O, PG8_ALIGN>(lds, tid_in, S, E);
}
__device__ __forceinline__ void phase_gemm_wout(LAS unsigned char* lds, const int tid_in, int bid, int G) {
    const Params P = kparams(); unsigned char* ws = P.ws;
    typedef pg8::Order<DR, D / 256, false, false, 0, WGM_WOUT> O;
    const O S{T / 256, G, bid, (const char*)(ws + WS_M + M_G), (const char*)(ws + WS_WOUT), nullptr, nullptr, nullptr, 0u, nullptr};
    const pg8::EpiResidZ<false> E{P.in[0], (bf16_t*)P.out, ALPHA};
    pg8::gemm_phase<pg8::EpiResidZ<false>, O, PG8_ALIGN>(lds, tid_in, S, E);
}
__device__ __forceinline__ void phase_gemm_wo(LAS unsigned char* lds, const int tid_in, int bid, int G) {
    const Params P = kparams(); unsigned char* ws = P.ws;
    typedef pg8::Order<D, D / 256, false, false, 0, WGM_WO> O;
    const O S{T / 256, G, bid, (const char*)(ws + WS_M + M_O), (const char*)(ws + WS_WO), nullptr, nullptr, nullptr, 0u, nullptr};
    const pg8::EpiResidZ<true> E{ws + WS_XB, (bf16_t*)P.out, ALPHA};
    pg8::gemm_phase<pg8::EpiResidZ<true>, O, PG8_ALIGN>(lds, tid_in, S, E);
}
__device__ __forceinline__ void phase_moe_up(int layer, LAS unsigned char* lds, const int tid_in, int bid, int G) {
    const Params P = kparams(); unsigned char* ws = P.ws; const int* ctl = (const int*)(ws + WS_CTL);
    typedef pg8::Order<D, 4, true, true, 1, WGM_UP> O;
    const O S{ctl[97], G, bid, (const char*)(ws + WS_XB), (const char*)(ws + WS_W13) + (size_t)layer * NE * (size_t)(D * D * 2), ctl + 128, (const int*)(ws + WS_ROUTE + 512 * 1024), (unsigned*)(ws + WS_READY + (size_t)layer * READY_BANK), 0u, (const LAS int*)(lds + 131072 + 4096)};
    { int t_ = tid_in; asm volatile("" : "+v"(t_)); S.fill_tokl((LAS int*)(lds + 131072 + 4096), t_); __syncthreads(); }
    const pg8::EpiSwiglu E{(bf16_t*)(ws + WS_M + M_HDN)};
    pg8::gemm_phase<pg8::EpiSwiglu, O, PG8_ALIGN>(lds, tid_in, S, E);
}
__device__ __forceinline__ void phase_moe_down(int layer, LAS unsigned char* lds, const int tid_in, int bid, int G) {
    const Params P = kparams(); unsigned char* ws = P.ws; const int* ctl = (const int*)(ws + WS_CTL);
    typedef pg8::Order<DE, 4, false, true, 2, WGM_DOWN> O;
    const O S{ctl[97], G, G - 1 - bid, (const char*)(ws + WS_M + M_HDN), (const char*)(ws + WS_W2) + (size_t)layer * NE * (size_t)(D * DE * 2), ctl + 128, nullptr, (unsigned*)(ws + WS_READY + (size_t)layer * READY_BANK), 32u, nullptr};
    const pg8::EpiBf16 E{(bf16_t*)(ws + WS_M + M_YS), D, 0, 0, 1.f};
    pg8::gemm_phase<pg8::EpiBf16, O, PG8_ALIGN>(lds, tid_in, S, E);
}

__device__ __forceinline__ void phase_gemm_win_null(LAS unsigned char* lds, const int tid_in, int bid, int G) {
    const Params P = kparams(); unsigned char* ws = P.ws;
    typedef pg8::Order<D, 2 * DR / 256, false, false> O;
    const O S{T / 256, G, bid, (const char*)(ws + WS_XB), (const char*)(ws + WS_WIN), nullptr, nullptr, nullptr, 0u, nullptr};
    const pg8::EpiNull E{};
    pg8::gemm_phase<pg8::EpiNull, O, PG8_ALIGN>(lds, tid_in, S, E);
}

template <int VARD> __device__ __forceinline__ void phase_moe_down_var(int layer, LAS unsigned char* lds, const int tid_in, int bid, int G) {
    const Params P = kparams(); unsigned char* ws = P.ws; const int* ctl = (const int*)(ws + WS_CTL);
    typedef pg8::Order<DE, 4, false, true, (VARD & 2) ? 0 : 2, WGM_DOWN> O;
    const O S{ctl[97], G, G - 1 - bid, (const char*)(ws + WS_M + M_HDN), (const char*)(ws + WS_W2) + (size_t)layer * NE * (size_t)(D * DE * 2), ctl + 128, nullptr, (unsigned*)(ws + WS_READY + (size_t)layer * READY_BANK), 32u, nullptr};
    if (VARD & 1) { const pg8::EpiNull E{}; pg8::gemm_phase<pg8::EpiNull, O, PG8_ALIGN>(lds, tid_in, S, E); }
    else { const pg8::EpiBf16 E{(bf16_t*)(ws + WS_M + M_YS), D, 0, 0, 1.f}; pg8::gemm_phase<pg8::EpiBf16, O, PG8_ALIGN>(lds, tid_in, S, E); }
}

template <bool GATH> __device__ __forceinline__ void phase_moe_up_null(int layer, LAS unsigned char* lds, const int tid_in, int bid, int G) {
    const Params P = kparams(); unsigned char* ws = P.ws; const int* ctl = (const int*)(ws + WS_CTL);
    typedef pg8::Order<D, 4, GATH, true, 0, WGM_UP> O;
    const O S{ctl[97] < 128 ? ctl[97] : 128, G, bid, (const char*)(ws + WS_XB), (const char*)(ws + WS_W13) + (size_t)layer * NE * (size_t)(D * D * 2), ctl + 128, (const int*)(ws + WS_ROUTE + 512 * 1024), nullptr, 0u, (const LAS int*)(lds + 131072 + 4096)};
    if (GATH) { int t_ = tid_in; asm volatile("" : "+v"(t_)); S.fill_tokl((LAS int*)(lds + 131072 + 4096), t_); __syncthreads(); }
    const pg8::EpiNull E{};
    pg8::gemm_phase<pg8::EpiNull, O, PG8_ALIGN>(lds, tid_in, S, E);
}
constexpr size_t CTL_CNT = 16384;
constexpr int LN_ROWS = 32, LN_TILES = T / LN_ROWS;
typedef float f32x2v __attribute__((ext_vector_type(2)));

__device__ __forceinline__ float wave_sum(float v) {
#pragma unroll
    for (int o = 1; o < 64; o <<= 1) v += __shfl_xor(v, o);
    return v;
}
__device__ __forceinline__ void split_bf(float x, unsigned& hi, unsigned& lo) { hi = f2bf(x); lo = f2bf(x - __uint_as_float(hi << 16)); }

__device__ __forceinline__ void phase_ln(int layer, LAS unsigned char* lds, const int tid_in, int bid, int G, bool dry = false) {
    const Params P = kparams();
    unsigned char* ws = P.ws;
    const bf16_t* Z = (const bf16_t*)P.out; bf16_t* XB = (bf16_t*)(ws + (dry ? WS_M + 128 * MiB : WS_XB));
    const float* lg = P.in[20] + (size_t)(layer * 2) * D; const float* lb = P.in[21] + (size_t)(layer * 2) * D;
    const float* wg = P.in[13] + (size_t)layer * D * 4; const float* bg = P.in[14] + layer * 4;
    const float* we = P.in[15] + (size_t)layer * D * 32; const float* be = P.in[16] + layer * 32;
    unsigned char* rbase = ws + (dry ? WS_M + 192 * MiB : WS_ROUTE);
    int* EXP = (int*)(rbase); float* GATE = (float*)(rbase + 256 * 1024); int* rowtok = (int*)(rbase + 512 * 1024);
    int* CNT = dry ? (int*)(rbase + 2 * MiB) : (int*)(ws + WS_CTL) + CTL_CNT;
    int tid = tid_in; asm volatile("" : "+v"(tid));
    const int lane = tid & 63, w = __builtin_amdgcn_readfirstlane(tid >> 6), fr = lane & 15, fq = lane >> 4;
    for (int i = bid * NTHREADS + tid; i < NROWS_MAX; i += G * NTHREADS) rowtok[i] = -1;
    LAS float* stat = (LAS float*)lds;
    LAS float* part = (LAS float*)(lds + 2048);
    LAS float* logit = (LAS float*)(lds + 2048 + 49152);
    LAS int* hist = (LAS int*)(lds + 2048 + 49152 + 6144);
    v2u vp[2][4][2];
#define LN_LOAD(tl) do { _Pragma("unroll") for (int rt = 0; rt < 2; ++rt) _Pragma("unroll") for (int s = 0; s < 4; ++s) _Pragma("unroll") for (int hf = 0; hf < 2; ++hf) \
        vp[rt][s][hf] = NT_LOAD_S(0, (const v2u*)(Z + (size_t)((tl) * LN_ROWS + 16 * rt + fr) * D + 128 * w + 32 * s + 16 * hf + 4 * fq)); } while (0)
#define LN_UNPACK(p) ((f32x4){__uint_as_float((p).x << 16), __uint_as_float((p).x & 0xffff0000u), __uint_as_float((p).y << 16), __uint_as_float((p).y & 0xffff0000u)})
    if (bid < LN_TILES) LN_LOAD(bid);
    bf16x8 Bh[4][3];
    LAS bf16x8* Bl = (LAS bf16x8*)(lds + 58368) + (w * 12) * 64 + lane;
    { float wv[4][3][8];
#pragma unroll
      for (int s = 0; s < 4; ++s)
#pragma unroll
          for (int ct = 0; ct < 3; ++ct)
#pragma unroll
              for (int j = 0; j < 8; ++j) {
                  const int col = 128 * w + 32 * s + (j < 4 ? 4 * fq + j : 16 + 4 * fq + (j - 4));
                  wv[s][ct][j] = (ct < 2) ? we[(size_t)col * 32 + 16 * ct + fr] : wg[(size_t)col * 4 + (fr & 3)];
              }
#pragma unroll
      for (int s = 0; s < 4; ++s)
#pragma unroll
          for (int ct = 0; ct < 3; ++ct) {
              unsigned h[8], l[8];
#pragma unroll
              for (int j = 0; j < 8; ++j) split_bf((ct < 2 || fr < 4) ? wv[s][ct][j] : 0.f, h[j], l[j]);
              Bh[s][ct] = __builtin_bit_cast(bf16x8, (v4u){h[0] | (h[1] << 16), h[2] | (h[3] << 16), h[4] | (h[5] << 16), h[6] | (h[7] << 16)});
              Bl[(s * 3 + ct) * 64] = __builtin_bit_cast(bf16x8, (v4u){l[0] | (l[1] << 16), l[2] | (l[3] << 16), l[4] | (l[5] << 16), l[6] | (l[7] << 16)});
          } }
    for (int tile = bid; tile < LN_TILES; tile += G) {
        const int row0 = tile * LN_ROWS;
        if (tid < 32) hist[tid] = 0;
#pragma unroll
        for (int rt = 0; rt < 2; ++rt) {
            float sm = 0.f, sq = 0.f;
#pragma unroll
            for (int s = 0; s < 4; ++s)
#pragma unroll
                for (int hf = 0; hf < 2; ++hf) { const f32x4 x = LN_UNPACK(vp[rt][s][hf]); sm += (x[0] + x[1]) + (x[2] + x[3]); sq += (x[0] * x[0] + x[1] * x[1]) + (x[2] * x[2] + x[3] * x[3]); }
            sm += __shfl_xor(sm, 16); sm += __shfl_xor(sm, 32); sq += __shfl_xor(sq, 16); sq += __shfl_xor(sq, 32);
            if (fq == 0) *(LAS f32x2v*)(stat + ((w * 32) + 16 * rt + fr) * 2) = (f32x2v){sm, sq};
        }
#pragma unroll
        for (int rt = 0; rt < 2; ++rt)
#pragma unroll
            for (int s = 0; s < 4; ++s) asm volatile("" : "+v"(vp[rt][s][0]), "+v"(vp[rt][s][1]));
        __syncthreads();
        float mean[2], rstd[2];
#pragma unroll
        for (int rt = 0; rt < 2; ++rt) { float sm = 0.f, sq = 0.f;
#pragma unroll
            for (int ww = 0; ww < 8; ++ww) { const f32x2v a = *(LAS f32x2v*)(stat + ((ww * 32) + 16 * rt + fr) * 2); sm += a.x; sq += a.y; }
            mean[rt] = sm * (1.f / D); const float var = fmaxf(sq * (1.f / D) - mean[rt] * mean[rt], 0.f); rstd[rt] = 1.f / sqrtf(var + LN_EPS); }
        f32x4 acc[2][3];
#pragma unroll
        for (int rt = 0; rt < 2; ++rt)
#pragma unroll
            for (int ct = 0; ct < 3; ++ct) acc[rt][ct] = (f32x4){0.f, 0.f, 0.f, 0.f};
#pragma unroll
        for (int s = 0; s < 4; ++s) {
            asm volatile("" ::: "memory");
            f32x4 gg[2], bb[2];
#pragma unroll
            for (int hf = 0; hf < 2; ++hf) { gg[hf] = *(const f32x4*)(lg + 128 * w + 32 * s + 16 * hf + 4 * fq); bb[hf] = *(const f32x4*)(lb + 128 * w + 32 * s + 16 * hf + 4 * fq); }
#pragma unroll
            for (int rt = 0; rt < 2; ++rt) {
                unsigned hp[4], lp[4];
#pragma unroll
                for (int hf = 0; hf < 2; ++hf) {
                    f32x4 y = (LN_UNPACK(vp[rt][s][hf]) - mean[rt]) * rstd[rt] * gg[hf] + bb[hf];
                    const size_t off = (size_t)(row0 + 16 * rt + fr) * D + 128 * w + 32 * s + 16 * hf + 4 * fq;
#pragma unroll
                    for (int q = 0; q < 2; ++q) { const unsigned hh = pg8::cvt_pk_bf16(y[2 * q], y[2 * q + 1]);
                        hp[2 * hf + q] = hh; lp[2 * hf + q] = pg8::cvt_pk_bf16(y[2 * q] - __uint_as_float(hh << 16), y[2 * q + 1] - __uint_as_float(hh & 0xffff0000u)); }
                    st8_wt(XB + off, (v2u){hp[2 * hf], hp[2 * hf + 1]});
                }
                const bf16x8 Ah = __builtin_bit_cast(bf16x8, (v4u){hp[0], hp[1], hp[2], hp[3]});
                const bf16x8 Al = __builtin_bit_cast(bf16x8, (v4u){lp[0], lp[1], lp[2], lp[3]});
#pragma unroll
                for (int ct = 0; ct < 3; ++ct) {
                    acc[rt][ct] = __builtin_amdgcn_mfma_f32_16x16x32_bf16(Ah, Bh[s][ct], acc[rt][ct], 0, 0, 0);
                    acc[rt][ct] = __builtin_amdgcn_mfma_f32_16x16x32_bf16(Ah, Bl[(s * 3 + ct) * 64], acc[rt][ct], 0, 0, 0);
                    acc[rt][ct] = __builtin_amdgcn_mfma_f32_16x16x32_bf16(Al, Bh[s][ct], acc[rt][ct], 0, 0, 0);
                }
                __builtin_amdgcn_sched_barrier(0);
            }
        }
#pragma unroll
        for (int rt = 0; rt < 2; ++rt)
#pragma unroll
            for (int ct = 0; ct < 3; ++ct) *(LAS f32x4*)(part + (((w * 2 + rt) * 3 + ct) * 64 + lane) * 4) = acc[rt][ct];
        asm volatile("" ::: "memory");
        if (tile + G < LN_TILES) LN_LOAD(tile + G);
        __syncthreads();
#pragma unroll
        for (int k = 0; k < 3; ++k) {
            const int idx = tid + k * NTHREADS, r = idx & 3, ln = (idx >> 2) & 63, t6 = idx >> 8;
            float s = 0.f;
#pragma unroll
            for (int ww = 0; ww < 8; ++ww) s += part[((ww * 6 + t6) * 64 + ln) * 4 + r];
            const int rt = t6 / 3, ct = t6 % 3, row = 16 * rt + 4 * (ln >> 4) + r, col = 16 * ct + (ln & 15);
            logit[row * 48 + col] = s;
        }
        __syncthreads();
        if (tid < 32) {
            const LAS float* L = logit + tid * 48;
            int gi = 0; float gm = L[32] + bg[0];
            for (int o = 1; o < 4; ++o) { const float x = L[32 + o] + bg[o]; if (x > gm) { gm = x; gi = o; } }
            float gs = 0.f;
            for (int o = 0; o < 4; ++o) gs += __expf(L[32 + o] + bg[o] - gm);
            const float ggate = 1.f / gs;
            int i0 = 0; float v0 = L[gi * 8] + be[gi * 8];
            for (int i = 1; i < 8; ++i) { const float x = L[gi * 8 + i] + be[gi * 8 + i]; if (x > v0) { v0 = x; i0 = i; } }
            int i1 = -1; float v1 = -INFINITY;
            for (int i = 0; i < 8; ++i) { const float x = L[gi * 8 + i] + be[gi * 8 + i]; if (i != i0 && x > v1) { v1 = x; i1 = i; } }
            const float w0 = 1.f / (1.f + __expf(v1 - v0)), w1 = 1.f - w0;
            const int row = row0 + tid, e0 = gi * 8 + i0, e1 = gi * 8 + i1;
            EXP[row * 2] = e0; EXP[row * 2 + 1] = e1; GATE[row * 2] = w0 * ggate; GATE[row * 2 + 1] = w1 * ggate;
            __hip_atomic_fetch_add(&hist[e0], 1, __ATOMIC_RELAXED, __HIP_MEMORY_SCOPE_WORKGROUP); __hip_atomic_fetch_add(&hist[e1], 1, __ATOMIC_RELAXED, __HIP_MEMORY_SCOPE_WORKGROUP);
        }
        __syncthreads();
        if (tid < 32) CNT[tile * 32 + tid] = hist[tid];
    }
#undef LN_LOAD
#undef LN_UNPACK
}

__device__ __forceinline__ void phase_ln2(int layer, LAS unsigned char* lds, const int tid_in, int bid, int G, bool dry = false) {
    const Params P = kparams();
    unsigned char* ws = P.ws;
    const bf16_t* Z = (const bf16_t*)P.out; bf16_t* XB = (bf16_t*)(ws + (dry ? WS_M + 128 * MiB : WS_XB));
    const float* lg = P.in[20] + (size_t)(layer * 2) * D; const float* lb = P.in[21] + (size_t)(layer * 2) * D;
    unsigned char* rbase = ws + (dry ? WS_M + 192 * MiB : WS_ROUTE);
    int* EXP = (int*)(rbase); float* GATE = (float*)(rbase + 256 * 1024); int* rowtok = (int*)(rbase + 512 * 1024);
    int* CNT = dry ? (int*)(rbase + 2 * MiB) : (int*)(ws + WS_CTL) + CTL_CNT;
    const unsigned char* RF = ws + WS_RF + (size_t)layer * RF_BYTES; const float* RC = (const float*)(ws + WS_RC) + layer * 96;
    int tid0 = tid_in; asm volatile("" : "+v"(tid0));
    const int w = __builtin_amdgcn_readfirstlane(tid0 >> 6);
    __builtin_amdgcn_s_waitcnt(0x0F70);
    LAS int* hist = (LAS int*)(lds + 155648);
    LAS float* Ls = (LAS float*)(lds + w * 2560);
    for (int blk = bid; blk < T / 128; blk += G) {
        int tid = tid0; asm volatile("" : "+v"(tid));
        const int lane = tid & 63, fr = lane & 15, fq = lane >> 4;
        const int row0 = blk * 128 + 16 * w;
        __syncthreads();
        { const unsigned char* rfl = RF + (unsigned)(tid * 16);
#pragma unroll
          for (int i = 0; i < 18; ++i) __builtin_amdgcn_global_load_lds((const unsigned*)(rfl + i * 8192), (LAS unsigned*)(lds + i * 8192 + w * 1024), 16, 0, 0);
          __builtin_amdgcn_global_load_lds((const unsigned*)((const unsigned char*)(w < 4 ? lg : lb - D) + (unsigned)(tid * 16)), (LAS unsigned*)(lds + 147456 + w * 1024), 16, 0, 0); }
        if (tid < 128) hist[tid] = 0;
        v4u zr[32];
        const bf16_t* zrow = Z + (size_t)(row0 + fr) * D + 8 * fq;
#pragma unroll
        for (int s = 0; s < 32; ++s) zr[s] = NT_LOAD_S(0, (const v4u*)(zrow + 32 * s));
        float s2c[3], s3c[3];
#pragma unroll
        for (int ct = 0; ct < 3; ++ct) { const int n = (ct < 2) ? 16 * ct + fr : 32 + (fr & 3); s2c[ct] = RC[n]; s3c[ct] = RC[48 + n]; }
        asm volatile("" ::: "memory"); __builtin_amdgcn_s_waitcnt(0x8076); asm volatile("" ::: "memory");
        __builtin_amdgcn_s_barrier();
        asm volatile("" ::: "memory");
        f32x4 acc[3];
#pragma unroll
        for (int ct = 0; ct < 3; ++ct) acc[ct] = (f32x4){0.f, 0.f, 0.f, 0.f};
        float sm = 0.f, sq = 0.f;
        const LAS bf16x8* Be = (const LAS bf16x8*)lds + lane;
        const LAS bf16x8* Bg = (const LAS bf16x8*)(lds + 131072) + (fr & 3) + 4 * fq;
        bf16x8 bq[2][6];
#define LN2_LDB(dst, s_) do { dst[0] = Be[(((s_) * 2 + 0) * 2 + 0) * 64]; dst[1] = Be[(((s_) * 2 + 1) * 2 + 0) * 64]; dst[2] = Bg[((s_) * 2 + 0) * 16]; \
                              dst[3] = Be[(((s_) * 2 + 0) * 2 + 1) * 64]; dst[4] = Be[(((s_) * 2 + 1) * 2 + 1) * 64]; dst[5] = Bg[((s_) * 2 + 1) * 16]; } while (0)
        LN2_LDB(bq[0], 0);
#pragma unroll
        for (int s = 0; s < 32; ++s) {
            if (s + 1 < 32) LN2_LDB(bq[(s + 1) & 1], s + 1);
            const v4u zz = zr[s];
            const bf16x8 a = __builtin_bit_cast(bf16x8, zz);
#pragma unroll
            for (int i = 0; i < 6; ++i) acc[i % 3] = __builtin_amdgcn_mfma_f32_16x16x32_bf16(a, bq[s & 1][i], acc[i % 3], 0, 0, 0);
#pragma unroll
            for (int e = 0; e < 4; ++e) { const float x0 = __uint_as_float(zz[e] << 16), x1 = __uint_as_float(zz[e] & 0xffff0000u); sm += x0 + x1; sq = __builtin_fmaf(x0, x0, sq); sq = __builtin_fmaf(x1, x1, sq); }
            __builtin_amdgcn_sched_barrier(0);
        }
#undef LN2_LDB
#pragma unroll
        for (int s = 0; s < 32; ++s) asm volatile("" : "+v"(zr[s]));
        sm += __shfl_xor(sm, 16); sm += __shfl_xor(sm, 32); sq += __shfl_xor(sq, 16); sq += __shfl_xor(sq, 32);
        const float mean = sm * (1.f / D), rstd = 1.f / sqrtf(fmaxf(sq * (1.f / D) - mean * mean, 0.f) + LN_EPS);
        { const LAS f32x4* G4 = (const LAS f32x4*)(lds + 147456) + 2 * fq; const LAS f32x4* B4 = G4 + 256;
          bf16_t* xrow = XB + (size_t)(row0 + fr) * D + 8 * fq;
#pragma unroll
          for (int s = 0; s < 32; ++s) {
              const v4u zz = zr[s];
              const f32x4 x0 = {__uint_as_float(zz.x << 16), __uint_as_float(zz.x & 0xffff0000u), __uint_as_float(zz.y << 16), __uint_as_float(zz.y & 0xffff0000u)};
              const f32x4 x1 = {__uint_as_float(zz.z << 16), __uint_as_float(zz.z & 0xffff0000u), __uint_as_float(zz.w << 16), __uint_as_float(zz.w & 0xffff0000u)};
              const f32x4 y0 = (x0 - mean) * rstd * G4[8 * s] + B4[8 * s], y1 = (x1 - mean) * rstd * G4[8 * s + 1] + B4[8 * s + 1];
              st16_wt(xrow + 32 * s, (v4u){pg8::cvt_pk_bf16(y0[0], y0[1]), pg8::cvt_pk_bf16(y0[2], y0[3]), pg8::cvt_pk_bf16(y1[0], y1[1]), pg8::cvt_pk_bf16(y1[2], y1[3])});
          } }
        float lv[3][4];
#pragma unroll
        for (int r = 0; r < 4; ++r) { const float mr = __shfl(mean, 4 * fq + r), rr = __shfl(rstd, 4 * fq + r);
#pragma unroll
            for (int ct = 0; ct < 3; ++ct) lv[ct][r] = rr * (acc[ct][r] - mr * s2c[ct]) + s3c[ct]; }
        __syncthreads();
#pragma unroll
        for (int ct = 0; ct < 3; ++ct)
#pragma unroll
            for (int r = 0; r < 4; ++r) if (ct < 2 || fr < 4) Ls[(4 * fq + r) * 37 + 16 * ct + fr] = lv[ct][r];
        LDS_WAIT();
        if (lane < 16) {
            const LAS float* L = Ls + lane * 37;
            int gi = 0; float gm = L[32];
            for (int o = 1; o < 4; ++o) { const float x = L[32 + o]; if (x > gm) { gm = x; gi = o; } }
            float gs = 0.f;
            for (int o = 0; o < 4; ++o) gs += __expf(L[32 + o] - gm);
            const float ggate = 1.f / gs;
            int i0 = 0; float v0 = L[gi * 8];
            for (int i = 1; i < 8; ++i) { const float x = L[gi * 8 + i]; if (x > v0) { v0 = x; i0 = i; } }
            int i1 = -1; float v1 = -INFINITY;
            for (int i = 0; i < 8; ++i) { const float x = L[gi * 8 + i]; if (i != i0 && x > v1) { v1 = x; i1 = i; } }
            const float w0 = 1.f / (1.f + __expf(v1 - v0)), w1 = 1.f - w0;
            const int row = row0 + lane, e0 = gi * 8 + i0, e1 = gi * 8 + i1;
            EXP[row * 2] = e0; EXP[row * 2 + 1] = e1; GATE[row * 2] = w0 * ggate; GATE[row * 2 + 1] = w1 * ggate;
            LAS int* hh = hist + (w >> 1) * 32;
            __hip_atomic_fetch_add(&hh[e0], 1, __ATOMIC_RELAXED, __HIP_MEMORY_SCOPE_WORKGROUP); __hip_atomic_fetch_add(&hh[e1], 1, __ATOMIC_RELAXED, __HIP_MEMORY_SCOPE_WORKGROUP);
        }
        __syncthreads();
        if (tid < 128) CNT[(blk * 4 + (tid >> 5)) * 32 + (tid & 31)] = hist[tid];
    }
    for (int i = bid * NTHREADS + tid0; i < NROWS_MAX; i += G * NTHREADS) rowtok[i] = -1;
}

__device__ __forceinline__ void phase_route(LAS unsigned char* lds, const int tid_in, int bid, int G) {
    const Params P = kparams();
    unsigned char* ws = P.ws;
    int* ctl = (int*)(ws + WS_CTL); const int* CNT = ctl + CTL_CNT;
    const int* EXP = (const int*)(ws + WS_ROUTE); int* rowtok = (int*)(ws + WS_ROUTE + 512 * 1024); int* slotrow = (int*)(ws + WS_ROUTE + 1024 * 1024);
    int tid = tid_in; asm volatile("" : "+v"(tid));
    const int lane = tid & 63, w = __builtin_amdgcn_readfirstlane(tid >> 6);
    LAS int* tab = (LAS int*)lds;
    LAS int* csum = (LAS int*)(lds + 131072);
    LAS int* cbase = (LAS int*)(lds + 131072 + 2048);
    typedef int i32x4 __attribute__((ext_vector_type(4)));
#pragma unroll 4
    for (int i = tid; i < LN_TILES * 32 / 4; i += NTHREADS) ((LAS i32x4*)tab)[i] = ((const i32x4*)CNT)[i];
    __syncthreads();
    const int e = tid & 31, ch = tid >> 5;
    { int run = 0;
#pragma unroll 8
      for (int t = 0; t < 64; ++t) { LAS int* p = tab + (ch * 64 + t) * 32 + e; const int v = *p; *p = run; run += v; }
      csum[ch * 32 + e] = run; }
    __syncthreads();
    if (tid < 32) { int run = 0; for (int c = 0; c < 16; ++c) { const int v = csum[c * 32 + tid]; cbase[c * 32 + tid] = run; run += v; } csum[tid] = run;   }
    __syncthreads();
    if (tid == 0) { int off = 0; for (int x = 0; x < NE; ++x) { const int p = (csum[x] + MB - 1) / MB * MB; csum[32 + x] = off;
            if (bid == 0) for (int r = off / MB; r < (off + p) / MB; ++r) ctl[128 + r] = x;
            off += p; }
        if (bid == 0) { ctl[96] = off; ctl[97] = off / MB; } }
    __syncthreads();
    for (int tile = bid * NWAVES + w; tile < LN_TILES; tile += G * NWAVES) {
        const int slot = tile * 64 + lane, ex = EXP[slot];
        int rank = 0;
        for (int x = 0; x < NE; ++x) { const unsigned long long m = __ballot(ex == x); if (ex == x) rank = __popcll(m & ((1ull << lane) - 1ull)); }
        const int row = csum[32 + ex] + cbase[(tile >> 6) * 32 + ex] + tab[tile * 32 + ex] + rank;
        rowtok[row] = slot; slotrow[slot] = row;
    }
}

__device__ __forceinline__ void phase_combine(int layer, const int tid_in, int bid, int G, bool dry = false) {
    const Params P = kparams();
    unsigned char* ws = P.ws;
    bf16_t* XB = (bf16_t*)(ws + WS_XB); float* Xo = P.out; const bf16_t* YS = (const bf16_t*)(ws + WS_M + M_YS);
    const float* GATE = (const float*)(ws + WS_ROUTE + 256 * 1024); const int* slotrow = (const int*)(ws + WS_ROUTE + 1024 * 1024);
    const float* g = P.in[20] + (size_t)(layer * 2 + 1) * D; const float* b = P.in[21] + (size_t)(layer * 2 + 1) * D;
    int tid = tid_in; asm volatile("" : "+v"(tid));
    const int lane = tid & 63, w = __builtin_amdgcn_readfirstlane(tid >> 6);
    const int NW = G * NWAVES;
    for (int rowa = bid * NWAVES + w; rowa < T; rowa += 2 * NW) {
        int rows[2]; rows[0] = rowa; rows[1] = rowa + NW;
        f32x4 v[2][4]; float s[2];
#pragma unroll
        for (int q = 0; q < 2; ++q) {
            const int row = rows[q] < T ? rows[q] : rowa;
            const float g0 = GATE[row * 2], g1 = GATE[row * 2 + 1];
            const v2u* xr = (const v2u*)(XB + (size_t)row * D);
            const v2u* y0 = (const v2u*)(YS + (size_t)slotrow[row * 2] * D);
            const v2u* y1 = (const v2u*)(YS + (size_t)slotrow[row * 2 + 1] * D);
            s[q] = 0.f;
#pragma unroll
            for (int j = 0; j < 4; ++j) { const v2u xx = NT_LOAD_S(1, xr + lane + 64 * j), a = NT_LOAD_S(1, y0 + lane + 64 * j), c = NT_LOAD_S(1, y1 + lane + 64 * j);
                const f32x4 x = {__uint_as_float(xx.x << 16), __uint_as_float(xx.x & 0xffff0000u), __uint_as_float(xx.y << 16), __uint_as_float(xx.y & 0xffff0000u)};
                const f32x4 fa = {__uint_as_float(a.x << 16), __uint_as_float(a.x & 0xffff0000u), __uint_as_float(a.y << 16), __uint_as_float(a.y & 0xffff0000u)};
                const f32x4 fc = {__uint_as_float(c.x << 16), __uint_as_float(c.x & 0xffff0000u), __uint_as_float(c.y << 16), __uint_as_float(c.y & 0xffff0000u)};
                v[q][j] = x * ALPHA + (fa * g0 + fc * g1);
                s[q] += (v[q][j][0] + v[q][j][1]) + (v[q][j][2] + v[q][j][3]); }
        }
#pragma unroll
        for (int q = 0; q < 2; ++q) {
            if (rows[q] >= T) continue;
            const int row = rows[q];
            const float mean = wave_sum(s[q]) * (1.f / D);
            float qq = 0.f;
#pragma unroll
            for (int j = 0; j < 4; ++j) { v[q][j] = v[q][j] - mean; qq += (v[q][j][0] * v[q][j][0] + v[q][j][1] * v[q][j][1]) + (v[q][j][2] * v[q][j][2] + v[q][j][3] * v[q][j][3]); }
            const float rstd = 1.f / sqrtf(wave_sum(qq) * (1.f / D) + LN_EPS);
#pragma unroll
            for (int j = 0; j < 4; ++j) { const f32x4 gg = ((const f32x4*)g)[lane + 64 * j], bb = ((const f32x4*)b)[lane + 64 * j];
                const f32x4 y = v[q][j] * rstd * gg + bb;
                if (layer == 0) ((v2u*)(XB + (size_t)row * D))[lane + 64 * j] = (v2u){pk2(y[0], y[1]), pk2(y[2], y[3])};
                else __builtin_nontemporal_store(y, (f32x4*)(Xo + (size_t)row * D) + lane + 64 * j); }
        }
    }
}
constexpr int ATT_KSTR = 144;
constexpr int ATT_VSTR = 528;
constexpr int ATT_K_OFF = 0, ATT_V_OFF = 256 * ATT_KSTR;
template <int VAR = 0> __device__ __forceinline__ void phase_attn(LAS unsigned char* lds, const int tid_in, int bid, int G) {
    const Params P = kparams();
    unsigned char* ws = P.ws;
    const bf16_t* QKV = (const bf16_t*)(ws + WS_M + M_QKV); bf16_t* O = (bf16_t*)(ws + WS_M + M_O);
    const float* sinks = P.in[11];
    int tid = tid_in; asm volatile("" : "+v"(tid));
    const int lane = tid & 63, w = __builtin_amdgcn_readfirstlane(tid >> 6), fr = lane & 15, fq = lane >> 4;
    const int g = w >> 1, qh = w & 1;
    const int vcu = (G % 8 == 0) ? (bid % 8) * (G / 8) + bid / 8 : bid;
    LAS unsigned char* Kl = lds + ATT_K_OFF; LAS unsigned char* Vl = lds + ATT_V_OFF;
    const float L2E = 1.4426950408889634f;
    v4u kvr[4], vvr[4];
#pragma unroll
    for (int it = 0; it < 4; ++it) { kvr[it] = (v4u){0u, 0u, 0u, 0u}; vvr[it] = (v4u){0u, 0u, 0u, 0u}; }
    for (int L = vcu * 4; L < BATCH * 4 * 16; L += G * 4) {
      for (int u4 = 0; u4 < 4; ++u4) {
        const int unit = L + u4; if (unit >= BATCH * 4 * 16) break;
        const int nb = unit & 15, kvh = (unit >> 4) & 3, b = unit >> 6;
        const int h = kvh * 4 + g;
        const float slope2 = __builtin_amdgcn_exp2f(-0.5f * (float)(h + 1)) * L2E, sink2 = sinks[h] * L2E;
        const long rowbase = (long)b * SEQ + nb * 128 - 128;
        if (u4 == 0) {
#pragma unroll
            for (int it = 0; it < 4; ++it) {
                const int c = tid + it * NTHREADS, sj = c >> 3, ch = c & 7;
                kvr[it] = (v4u){0u, 0u, 0u, 0u}; vvr[it] = (v4u){0u, 0u, 0u, 0u};
                if (!(VAR & 1) && (nb > 0 || sj >= 128)) { const bf16_t* rp = QKV + (size_t)(rowbase + sj) * QKVD + kvh * 64 + ch * 8; kvr[it] = *(const v4u*)(rp + 1024); vvr[it] = *(const v4u*)(rp + 1280); }
            }
        }
        __syncthreads();
#pragma unroll
        for (int it = 0; it < 4; ++it) {
            const int c = tid + it * NTHREADS, sj = c >> 3, ch = c & 7;
            *(LAS v4u*)(Kl + sj * ATT_KSTR + ch * 16) = kvr[it];
            LAS bf16_t* vt = (LAS bf16_t*)(Vl + (ch * 8) * ATT_VSTR) + (sj ^ (ch << 2));
            const v4u vv = vvr[it];
#pragma unroll
            for (int e = 0; e < 8; ++e) vt[e * (ATT_VSTR / 2)] = (bf16_t)(vv[e >> 1] >> (16 * (e & 1)));
        }
        __syncthreads();
        if (u4 < 3 && unit + 1 < BATCH * 4 * 16) {
            const long rb2 = rowbase + 128;
#pragma unroll
            for (int it = 0; it < 4; ++it) {
                const int c = tid + it * NTHREADS, sj = c >> 3, ch = c & 7;
                const bf16_t* rp = QKV + (size_t)(rb2 + sj) * QKVD + kvh * 64 + ch * 8;
                if (!(VAR & 1)) { kvr[it] = *(const v4u*)(rp + 1024); vvr[it] = *(const v4u*)(rp + 1280); }
            }
        }
#pragma unroll 1
        for (int it = 0; it < 2; ++it) {
            const int kb = 4 * qh + 2 * it;
            const int qrow0 = 64 * qh + 32 * it;
            bf16x8 qf[2][2];
#pragma unroll
            for (int qt = 0; qt < 2; ++qt)
#pragma unroll
                for (int ds = 0; ds < 2; ++ds)
                    qf[qt][ds] = NT_LOAD_S(3, (const bf16x8*)(QKV + (size_t)(rowbase + 128 + qrow0 + 16 * qt + fr) * QKVD + h * 64 + 32 * ds + 8 * fq));
            f32x4 acc[2][9];
#pragma unroll
            for (int qt = 0; qt < 2; ++qt)
#pragma unroll
                for (int i = 0; i < 9; ++i) acc[qt][i] = (f32x4){0.f, 0.f, 0.f, 0.f};
#pragma unroll
            for (int u = 0; u < 10; ++u)
#pragma unroll
                for (int ds = 0; ds < 2; ++ds) {
                    const bf16x8 kf = *(const LAS bf16x8*)(Kl + (16 * (kb + u) + fr) * ATT_KSTR + ds * 64 + fq * 16);
                    if (u <= 8) acc[0][u] = __builtin_amdgcn_mfma_f32_16x16x32_bf16(kf, qf[0][ds], acc[0][u], 0, 0, 0);
                    if (u >= 1) acc[1][u - 1] = __builtin_amdgcn_mfma_f32_16x16x32_bf16(kf, qf[1][ds], acc[1][u - 1], 0, 0, 0);
                }
#pragma unroll
            for (int qt = 0; qt < 2; ++qt) {
                const int kt0 = kb + qt;
                const int q = qrow0 + 16 * qt + fr;
                float m = -INFINITY;
                const float abias = -slope2 * (float)(fr - 4 * fq);
#pragma unroll
                for (int i = 0; i < 9; ++i)
#pragma unroll
                    for (int r = 0; r < 4; ++r) {
                        const int e = 4 * fq + r;
                        bool ok = (i == 0) ? (e > fr) : (i == 8) ? (e <= fr) : true;
                        if (nb == 0) ok = ok && (kt0 + i >= 8);
                        const float s = (VAR & 2) ? acc[qt][i][r] : (ok ? acc[qt][i][r] + __builtin_fmaf(slope2, (float)(r - 16 * (8 - i)), abias) : -INFINITY);
                        acc[qt][i][r] = s; m = fmaxf(m, s);
                    }
                m = fmaxf(m, __shfl_xor(m, 16)); m = fmaxf(m, __shfl_xor(m, 32));
                m = fmaxf(m, sink2);
                float l = 0.f;
                unsigned pk[10][2];
#pragma unroll
                for (int i = 0; i < 9; ++i) {
                    float p[4];
#pragma unroll
                    for (int r = 0; r < 4; ++r) { p[r] = (VAR & 2) ? acc[qt][i][r] : __builtin_amdgcn_exp2f(acc[qt][i][r] - m); l += p[r]; }
                    pk[i][0] = pg8::cvt_pk_bf16(p[0], p[1]); pk[i][1] = pg8::cvt_pk_bf16(p[2], p[3]);
                }
                pk[9][0] = 0u; pk[9][1] = 0u;
                l += __shfl_xor(l, 16); l += __shfl_xor(l, 32);
                l += __builtin_amdgcn_exp2f(sink2 - m);
                const float rl = 1.f / l;
                f32x4 oacc[4];
#pragma unroll
                for (int dt = 0; dt < 4; ++dt) oacc[dt] = (f32x4){0.f, 0.f, 0.f, 0.f};
#pragma unroll
                for (int c = 0; c < 5; ++c) {
                    const int i0 = 2 * c, i1 = (c < 4) ? 2 * c + 1 : 7;
                    const bf16x8 pf = __builtin_bit_cast(bf16x8, (v4u){pk[i0][0], pk[i0][1], pk[2 * c + 1][0], pk[2 * c + 1][1]});
#pragma unroll
                    for (int dt = 0; dt < 4; ++dt) {
                        const LAS unsigned char* vr = Vl + (16 * dt + fr) * ATT_VSTR;
                        const int vsw = (((16 * dt + fr) >> 3) & 7) << 3;
                        const v2u a0 = *(const LAS v2u*)(vr + ((32 * (kt0 + i0) + 8 * fq) ^ vsw)), a1 = *(const LAS v2u*)(vr + ((32 * (kt0 + i1) + 8 * fq) ^ vsw));
                        const bf16x8 vf = __builtin_bit_cast(bf16x8, (v4u){a0.x, a0.y, a1.x, a1.y});
                        oacc[dt] = __builtin_amdgcn_mfma_f32_16x16x32_bf16(vf, pf, oacc[dt], 0, 0, 0);
                    }
                }
                bf16_t* orow = O + (size_t)(rowbase + 128 + q) * D + h * 64 + 4 * fq;
#pragma unroll
                for (int dt = 0; dt < 4; ++dt) st8_wt(orow + 16 * dt, (v2u){pg8::cvt_pk_bf16(oacc[dt][0] * rl, oacc[dt][1] * rl), pg8::cvt_pk_bf16(oacc[dt][2] * rl, oacc[dt][3] * rl)});
            }
        }
      }
    }
}
constexpr int RG_GF_OFF = 0;
constexpr int RG_C_OFF = 25600;
constexpr int RG_TOT_OFF = 25600 + 2560;
constexpr int RG_RS = 176;
constexpr int RG_X_OFF = 35840, RG_XB = 131 * RG_RS + 48;
constexpr int RG_G_OFF = RG_X_OFF + 2 * RG_XB, RG_GB = 128 * RG_RS;
constexpr int RG_Y_OFF = RG_G_OFF + 2 * RG_GB;
static_assert(RG_Y_OFF + RG_GB <= 163840 - 16, "RG-LRU LDS map");
#ifndef BG_IN_RGLRU
#define BG_IN_RGLRU 0
#endif
#ifndef BG_NTST
#define BG_NTST 0
#endif
#if BG_NTST
#define BG_ST(v, p) __builtin_nontemporal_store(v, p)
#else
#define BG_ST(v, p) (*(p) = (v))
#endif
constexpr int BG_CHUNKS = 3 * NE * 512;
struct BgChunk { const float* src; bf16_t* dst; int nstride; };
__device__ __forceinline__ BgChunk bg_decode(const Params& P, int layer, int id, int lane) {
    const int me = id >> 9, q = id & 511, mat = me % 3, e = me / 3;
    BgChunk c;
    if (mat < 2) { const int nb = q >> 6, kb = q & 63, n = nb * 64 + lane;
        c.src = (mat ? P.in[18] : P.in[17]) + ((size_t)layer * NE + e) * (size_t)(D * DE) + (size_t)(kb * 16) * DE + n; c.nstride = DE;
        c.dst = (bf16_t*)(P.ws + WS_W13) + ((size_t)layer * NE + e) * (size_t)(D * D) + (size_t)((n >> 7) * 256 + mat * 128 + (n & 127)) * D + kb * 16; }
    else { const int nb = q >> 5, kb = q & 31, n = nb * 64 + lane;
        c.src = P.in[19] + ((size_t)layer * NE + e) * (size_t)(D * DE) + (size_t)(kb * 16) * D + n; c.nstride = D;
        c.dst = (bf16_t*)(P.ws + WS_W2) + ((size_t)layer * NE + e) * (size_t)(D * DE) + (size_t)n * DE + kb * 16; }
    return c;
}
__device__ __forceinline__ float fast_sigmoid(float x) { return __builtin_amdgcn_rcpf(1.f + __builtin_amdgcn_exp2f(-1.4426950408889634f * x)); }
template <int VAR = 0> __device__ __forceinline__ void phase_rglru(LAS unsigned char* lds, const int tid_in, int bid, int G, bool dry = false) {
    const Params P = kparams();
    unsigned char* ws = P.ws;
    const bf16_t* Gt = (const bf16_t*)(ws + WS_M + M_G); bf16_t* Yo = dry ? (bf16_t*)P.out : (bf16_t*)(ws + WS_M + M_G); const bf16_t* XR = (const bf16_t*)(ws + WS_M + M_XR);
    int tid = tid_in; asm volatile("" : "+v"(tid));
    const int lane = tid & 63, w = __builtin_amdgcn_readfirstlane(tid >> 6), fr = lane & 15, fq = lane >> 4;
    LAS v2u* gfl = (LAS v2u*)(lds + RG_GF_OFF);
    LAS float* cst = (LAS float*)(lds + RG_C_OFF);
    LAS float* tot = (LAS float*)(lds + RG_TOT_OFF);
    LAS float* hinb = (LAS float*)(lds + RG_TOT_OFF + 5120);
    const int vcu = (G % 8 == 0) ? (bid % 8) * (G / 8) + bid / 8 : bid;
    int xro[3], gro[3];
    unsigned xgo[3];
#pragma unroll
    for (int i = 0; i < 3; ++i) { const int idx = tid + i * NTHREADS, rw = idx / 10, ch = idx % 10;
        xro[i] = (idx < 1310) ? rw * RG_RS + ch * 16 : -1; gro[i] = (idx < 1280) ? rw * RG_RS + ch * 16 : -1; xgo[i] = (unsigned)(rw * DR + ch * 8); }
    const int bg_cpw = (BG_CHUNKS + G * NWAVES - 1) / (G * NWAVES);
    int bg_next = (bid * NWAVES + w) * bg_cpw, bg_end = bg_next + bg_cpw; if (bg_end > BG_CHUNKS) bg_end = BG_CHUNKS; if (!BG_IN_RGLRU || dry) bg_next = bg_end;
    float bgv[2][16]; bf16_t* bgd[2]; bool bgh[2];
#pragma unroll
    for (int s = 0; s < 2; ++s) { bgd[s] = nullptr; bgh[s] = false;
#pragma unroll
        for (int k = 0; k < 16; ++k) bgv[s][k] = 0.f; }
#define BG_ISSUE(s) do { bgh[s] = bg_next < bg_end; if (bgh[s]) { const BgChunk c_ = bg_decode(P, 0, bg_next, lane); ++bg_next; bgd[s] = c_.dst; \
        _Pragma("unroll") for (int k = 0; k < 16; ++k) bgv[s][k] = __builtin_nontemporal_load(c_.src + (size_t)k * c_.nstride); } } while (0)
#define BG_FINISH(s) do { if (bgh[s]) { v4u o0_, o1_; \
        o0_.x = pg8::cvt_pk_bf16(bgv[s][0], bgv[s][1]); o0_.y = pg8::cvt_pk_bf16(bgv[s][2], bgv[s][3]); o0_.z = pg8::cvt_pk_bf16(bgv[s][4], bgv[s][5]); o0_.w = pg8::cvt_pk_bf16(bgv[s][6], bgv[s][7]); \
        o1_.x = pg8::cvt_pk_bf16(bgv[s][8], bgv[s][9]); o1_.y = pg8::cvt_pk_bf16(bgv[s][10], bgv[s][11]); o1_.z = pg8::cvt_pk_bf16(bgv[s][12], bgv[s][13]); o1_.w = pg8::cvt_pk_bf16(bgv[s][14], bgv[s][15]); \
        BG_ST(o0_, (v4u*)bgd[s]); BG_ST(o1_, (v4u*)bgd[s] + 1); bgh[s] = false; } } while (0)
    for (int unit = vcu; unit < BATCH * 16; unit += G) {
        const int b = unit >> 4, n = unit & 15;
        const bf16_t* xbase = XR + ((size_t)b * SEQ) * DR + n * 80; const bf16_t* gbase = Gt + ((size_t)b * SEQ) * DR + n * 80; bf16_t* ybase = Yo + ((size_t)b * SEQ) * DR + n * 80;
#define RG_FETCH(rr) do { _Pragma("unroll") for (int i = 0; i < 3; ++i) { xs[i] = (v4u){0u, 0u, 0u, 0u}; gs[i] = (v4u){0u, 0u, 0u, 0u}; \
            if (xro[i] >= 0 && ((rr) > 0 || xro[i] >= 3 * RG_RS)) xs[i] = NT_LOAD_S(2, (const v4u*)(xbase + (long)(128 * (rr) - 3) * DR + xgo[i])); \
            if (gro[i] >= 0) gs[i] = NT_LOAD_S(2, (const v4u*)(gbase + (size_t)(128 * (rr)) * DR + xgo[i])); } } while (0)
#define RG_STASH(bufi) do { _Pragma("unroll") for (int i = 0; i < 3; ++i) { \
            if (xro[i] >= 0) *(LAS v4u*)(lds + RG_X_OFF + (bufi) * RG_XB + xro[i]) = xs[i]; \
            if (gro[i] >= 0) *(LAS v4u*)(lds + RG_G_OFF + (bufi) * RG_GB + gro[i]) = gs[i]; } } while (0)
#define RG_YSTORE(rr) do { _Pragma("unroll") for (int i = 0; i < 3; ++i) { if (gro[i] >= 0) \
            st16_wt(ybase + (size_t)(128 * (rr)) * DR + xgo[i], *(const LAS v4u*)(lds + RG_Y_OFF + gro[i])); } } while (0)
        v4u xs[3], gs[3];
        __syncthreads();
        RG_FETCH(0);
        { const v2u* GF = (const v2u*)(ws + WS_GF);
          for (int i = tid; i < 2 * 1600; i += NTHREADS) { const int mat = i / 1600, rem = i % 1600; gfl[i] = GF[(size_t)(mat * 16 + n) * 1600 + rem]; }
          if (tid < 80) { const int c = n * 80 + tid;
              cst[0 * 80 + tid] = P.in[2][0 * DR + c]; cst[1 * 80 + tid] = P.in[2][1 * DR + c]; cst[2 * 80 + tid] = P.in[2][2 * DR + c]; cst[3 * 80 + tid] = P.in[2][3 * DR + c];
              cst[4 * 80 + tid] = P.in[3][c]; cst[5 * 80 + tid] = P.in[5][c]; cst[6 * 80 + tid] = P.in[7][c];
              cst[7 * 80 + tid] = -8.0f * log1pf(expf(-P.in[8][c])) * 1.4426950408889634f; } }
        RG_STASH(0);
        __syncthreads();
        float hcar = 0.f;
#pragma unroll 1
        for (int r = 0; r < SEQ / 128; ++r) {
            const LAS unsigned char* xb = lds + RG_X_OFF + (r & 1) * RG_XB + (16 * w + fr) * RG_RS + 8 * fq;
            const LAS unsigned char* gb = lds + RG_G_OFF + (r & 1) * RG_GB + (16 * w + fr) * RG_RS + 8 * fq;
            if (!(VAR & 2)) { if (r + 1 < SEQ / 128) RG_FETCH(r + 1); }
            BG_FINISH(0); BG_FINISH(1); BG_ISSUE(0); BG_ISSUE(1);
            float xc[5][4]; s16x4 bfr[5];
#pragma unroll
            for (int ks = 0; ks < 5; ++ks) {
                const int c0 = 16 * ks + 4 * fq;
                f32x4 s = *(LAS f32x4*)(cst + 4 * 80 + c0);
#pragma unroll
                for (int k = 0; k < 4; ++k) { const f32x4 wv = *(LAS f32x4*)(cst + k * 80 + c0); const v2u x = *(const LAS v2u*)(xb + k * RG_RS + 32 * ks);
                    s[0] += __uint_as_float(x.x << 16) * wv[0]; s[1] += __uint_as_float(x.x & 0xffff0000u) * wv[1]; s[2] += __uint_as_float(x.y << 16) * wv[2]; s[3] += __uint_as_float(x.y & 0xffff0000u) * wv[3]; }
#pragma unroll
                for (int j = 0; j < 4; ++j) xc[ks][j] = s[j];
                bfr[ks] = __builtin_bit_cast(s16x4, (v2u){pg8::cvt_pk_bf16(s[0], s[1]), pg8::cvt_pk_bf16(s[2], s[3])});
            }
            f32x4 ra[5], ia[5];
#pragma unroll
            for (int jt = 0; jt < 5; ++jt) { ra[jt] = (f32x4){0.f, 0.f, 0.f, 0.f}; ia[jt] = (f32x4){0.f, 0.f, 0.f, 0.f};
#pragma unroll
                for (int ks = 0; ks < 5; ++ks) {
                    const s16x4 ar = __builtin_bit_cast(s16x4, gfl[(jt * 5 + ks) * 64 + lane]), ai = __builtin_bit_cast(s16x4, gfl[1600 + (jt * 5 + ks) * 64 + lane]);
                    ra[jt] = __builtin_amdgcn_mfma_f32_16x16x16bf16_1k(ar, bfr[ks], ra[jt], 0, 0, 0);
                    ia[jt] = __builtin_amdgcn_mfma_f32_16x16x16bf16_1k(ai, bfr[ks], ia[jt], 0, 0, 0);
                } }
            float A[5][4], U[5][4];
#pragma unroll
            for (int jt = 0; jt < 5; ++jt) {
                const int c0 = 16 * jt + 4 * fq;
                const f32x4 brv = *(LAS f32x4*)(cst + 5 * 80 + c0), biv = *(LAS f32x4*)(cst + 6 * 80 + c0), cav = *(LAS f32x4*)(cst + 7 * 80 + c0);
#pragma unroll
                for (int j = 0; j < 4; ++j) {
                    const float rg = fast_sigmoid(ra[jt][j] + brv[j]), ig = fast_sigmoid(ia[jt][j] + biv[j]);
                    const float la2 = rg * cav[j];
                    float a = __builtin_amdgcn_exp2f(la2);
                    float u = __builtin_amdgcn_sqrtf(fmaxf(1.f - a * a, 0.f)) * (ig * xc[jt][j]);
                    A[jt][j] = a; U[jt][j] = u;
                }
#define RG_SCAN4(S) asm volatile("s_nop 1\n\t" \
                    "v_fmac_f32_dpp %0, %0, %4 row_shr:" #S " row_mask:0xf bank_mask:0xf\n\tv_fmac_f32_dpp %1, %1, %5 row_shr:" #S " row_mask:0xf bank_mask:0xf\n\t" \
                    "v_fmac_f32_dpp %2, %2, %6 row_shr:" #S " row_mask:0xf bank_mask:0xf\n\tv_fmac_f32_dpp %3, %3, %7 row_shr:" #S " row_mask:0xf bank_mask:0xf\n\t" \
                    "v_mul_f32_dpp %4, %4, %4 row_shr:" #S " row_mask:0xf bank_mask:0xf\n\tv_mul_f32_dpp %5, %5, %5 row_shr:" #S " row_mask:0xf bank_mask:0xf\n\t" \
                    "v_mul_f32_dpp %6, %6, %6 row_shr:" #S " row_mask:0xf bank_mask:0xf\n\tv_mul_f32_dpp %7, %7, %7 row_shr:" #S " row_mask:0xf bank_mask:0xf" \
                    : "+v"(U[jt][0]), "+v"(U[jt][1]), "+v"(U[jt][2]), "+v"(U[jt][3]), "+v"(A[jt][0]), "+v"(A[jt][1]), "+v"(A[jt][2]), "+v"(A[jt][3]))
                RG_SCAN4(1); RG_SCAN4(2); RG_SCAN4(4); RG_SCAN4(8);
#undef RG_SCAN4
            }
            if (fr == 15) {
#pragma unroll
                for (int jt = 0; jt < 5; ++jt)
#pragma unroll
                    for (int j = 0; j < 4; j += 2) *(LAS f32x4*)(tot + w * 160 + (16 * jt + 4 * fq + j) * 2) = (f32x4){A[jt][j], U[jt][j], A[jt][j + 1], U[jt][j + 1]};
            }
            if (!(VAR & 1)) __syncthreads();
            if (tid < 80) {
#pragma unroll
                for (int ww = 0; ww < 8; ++ww) { const f32x2v q = *(LAS f32x2v*)(tot + ww * 160 + tid * 2); hinb[ww * 80 + tid] = hcar; hcar = q.x * hcar + q.y; }
            }
            if (r > 0) RG_YSTORE(r - 1);
            if (!(VAR & 2)) { if (r + 1 < SEQ / 128) RG_STASH((r + 1) & 1); }
            if (!(VAR & 1)) __syncthreads();
#pragma unroll
            for (int jt = 0; jt < 5; ++jt) {
                const f32x4 hq = *(LAS f32x4*)(hinb + w * 80 + 16 * jt + 4 * fq);
                const v2u gv = *(const LAS v2u*)(gb + 32 * jt);
                float y[4];
#pragma unroll
                for (int j = 0; j < 4; ++j) {
                    const float h = A[jt][j] * hq[j] + U[jt][j];
                    const unsigned gw = (j < 2) ? gv.x : gv.y;
                    const float gt = (j & 1) ? __uint_as_float(gw & 0xffff0000u) : __uint_as_float(gw << 16);
                    const float uu = 0.7978845608028654f * (gt + 0.044715f * gt * gt * gt);
                    y[j] = h * gt * __builtin_amdgcn_rcpf(1.f + __builtin_amdgcn_exp2f(-2.885390081777927f * uu));
                }
                *(LAS v2u*)(lds + RG_Y_OFF + (16 * w + fr) * RG_RS + 8 * fq + 32 * jt) = (v2u){pg8::cvt_pk_bf16(y[0], y[1]), pg8::cvt_pk_bf16(y[2], y[3])};
            }
        }
        __syncthreads();
        RG_YSTORE(SEQ / 128 - 1);
#undef RG_FETCH
#undef RG_STASH
#undef RG_YSTORE
    }
    BG_FINISH(0); BG_FINISH(1);
    while (bg_next < bg_end) { BG_ISSUE(0); BG_FINISH(0); }
#undef BG_ISSUE
#undef BG_FINISH
}
#ifndef PROBE_MASK
#define PROBE_MASK 0
#endif
#ifndef PROBE_VAR
#define PROBE_VAR 0
#endif
#ifndef PROBE_PFX_NULL
#define PROBE_PFX_NULL 0
#endif
#ifndef PROBE_DOWNVAR
#define PROBE_DOWNVAR 0
#endif
#if PROBE_DOWNVAR
#define DOWNVAR_CALL phase_moe_down_var<PROBE_DOWNVAR>(0, lds, tid_in, bid, G);
#else
#define DOWNVAR_CALL
#endif
#ifndef PROBE_UPVAR
#define PROBE_UPVAR 0
#endif
#if PROBE_UPVAR == 1
#define UPVAR_CALL phase_moe_up_null<true>(0, lds, tid_in, bid, G);
#elif PROBE_UPVAR == 2
#define UPVAR_CALL phase_moe_up_null<false>(0, lds, tid_in, bid, G);
#else
#define UPVAR_CALL
#endif
#ifndef PROBE_HALFLN
#define PROBE_HALFLN 0
#endif
#ifndef LN_V2
#define LN_V2 1
#endif
#if LN_V2
#define LN_FN phase_ln2
#else
#define LN_FN phase_ln
#endif
#ifndef PROBE_DRY
#define PROBE_DRY 0
#endif
struct Args { Params P; int ph_lo, ph_hi; };
__device__ __forceinline__ int lane_id_now() { int l; asm volatile("v_mbcnt_lo_u32_b32 %0, -1, 0\n\tv_mbcnt_hi_u32_b32 %0, -1, %0" : "=v"(l)); return l; }
__global__ void __launch_bounds__(NTHREADS, 2) mk_fwd(Args a) {
    extern __shared__ __attribute__((aligned(16))) unsigned char lds_raw[];
    LAS unsigned char* lds = (LAS unsigned char*)lds_raw;
    const int wv = __builtin_amdgcn_readfirstlane(threadIdx.x >> 6);
#define MYTID(wvv) ((wvv) * 64 + lane_id_now())
    volatile LAS unsigned* bst = (volatile LAS unsigned*)(lds + LDS_BYTES - 16);
    { const int t0 = MYTID(wv); if (t0 < 4) bst[t0] = 0u;
      __syncthreads();
      const Params P0 = kparams(); (void)xcd_barrier_post((unsigned*)(P0.ws + WS_BAR), bst, t0); }
#define SEAM(ph) do { if (hi > PH_COUNT) cg::this_grid().sync();   { const Params Pb = kparams(); XcdBarrier xb; xb.bar = (unsigned*)(Pb.ws + WS_BAR); xb.x = xb_xcc_id(); xb.st = bst; xcd_barrier(xb, tid_in); } } while (0)
#define RUN(ph, call) do { if (lo <= (ph) && (ph) < hi) { int bid = blockIdx.x, G = gridDim.x, wvl = wv; asm volatile("" : "+s"(bid), "+s"(G), "+s"(wvl)); const int tid_in = MYTID(wvl); \
        call; if ((PROBE_MASK >> (ph)) & 1) { call; } if ((ph) + 1 < hi && (ph) != PH_UP0 && (ph) != PH_UP1) SEAM(ph); } } while (0)
#define PHASE_PROGRAM \
    RUN(PH_PROLOGUE, phase_prologue(lds, tid_in, bid, G)); \
    RUN(PH_WIN, { if (pfx && PROBE_PFX_NULL) phase_gemm_win_null(lds, tid_in, bid, G); else phase_gemm_win(lds, tid_in, bid, G); }); \
    if ((PROBE_DRY >> PH_RGLRU) & 1) { int bid = blockIdx.x, G = gridDim.x; asm volatile("" : "+s"(bid), "+s"(G)); phase_rglru<PROBE_VAR>(lds, MYTID(wv), bid, G, true); } \
    RUN(PH_RGLRU, phase_rglru(lds, tid_in, bid, G)); \
    RUN(PH_WOUT, phase_gemm_wout(lds, tid_in, bid, G)); \
    RUN(PH_LN0, { if (PROBE_HALFLN == 1) phase_ln(0, lds, tid_in, bid, G, true); else if (PROBE_HALFLN == 2) { if ((bid & 7) < 4) phase_ln(0, lds, tid_in, (bid >> 3) * 4 + (bid & 7), G / 2, true); } LN_FN(0, lds, tid_in, bid, G); }); \
    RUN(PH_ROUTE0, phase_route(lds, tid_in, bid, G)); \
    RUN(PH_UP0, { UPVAR_CALL phase_moe_up(0, lds, tid_in, bid, G); }); \
    RUN(PH_DOWN0, { DOWNVAR_CALL phase_moe_down(0, lds, tid_in, bid, G); }); \
    RUN(PH_COMB0, phase_combine(0, tid_in, bid, G)); \
    RUN(PH_QKV, phase_gemm_qkv(lds, tid_in, bid, G)); \
    if ((PROBE_DRY >> PH_ATTN) & 1) { int bid = blockIdx.x, G = gridDim.x; asm volatile("" : "+s"(bid), "+s"(G)); phase_attn<PROBE_VAR>(lds, MYTID(wv), bid, G); } \
    RUN(PH_ATTN, phase_attn(lds, tid_in, bid, G)); \
    RUN(PH_WO, phase_gemm_wo(lds, tid_in, bid, G)); \
    RUN(PH_LN1, LN_FN(1, lds, tid_in, bid, G)); \
    RUN(PH_ROUTE1, phase_route(lds, tid_in, bid, G)); \
    RUN(PH_UP1, phase_moe_up(1, lds, tid_in, bid, G)); \
    RUN(PH_DOWN1, phase_moe_down(1, lds, tid_in, bid, G)); \
    RUN(PH_COMB1, phase_combine(1, tid_in, bid, G));
#ifdef PROBE_PREFIX
    { const int lo = 0, hi = PROBE_PREFIX; const bool pfx = true; PHASE_PROGRAM { const int tid_in = MYTID(wv); SEAM(0); } }
#endif
    { const int lo = a.ph_lo, hi = a.ph_hi; const bool pfx = false; PHASE_PROGRAM }
#ifdef PROBE_XBAR
    { const int hi = a.ph_hi; const int tid_in = MYTID(wv); for (int i = 0; i < PROBE_XBAR; ++i) SEAM(PH_COUNT - 1); }
#endif
#undef RUN
#undef SEAM
#undef MYTID
}
static int g_grid = 0;
extern "C" void kernel_launch(void* const* d_in, const int* in_sizes, int n_in, void* d_out, int out_size, void* d_ws, size_t ws_size, hipStream_t stream) {
    if (ws_size < WS_END || n_in < 22) { fprintf(stderr, "kernel_launch: workspace too small (%zu < %zu) or %d inputs\n", ws_size, (size_t)WS_END, n_in); return; }
    if (g_grid == 0) {
        int dev = 0, cus = 0, per_cu = 0;
        (void)hipGetDevice(&dev); (void)hipDeviceGetAttribute(&cus, hipDeviceAttributeMultiprocessorCount, dev);
        if (hipFuncSetAttribute((const void*)mk_fwd, hipFuncAttributeMaxDynamicSharedMemorySize, LDS_BYTES) != hipSuccess) fprintf(stderr, "kernel_launch: hipFuncSetAttribute failed\n");
        if (hipOccupancyMaxActiveBlocksPerMultiprocessor(&per_cu, (const void*)mk_fwd, NTHREADS, LDS_BYTES) != hipSuccess || per_cu < 1) { fprintf(stderr, "kernel_launch: occupancy query says %d blocks per CU\n", per_cu); per_cu = 1; }
        (void)hipGetLastError();
        g_grid = cus;
    }
    (void)hipMemsetAsync((unsigned char*)d_ws + WS_READY, 0, WS_BAR + 16384 - WS_READY, stream);
    Args a{};
    for (int i = 0; i < 22; ++i) a.P.in[i] = (const float*)d_in[i];
    a.P.out = (float*)d_out; a.P.ws = (unsigned char*)d_ws;
    a.ph_lo = 0; a.ph_hi = PH_COUNT;
    void* args[] = {&a};
    hipError_t e = hipLaunchCooperativeKernel((const void*)mk_fwd, dim3(g_grid), dim3(NTHREADS), args, LDS_BYTES, stream);
    if (e != hipSuccess) fprintf(stderr, "kernel_launch: cooperative launch failed: %s (grid %d)\n", hipGetErrorString(e), g_grid);
}
```

```cpp
#include <hip/hip_runtime.h>
#include <stdint.h>
#include <cstdio>
#include <hip/hip_cooperative_groups.h>
namespace cg = cooperative_groups;

typedef unsigned short bf16_t;
constexpr int D = 1024, BATCH = 16, SEQ = 2048, T = BATCH * SEQ;
constexpr int DR = 1280, BW = 80;
constexpr int NH = 16, HD = 64, WIN = 128;
constexpr int QKVD = 1536;
constexpr int NE = 32, DE = 512;
constexpr int MB = 256;
constexpr int TK = T * 2;
constexpr int NROWS_MAX = TK + NE * MB;
constexpr float ALPHA = 1.41421356237309515f;
constexpr float LN_EPS = 1e-5f;
constexpr float QSCALE = 0.125f * 1.4426950408889634f;

constexpr size_t MiB = 1u << 20;
constexpr size_t WS_CTL = 0;
constexpr size_t WS_READY = 256 * 1024, READY_BANK = 128 * 1024;
constexpr size_t WS_Q = 512 * 1024 - 4096;
constexpr size_t WS_XRDY = WS_READY + 80 * 1024;
constexpr size_t WS_BAR = 512 * 1024;
constexpr size_t WS_WIN = 1 * MiB, WS_WOUT = 6 * MiB, WS_WQKV = 8 * MiB + 512 * 1024, WS_WO = 11 * MiB + 512 * 1024, WS_GF = 13 * MiB + 512 * 1024;
constexpr size_t WS_ROUTE = 14 * MiB;
constexpr int RF_BYTES = 147456;
constexpr size_t WS_RF = 15 * MiB + 512 * 1024, WS_RC = WS_RF + 2 * (size_t)RF_BYTES;
#ifndef MIXQ_LAYOUT
#define MIXQ_LAYOUT 0
#endif
constexpr size_t WS_W13 = 16 * MiB, WS_W2 = 144 * MiB, WS_XB = 208 * MiB, WS_M = 272 * MiB, WS_END = (MIXQ_LAYOUT ? 512 : 488) * MiB;
constexpr size_t WS_XB2 = WS_W13;
constexpr size_t M_G = 0, M_XR = 80 * MiB, M_TMP = 160 * MiB;
constexpr size_t M_QKV = 0, M_O = 96 * MiB;
constexpr size_t M_HDN = 0, M_YS = (MIXQ_LAYOUT ? 96 : 72) * MiB;

#ifndef MOE_F8
#define MOE_F8 1
#endif
#ifndef YS_F8
#define YS_F8 1
#endif
#ifndef UP_F8
#define UP_F8 MOE_F8
#endif
#ifndef DOWN_F8
#define DOWN_F8 MOE_F8
#endif
#ifndef ATT_F8
#define ATT_F8 1
#endif
#ifndef WIN_F8
#define WIN_F8 0
#endif
#ifndef WOUT_F8
#define WOUT_F8 1
#endif
#ifndef LNSTAT
#define LNSTAT 1
#endif
constexpr size_t WS_STAT = WS_ROUTE + 1280 * 1024;
constexpr int Y8_SHIFT = 2;
constexpr size_t M_Y8 = 160 * MiB;
constexpr int O8_SHIFT = 3;
constexpr int W8_SHIFT = 6;
constexpr int W8_SCALE_WORD = (127 - W8_SHIFT) * 0x01010101, ONE_SCALE_WORD = 127 * 0x01010101;
constexpr size_t WS_XB8 = 80 * MiB;
__device__ __forceinline__ unsigned pk_fp8x4(float a, float b, float c, float d) { int p_ = 0; p_ = __builtin_amdgcn_cvt_pk_fp8_f32(a, b, p_, false); p_ = __builtin_amdgcn_cvt_pk_fp8_f32(c, d, p_, true); return (unsigned)p_; }
__device__ __forceinline__ float bf2f(bf16_t v) { return __uint_as_float((unsigned)v << 16); }
__device__ __forceinline__ bf16_t f2bf(float f) { unsigned u = __float_as_uint(f); return (bf16_t)((u + 0x7fffu + ((u >> 16) & 1u)) >> 16); }


#ifndef WT_STORES
#define WT_STORES 0
#endif
typedef unsigned wt_v4u __attribute__((ext_vector_type(4)));
typedef unsigned wt_v2u __attribute__((ext_vector_type(2)));
__device__ __forceinline__ void st16_wt(void* p, wt_v4u v) {
#if WT_STORES
    asm volatile("global_store_dwordx4 %0, %1, off sc1\n\ts_nop 1" :: "v"(p), "v"(v) : "memory");
#else
    *(wt_v4u*)p = v;
#endif
}
__device__ __forceinline__ void st8_wt(void* p, wt_v2u v) {
#if WT_STORES
    asm volatile("global_store_dwordx2 %0, %1, off sc1\n\ts_nop 0" :: "v"(p), "v"(v) : "memory");
#else
    *(wt_v2u*)p = v;
#endif
}

#ifndef WT_GEMM
#define WT_GEMM 0
#endif
__device__ __forceinline__ void st16_gemm(void* p, wt_v4u v) {
#if WT_GEMM == 1
    asm volatile("global_store_dwordx4 %0, %1, off sc1\n\ts_nop 1" :: "v"(p), "v"(v) : "memory");
#elif WT_GEMM == 2
    asm volatile("global_store_dwordx4 %0, %1, off nt\n\ts_nop 1" :: "v"(p), "v"(v) : "memory");
#elif WT_GEMM == 3
    asm volatile("global_store_dwordx4 %0, %1, off sc0 sc1\n\ts_nop 1" :: "v"(p), "v"(v) : "memory");
#else
    *(wt_v4u*)p = v;
#endif
}

#ifndef NT_STREAMS
#define NT_STREAMS 1
#endif
#if NT_STREAMS
#define NT_LOAD(p) __builtin_nontemporal_load(p)
#else
#define NT_LOAD(p) (*(p))
#endif
#ifndef NT_RECENT
#define NT_RECENT 0
#endif
#if NT_RECENT
#define NT_LOAD_R(p) __builtin_nontemporal_load(p)
#else
#define NT_LOAD_R(p) (*(p))
#endif

#ifndef NT_SEL
#define NT_SEL 0
#endif
#define NT_LOAD_S(bit, p) (((NT_SEL >> (bit)) & 1) ? __builtin_nontemporal_load(p) : *(p))
#ifndef PG8_STAGGER_TICKS
#define PG8_STAGGER_TICKS 0
#endif
#ifndef PG8_CHUNKED
#define PG8_CHUNKED 0
#endif
#ifndef PG8_MOE_AUX_B
#define PG8_MOE_AUX_B 0
#endif
#ifndef PG8_DOWN_AUX
#define PG8_DOWN_AUX 16
#endif
#ifndef PG8_ROWMAJOR
#define PG8_ROWMAJOR 0
#endif
#ifndef PG8_XCDREMAP
#define PG8_XCDREMAP 1
#endif
#ifndef PG8_WGM
#define PG8_WGM 2
#endif
namespace pg8 {
#define PG8_LAS __attribute__((address_space(3)))
typedef short bf16x8 __attribute__((ext_vector_type(8)));
typedef float f32x4 __attribute__((ext_vector_type(4)));
typedef unsigned u32x4 __attribute__((ext_vector_type(4)));
typedef unsigned u32x2 __attribute__((ext_vector_type(2)));
typedef int v4i_t __attribute__((ext_vector_type(4)));
typedef int v8i_t __attribute__((ext_vector_type(8)));
constexpr int BM = 256, BK = 64, HALF = 128, HTB = HALF * BK * 2  , STAGE_BYTES = 8 * HTB, NXCD = 8, WGM = PG8_WGM;

__host__ __device__ __forceinline__ int lds_byte(int r, int c) { const int st = (r >> 4) * 2 + (c >> 5), rr = r & 15, cc = c & 31, ob = rr * 64 + cc * 2; return st * 1024 + (ob ^ (((ob >> 9) & 1) << 5)); }
__host__ __device__ __forceinline__ void stage_rc(int b, int& R, int& C) { const int st = b / 1024, sb = b % 1024, swz = sb ^ (((sb >> 9) & 1) << 5); R = (st >> 1) * 16 + swz / 64; C = (st & 1) * 32 + (swz % 64) / 2; }
__host__ __device__ __forceinline__ int perm32(int rho) { const int n = rho >> 4, i = rho & 15; return 8 * (i >> 2) + 4 * n + (i & 3); }

struct Unit { int pm, pn, li; };

template <int WGM_> __device__ __forceinline__ bool order_at(long L, int nM, int nN, Unit& u) {
    constexpr int WGM = WGM_;
    const int nwg = nM * nN; if (L >= nwg) return false;
    int wgid = (int)L; if (PG8_XCDREMAP) { const int q = nwg / NXCD, r = nwg % NXCD, xcd = wgid % NXCD, off = wgid / NXCD; wgid = (xcd < r ? xcd * (q + 1) : r * (q + 1) + (xcd - r) * q) + off; }
    const int nig = WGM * nN, gid = wgid / nig, fm = gid * WGM, gsz = (nM - fm) < WGM ? (nM - fm) : WGM;
    if (PG8_ROWMAJOR) { u.pm = fm + ((wgid % nig) / nN); u.pn = (wgid % nig) % nN; if (u.pm >= fm + gsz) { const int idx = wgid % nig; u.pm = fm + idx % gsz; u.pn = idx / gsz; } }
    else { u.pm = fm + ((wgid % nig) % gsz); u.pn = (wgid % nig) / gsz; }
    return true;
}
template <int WGM_> __device__ __forceinline__ bool order_next(int i, int G, int c, int nM, int nN, Unit& u) {
#if PG8_CHUNKED
    const int nwg = nM * nN, per = (nwg + G - 1) / G; if (i >= per) return false; return order_at<WGM_>((long)c * per + i, nM, nN, u);
#else
    return order_at<WGM_>((long)i * G + c, nM, nN, u);
#endif
}
template <int K_, int NN_, bool GATHER, bool EXPERT, int DEP = 0, int WGM_ = PG8_WGM, bool DYN_ = false, bool F8_ = false, int ASH_ = 0>
struct Order {
    static constexpr bool F8 = F8_; static constexpr int ASH = ASH_;
    static constexpr int K = K_, nN = NN_, AUX_A = (DEP == 2) ? PG8_DOWN_AUX : 0, AUX_B = EXPERT ? PG8_MOE_AUX_B : 0;
    static constexpr bool DYN = DYN_; static constexpr int DEPK = DEP;
    int nM, G, c; const char* A; const char* Bt; const int* block_e; const int* rowtok; unsigned* ready; unsigned need; const PG8_LAS int* tokl;
    unsigned* qctr = nullptr;
    __device__ __forceinline__ bool at_ticket(unsigned ticket, Unit& u) const { return order_at<WGM_>((long)ticket * 8 + (c & 7), nM, nN, u); }
    __device__ __forceinline__ bool next(int i, Unit& u) const { return order_next<WGM_>(i, G, c, nM, nN, u); }
    __device__ __forceinline__ const char* a_base(const Unit& u) const { return GATHER ? A : A + (size_t)u.pm * BM * K * 2; }
    __device__ __forceinline__ const char* b_base(const Unit& u) const { return Bt + (EXPERT ? (size_t)__builtin_amdgcn_readfirstlane(block_e[u.pm]) * (size_t)(nN * BM) * K * 2 : (size_t)0) + (size_t)u.pn * BM * K * 2; }
    __device__ __forceinline__ unsigned a_rowoff(const Unit& u, int r) const {
        if (GATHER) return (unsigned)tokl[u.li * BM + r] * (unsigned)(K * 2);
        return (unsigned)(r * K * 2);
    }
    __device__ __forceinline__ void fill_tokl(PG8_LAS int* dst, int tid) const {
        Unit u;
        int sv[8]; int nu = 0;
#pragma unroll
        for (int i = 0; i < 8; ++i) { sv[i] = -1; if (next(i, u)) { nu = i + 1; if (tid < BM) sv[i] = rowtok[u.pm * BM + tid]; } }
#pragma unroll
        for (int i = 0; i < 8; ++i) if (i < nu && tid < BM) dst[i * BM + tid] = sv[i] >= 0 ? (sv[i] >> 1) : 0;
        for (int i = 8; next(i, u); ++i) if (tid < BM) { const int s = rowtok[u.pm * BM + tid]; dst[i * BM + tid] = s >= 0 ? (s >> 1) : 0; }
    }
    __device__ __forceinline__ unsigned a_peek(const Unit& u) const { return (DEP >= 2) ? __hip_atomic_load(ready + 64 * u.pm, __ATOMIC_RELAXED, __HIP_MEMORY_SCOPE_AGENT) : 0u; }
    __device__ __forceinline__ void a_ready(const Unit& u, int tid, unsigned peek = 0u) const {
        if (DEP >= 2) {
            if (tid < 64 && (unsigned)__builtin_amdgcn_readfirstlane(peek) < need) { unsigned spins = 0;
                while ((unsigned)__builtin_amdgcn_readfirstlane(__hip_atomic_load(ready + 64 * u.pm, __ATOMIC_RELAXED, __HIP_MEMORY_SCOPE_AGENT)) < need) { __builtin_amdgcn_s_sleep(2); if (++spins > (1u << 22)) break; } }
            asm volatile("" ::: "memory"); __builtin_amdgcn_s_barrier(); asm volatile("" ::: "memory");
        }
    }
    __device__ __forceinline__ void done(const Unit& u, int lane) const {
        if (DEP == 1) { asm volatile("s_waitcnt vmcnt(0)" ::: "memory"); if (lane == 0) __hip_atomic_fetch_add(ready + 64 * u.pm, 1u, __ATOMIC_RELAXED, __HIP_MEMORY_SCOPE_AGENT); }
    }
};

__device__ __forceinline__ unsigned cvt_pk_bf16(float lo, float hi) { unsigned r; asm volatile("v_cvt_pk_bf16_f32 %0, %1, %2" : "=v"(r) : "v"(lo), "v"(hi)); return r; }

__device__ __forceinline__ float gelu_tanh_fast(float x) { const float uu = 0.7978845608028654f * (x + 0.044715f * x * x * x); return x * __builtin_amdgcn_rcpf(1.f + __builtin_amdgcn_exp2f(-2.885390081777927f * uu)); }
__device__ __forceinline__ void store_full_lines(bf16_t* grp  , int ldc, int fr, int fq, const u32x4 (&w)[2]) {
    const bool lo = fr < 8;
    u32x4 snd, rcv;
#pragma unroll
    for (int k = 0; k < 4; ++k) { snd[k] = lo ? w[1][k] : w[0][k]; rcv[k] = (unsigned)__builtin_amdgcn_update_dpp(0, (int)snd[k], 0x128  , 0xF, 0xF, false); }
    u32x4 da, db;
#pragma unroll
    for (int k = 0; k < 4; ++k) { da[k] = lo ? w[0][k] : rcv[k]; db[k] = lo ? rcv[k] : w[1][k]; }
    bf16_t* p = grp + (size_t)(fr & 7) * ldc + (lo ? 0 : 32) + 8 * fq;
    *(u32x4*)p = da; *(u32x4*)(p + (size_t)8 * ldc) = db;
}
struct EpiBf16 {
    static constexpr bool PERM = true, FULL = true; static constexpr int NST = 16;
    bf16_t* O; int ldc; int split_cols; size_t split_stride; float scale0;
    __device__ __forceinline__ void operator()(const f32x4 (&acc)[2][2][4][2], const Unit& u, int wr, int wc, int fr, int fq) const {
        int colt = u.pn * BM; bf16_t* base = O;
        float sc = 1.f; if (split_cols) { const int t = colt / split_cols; base += (size_t)t * split_stride; colt -= t * split_cols; if (t == 0) sc = scale0; }
#pragma unroll
        for (int ai = 0; ai < 2; ++ai)
#pragma unroll
            for (int m = 0; m < 4; ++m) { u32x4 w[2];
#pragma unroll
                for (int bj = 0; bj < 2; ++bj) { const f32x4 v0 = acc[ai][bj][m][0] * sc, v1 = acc[ai][bj][m][1] * sc;
                    w[bj].x = cvt_pk_bf16(v0[0], v0[1]); w[bj].y = cvt_pk_bf16(v0[2], v0[3]); w[bj].z = cvt_pk_bf16(v1[0], v1[1]); w[bj].w = cvt_pk_bf16(v1[2], v1[3]); }
                store_full_lines(base + (size_t)(u.pm * BM + wr * 64 + ai * HALF + m * 16) * ldc + colt + wc * 64, ldc, fr, fq, w); }
    }
};
struct EpiFp8 {
    static constexpr bool PERM = true, FULL = true; static constexpr int NST = 16;
    unsigned char* O; int ldc;
    __device__ __forceinline__ void operator()(const f32x4 (&acc)[2][2][4][2], const Unit& u, int wr, int wc, int fr, int fq) const {
#pragma unroll
        for (int ai = 0; ai < 2; ++ai)
#pragma unroll
            for (int m = 0; m < 4; ++m) { unsigned char* rowp = O + (size_t)(u.pm * BM + wr * 64 + ai * HALF + m * 16 + fr) * ldc + u.pn * BM + wc * 64 + 8 * fq;
#pragma unroll
                for (int bj = 0; bj < 2; ++bj) { const f32x4 v0 = acc[ai][bj][m][0], v1 = acc[ai][bj][m][1];
                    u32x2 w; w.x = pk_fp8x4(v0[0], v0[1], v0[2], v0[3]); w.y = pk_fp8x4(v1[0], v1[1], v1[2], v1[3]);
                    *(u32x2*)(rowp + 32 * bj) = w; } }
    }
};
struct EpiNull {
    static constexpr bool PERM = true, FULL = true; static constexpr int NST = 0;
    __device__ __forceinline__ void operator()(const f32x4 (&acc)[2][2][4][2], const Unit&, int, int, int, int) const {
#pragma unroll
        for (int ai = 0; ai < 2; ++ai)
#pragma unroll
            for (int bj = 0; bj < 2; ++bj)
#pragma unroll
                for (int m = 0; m < 4; ++m)
#pragma unroll
                    for (int n = 0; n < 2; ++n) asm volatile("" :: "v"(acc[ai][bj][m][n]));
    }
};
template <bool RES_BF16>
struct EpiResidZ {
    static constexpr bool PERM = true, FULL = true; static constexpr int NST = 16;
    const void* res; bf16_t* Z; float alpha;
    __device__ __forceinline__ void operator()(const f32x4 (&acc)[2][2][4][2], const Unit& u, int wr, int wc, int fr, int fq) const {
        const int row0 = u.pm * BM + wr * 64 + fr, col0 = u.pn * BM + wc * 64 + 8 * fq;
        u32x4 rbp[2][4][2];
        if (RES_BF16) {
#pragma unroll
            for (int ai = 0; ai < 2; ++ai)
#pragma unroll
                for (int m = 0; m < 4; ++m)
#pragma unroll
                    for (int bj = 0; bj < 2; ++bj) rbp[ai][m][bj] = *(const u32x4*)((const bf16_t*)res + (size_t)(row0 + ai * HALF + m * 16) * 1024 + col0 + bj * 32);
            asm volatile("" ::: "memory");
        }
#pragma unroll
        for (int ai = 0; ai < 2; ++ai)
#pragma unroll
            for (int m = 0; m < 4; ++m) { const size_t off = (size_t)(row0 + ai * HALF + m * 16) * 1024 + col0; u32x4 w[2];
#pragma unroll
                for (int bj = 0; bj < 2; ++bj) { f32x4 r0, r1;
                    if (RES_BF16) { const u32x4 rb = rbp[ai][m][bj];
                        r0 = (f32x4){__uint_as_float(rb.x << 16), __uint_as_float(rb.x & 0xffff0000u), __uint_as_float(rb.y << 16), __uint_as_float(rb.y & 0xffff0000u)};
                        r1 = (f32x4){__uint_as_float(rb.z << 16), __uint_as_float(rb.z & 0xffff0000u), __uint_as_float(rb.w << 16), __uint_as_float(rb.w & 0xffff0000u)}; }
                    else { r0 = NT_LOAD((const f32x4*)((const float*)res + off + bj * 32)); r1 = NT_LOAD((const f32x4*)((const float*)res + off + bj * 32 + 4)); }
                    const f32x4 v0 = r0 * alpha + acc[ai][bj][m][0], v1 = r1 * alpha + acc[ai][bj][m][1];
                    w[bj].x = cvt_pk_bf16(v0[0], v0[1]); w[bj].y = cvt_pk_bf16(v0[2], v0[3]); w[bj].z = cvt_pk_bf16(v1[0], v1[1]); w[bj].w = cvt_pk_bf16(v1[2], v1[3]); }
                store_full_lines(Z + (size_t)(u.pm * BM + wr * 64 + ai * HALF + m * 16) * 1024 + u.pn * BM + wc * 64, 1024, fr, fq, w); }
    }
};
struct EpiSwiglu8 {
    static constexpr bool PERM = true, FULL = false; static constexpr int NST = 0;
    unsigned char* H;
    __device__ __forceinline__ void operator()(const f32x4 (&acc)[2][2][4][2], const Unit& u, int wr, int wc, int fr, int fq) const {
        const int row0 = u.pm * BM + wr * 64 + fr, col0 = u.pn * HALF + wc * 32 + 8 * fq;
#pragma unroll
        for (int ai = 0; ai < 2; ++ai)
#pragma unroll
            for (int m = 0; m < 4; ++m) { float h[8];
#pragma unroll
                for (int n = 0; n < 2; ++n)
#pragma unroll
                    for (int j = 0; j < 4; ++j) { const float a = acc[ai][0][m][n][j], b = acc[ai][1][m][n][j];
                        h[n * 4 + j] = a * __builtin_amdgcn_rcpf(1.f + __builtin_amdgcn_exp2f(-1.4426950408889634f * a)) * b; }
                u32x2 w; w.x = pk_fp8x4(h[0], h[1], h[2], h[3]); w.y = pk_fp8x4(h[4], h[5], h[6], h[7]);
                asm volatile("global_store_dwordx2 %0, %1, off sc1\n\ts_nop 0" :: "v"(H + (size_t)(row0 + ai * HALF + m * 16) * 512 + col0), "v"(w) : "memory"); }
    }
};
struct EpiSwiglu {
    static constexpr bool PERM = true, FULL = false; static constexpr int NST = 0;
    bf16_t* H;
    __device__ __forceinline__ void operator()(const f32x4 (&acc)[2][2][4][2], const Unit& u, int wr, int wc, int fr, int fq) const {
        const int row0 = u.pm * BM + wr * 64 + fr, col0 = u.pn * HALF + wc * 32 + 8 * fq;
#pragma unroll
        for (int ai = 0; ai < 2; ++ai)
#pragma unroll
            for (int m = 0; m < 4; ++m) { float h[8];
#pragma unroll
                for (int n = 0; n < 2; ++n)
#pragma unroll
                    for (int j = 0; j < 4; ++j) { const float a = acc[ai][0][m][n][j], b = acc[ai][1][m][n][j];
                        h[n * 4 + j] = a * __builtin_amdgcn_rcpf(1.f + __builtin_amdgcn_exp2f(-1.4426950408889634f * a)) * b; }
                u32x4 w; w.x = cvt_pk_bf16(h[0], h[1]); w.y = cvt_pk_bf16(h[2], h[3]); w.z = cvt_pk_bf16(h[4], h[5]); w.w = cvt_pk_bf16(h[6], h[7]);
                asm volatile("global_store_dwordx4 %0, %1, off sc1\n\ts_nop 1" :: "v"(H + (size_t)(row0 + ai * HALF + m * 16) * 512 + col0), "v"(w) : "memory"); }
    }
};

#ifndef PG8_RELAX
#define PG8_RELAX 0
#endif
template <class Epi, class Sched, bool ALIGN_EPI>
__device__ __forceinline__ void gemm_phase(PG8_LAS unsigned char* lds, const int tid_in, const Sched& S, const Epi& E) {
    constexpr int K = Sched::K;
    int tid = tid_in; asm volatile("" : "+v"(tid));
    const int wid = __builtin_amdgcn_readfirstlane(tid >> 6), lane = tid & 63, wr = wid >> 2, wc = wid & 3, fr = lane & 15, fq = lane >> 4;
    const int nt = K / BK;
    int Rr[2], Cc[2]; unsigned voffB[2][2];
#pragma unroll
    for (int i = 0; i < 2; ++i) { int R, C; stage_rc(tid * 16 + i * 8192, R, C); Rr[i] = R; Cc[i] = C;
#pragma unroll
        for (int h = 0; h < 2; ++h) {
            const int col = Epi::FULL ? (64 * (R >> 5) + 32 * h + perm32(R & 31)) : (HALF * h + (Epi::PERM ? ((R & ~31) + perm32(R & 31)) : R));
            voffB[h][i] = (unsigned)(col * K + C) * 2u; } }
    const size_t kstep = (size_t)(BK * 2);
    const unsigned ldsw = (unsigned)wid * 1024u;
    const int aoff = lds_byte(wr * 64 + fr, fq * 8), boff = lds_byte(wc * 32 + fr, fq * 8);
#define PG8_SA(b, h) (((b) * 2 + (h)) * HTB)
#define PG8_SB(b, h) ((4 + (b) * 2 + (h)) * HTB)
#define PG8_UNI(p_) ((const char*)(((unsigned long long)(unsigned)__builtin_amdgcn_readfirstlane((int)((unsigned long long)(p_) >> 32)) << 32) | (unsigned long long)(unsigned)__builtin_amdgcn_readfirstlane((int)(unsigned long long)(p_))))
#define PG8_STAGE(bufoff, gbase, voff) do { const char* gb_ = PG8_UNI(gbase); _Pragma("unroll") for (int _i = 0; _i < 2; ++_i) \
        __builtin_amdgcn_global_load_lds((const unsigned*)(gb_ + (voff)[_i]), (PG8_LAS unsigned*)(lds + (bufoff) + ldsw + _i * 8192), 16, 0, Sched::AUX_B); } while (0)
#define PG8_STAGEA(bufoff, gbase, voff) do { const char* gb_ = PG8_UNI(gbase); _Pragma("unroll") for (int _i = 0; _i < 2; ++_i) \
        __builtin_amdgcn_global_load_lds((const unsigned*)(gb_ + (voff)[_i]), (PG8_LAS unsigned*)(lds + (bufoff) + ldsw + _i * 8192), 16, 0, Sched::AUX_A); } while (0)
#define PG8_LDA(dst, b, h) do { _Pragma("unroll") for (int m = 0; m < 4; ++m) _Pragma("unroll") for (int k = 0; k < 2; ++k) dst[m][k] = *(const PG8_LAS bf16x8*)(lds + PG8_SA(b, h) + aoff + m * 2048 + k * 1024); } while (0)
#define PG8_LDB(dst, b, h) do { _Pragma("unroll") for (int n = 0; n < 2; ++n) _Pragma("unroll") for (int k = 0; k < 2; ++k) dst[n][k] = *(const PG8_LAS bf16x8*)(lds + PG8_SB(b, h) + boff + n * 2048 + k * 1024); } while (0)
#define PG8_CAT8(x0_, x1_) __builtin_shufflevector(__builtin_bit_cast(v4i_t, x0_), __builtin_bit_cast(v4i_t, x1_), 0, 1, 2, 3, 4, 5, 6, 7)
#define PG8_MMA(ai, bj, At, Bt) do { __builtin_amdgcn_s_setprio(1); \
        if constexpr (Sched::F8) { _Pragma("unroll") for (int m = 0; m < 4; ++m) _Pragma("unroll") for (int n = 0; n < 2; ++n) \
            { const v8i_t a8_ = PG8_CAT8(Bt[n][0], Bt[n][1]), b8_ = PG8_CAT8(At[m][0], At[m][1]); \
              asm volatile("v_mfma_scale_f32_16x16x128_f8f6f4 %0, %1, %2, %0, %3, %4 op_sel_hi:[0,0,0]" : "+v"(acc[ai][bj][m][n]) : "v"(a8_), "v"(b8_), "v"(f8sw_), "v"(f8so_)); } } \
        else { _Pragma("unroll") for (int m = 0; m < 4; ++m) _Pragma("unroll") for (int n = 0; n < 2; ++n) _Pragma("unroll") for (int k = 0; k < 2; ++k) \
            acc[ai][bj][m][n] = __builtin_amdgcn_mfma_f32_16x16x32_bf16(Bt[n][k], At[m][k], acc[ai][bj][m][n], 0, 0, 0); } \
        __builtin_amdgcn_s_setprio(0); } while (0)
#define PG8_WAIT_V(n) asm volatile("s_waitcnt vmcnt(" #n ")" ::: "memory")
#define PG8_WAIT_V8_OR_24(relax_) asm volatile("s_cmp_lg_u32 %0, 0\n\ts_cbranch_scc1 .Lpg8rx%=\n\ts_waitcnt vmcnt(8)\n.Lpg8rx%=:\n\ts_waitcnt vmcnt(24)" :: "s"(relax_) : "memory", "scc")
#if PG8_RELAX
#define PG8_WAIT_FIRST2(r_) PG8_WAIT_V8_OR_24(r_)
#else
#define PG8_WAIT_FIRST2(r_) do { (void)(r_); PG8_WAIT_V(8); } while (0)
#endif
#define PG8_WAIT_L(n) asm volatile("s_waitcnt lgkmcnt(" #n ")" ::: "memory")
#define PG8_BAR __builtin_amdgcn_s_barrier()
#define PG8_SCHED __builtin_amdgcn_sched_barrier(0)
#define PG8_VOFF(dst, u) do { _Pragma("unroll") for (int _h = 0; _h < 2; ++_h) _Pragma("unroll") for (int _i = 0; _i < 2; ++_i) dst[_h][_i] = S.a_rowoff(u, _h * HALF + Rr[_i]) + (unsigned)(Cc[_i] * 2); } while (0)
    int f8sw_ = W8_SCALE_WORD, f8so_ = (127 - Sched::ASH) * 0x01010101; asm volatile("" : "+v"(f8sw_), "+v"(f8so_));
    Unit cur, nxt; int ui = 0;
    PG8_LAS unsigned* qslot = (PG8_LAS unsigned*)(lds + 131072 + 64);
    unsigned qv = 0u;
    constexpr bool DYN2 = Sched::DYN && (K / BK) < 8;
    if constexpr (Sched::DYN) {
        if (tid == 0) { qslot[0] = __hip_atomic_fetch_add(S.qctr, 1u, __ATOMIC_RELAXED, __HIP_MEMORY_SCOPE_AGENT);
            if (DYN2) qslot[1] = __hip_atomic_fetch_add(S.qctr, 1u, __ATOMIC_RELAXED, __HIP_MEMORY_SCOPE_AGENT); }
        __syncthreads();
        const unsigned tk0 = (unsigned)__builtin_amdgcn_readfirstlane((int)*qslot);
        if (!S.at_ticket(tk0, cur)) return;
    } else { if (!S.next(0, cur)) return; }
    cur.li = 0;
#if PG8_STAGGER_TICKS
    if (S.c & 1) { const unsigned long long t0 = __builtin_amdgcn_s_memrealtime(); while (__builtin_amdgcn_s_memrealtime() - t0 < (unsigned long long)PG8_STAGGER_TICKS) __builtin_amdgcn_s_sleep(16); }
#endif
    f32x4 acc[2][2][4][2];
#pragma unroll
    for (int a = 0; a < 2; ++a)
#pragma unroll
        for (int b = 0; b < 2; ++b)
#pragma unroll
            for (int m = 0; m < 4; ++m)
#pragma unroll
                for (int n = 0; n < 2; ++n) acc[a][b][m][n] = (f32x4){0.f, 0.f, 0.f, 0.f};
    bf16x8 At[4][2], B0[2][2], B1[2][2];
    unsigned vC[2][2], vN[2][2];
    PG8_VOFF(vC, cur);
    const char* cA = S.a_base(cur); const char* cB = S.b_base(cur);
    S.a_ready(cur, tid);
    PG8_STAGE(PG8_SB(0, 0), cB, voffB[0]); PG8_STAGE(PG8_SB(0, 1), cB, voffB[1]); PG8_STAGEA(PG8_SA(0, 0), cA, vC[0]); PG8_STAGEA(PG8_SA(0, 1), cA, vC[1]);
    if (wr == 1) PG8_BAR;
    PG8_WAIT_V(2); PG8_BAR;
    PG8_STAGE(PG8_SB(1, 0), cB + kstep, voffB[0]); PG8_STAGEA(PG8_SA(1, 0), cA + kstep, vC[0]); PG8_STAGE(PG8_SB(1, 1), cB + kstep, voffB[1]);
    PG8_WAIT_V(6); PG8_BAR;
    for (;;) {
        bool has_next = false;
        const char* nA = cA; const char* nB = cB;
#pragma unroll
        for (int h = 0; h < 2; ++h)
#pragma unroll
            for (int i = 0; i < 2; ++i) vN[h][i] = vC[h][i];
        unsigned peek = 0u;
        if constexpr (!Sched::DYN) {
            has_next = S.next(ui + 1, nxt); nxt.li = ui + 1;
            if (has_next) { nA = S.a_base(nxt); nB = S.b_base(nxt); PG8_VOFF(vN, nxt); peek = S.a_peek(nxt); }
        } else {
            if constexpr (DYN2) {
                const unsigned tk = (unsigned)__builtin_amdgcn_readfirstlane((int)qslot[(ui + 1) & 1]); has_next = S.at_ticket(tk, nxt); nxt.li = ui + 1;
                if (has_next) { nA = S.a_base(nxt); nB = S.b_base(nxt); PG8_VOFF(vN, nxt);
                    if (Sched::DEPK >= 2) asm volatile("global_load_dword %0, %1, off sc1" : "=v"(peek) : "v"(S.ready + 64 * nxt.pm) : "memory"); }
            }
            if (tid == 0) { const unsigned one_ = 1u; asm volatile("global_atomic_add %0, %1, %2, off sc0" : "=v"(qv) : "v"(S.qctr), "v"(one_) : "memory"); }
        }
#pragma unroll 1
        for (int t = 0; t < nt; t += 2) {
            const bool last = (t == nt - 2);
            if constexpr (DYN2) { if (t == 2 && tid == 0) qslot[ui & 1] = qv; }
            else if constexpr (Sched::DYN) {
                if (t == 2 && tid == 0) *qslot = qv;
                if (t == 4) { const unsigned tk = (unsigned)__builtin_amdgcn_readfirstlane((int)*qslot); has_next = S.at_ticket(tk, nxt); nxt.li = ui + 1;
                    if (has_next) { nA = S.a_base(nxt); nB = S.b_base(nxt); PG8_VOFF(vN, nxt);
                        if (Sched::DEPK >= 2) asm volatile("global_load_dword %0, %1, off sc1" : "=v"(peek) : "v"(S.ready + 64 * nxt.pm) : "memory"); } }
            }
            if (last && has_next) S.a_ready(nxt, tid, peek);
            const char* a1 = cA + (size_t)(t + 1) * kstep;
            const char* a2 = last ? nA : cA + (size_t)(t + 2) * kstep; const char* b2 = last ? nB : cB + (size_t)(t + 2) * kstep;
            const char* a3 = a2 + kstep; const char* b3 = b2 + kstep;
            unsigned v2[2][2];
#pragma unroll
            for (int h = 0; h < 2; ++h)
#pragma unroll
                for (int i = 0; i < 2; ++i) v2[h][i] = last ? vN[h][i] : vC[h][i];
            const int relax = __builtin_amdgcn_readfirstlane((PG8_RELAX && Epi::NST == 16 && ui > 0 && t == 0) ? 1 : 0);
            PG8_LDB(B0, 0, 0); PG8_LDB(B1, 0, 1); PG8_SCHED; PG8_LDA(At, 0, 0); PG8_STAGEA(PG8_SA(1, 1), a1, vC[1]);
            PG8_WAIT_FIRST2(relax);
            PG8_WAIT_L(0); PG8_BAR; PG8_MMA(0, 0, At, B0); PG8_MMA(0, 1, At, B1); PG8_BAR; PG8_SCHED;
            PG8_LDA(At, 0, 1); PG8_STAGE(PG8_SB(0, 0), b2, voffB[0]); PG8_STAGE(PG8_SB(0, 1), b2, voffB[1]); PG8_STAGEA(PG8_SA(0, 0), a2, v2[0]);
            PG8_WAIT_FIRST2(relax);
            PG8_WAIT_L(0); PG8_BAR; PG8_MMA(1, 0, At, B0); PG8_MMA(1, 1, At, B1); PG8_BAR; PG8_SCHED;
            PG8_LDB(B0, 1, 0); PG8_LDB(B1, 1, 1); PG8_SCHED; PG8_LDA(At, 1, 0); PG8_STAGEA(PG8_SA(0, 1), a2, v2[1]);
            PG8_WAIT_V(8); PG8_WAIT_L(0); PG8_BAR; PG8_MMA(0, 0, At, B0); PG8_MMA(0, 1, At, B1); PG8_BAR; PG8_SCHED;
            PG8_LDA(At, 1, 1); PG8_STAGE(PG8_SB(1, 0), b3, voffB[0]); PG8_STAGE(PG8_SB(1, 1), b3, voffB[1]); PG8_STAGEA(PG8_SA(1, 0), a3, v2[0]);
            PG8_WAIT_V(8); PG8_WAIT_L(0); PG8_BAR; PG8_MMA(1, 0, At, B0); PG8_MMA(1, 1, At, B1); PG8_BAR; PG8_SCHED;
        }
        if constexpr (Sched::F8) asm volatile("s_nop 15\n\ts_nop 15" ::: "memory");
        if constexpr (ALIGN_EPI) { if (wr == 0) PG8_BAR; }
        E(acc, cur, wr, wc, fr, fq); S.done(cur, lane);
        if (!has_next) break;
#pragma unroll
        for (int a = 0; a < 2; ++a)
#pragma unroll
            for (int b = 0; b < 2; ++b)
#pragma unroll
                for (int m = 0; m < 4; ++m)
#pragma unroll
                    for (int n = 0; n < 2; ++n) acc[a][b][m][n] = (f32x4){0.f, 0.f, 0.f, 0.f};
        cur = nxt; cA = nA; cB = nB; ++ui;
#pragma unroll
        for (int h = 0; h < 2; ++h)
#pragma unroll
            for (int i = 0; i < 2; ++i) vC[h][i] = vN[h][i];
        if constexpr (ALIGN_EPI) { if (wr == 1) PG8_BAR; }
    }
    PG8_WAIT_V(0);
    if constexpr (!ALIGN_EPI) { if (wr == 0) PG8_BAR; }
    PG8_BAR;
#undef PG8_SA
#undef PG8_SB
#undef PG8_STAGE
#undef PG8_STAGEA
#undef PG8_UNI
#undef PG8_LDA
#undef PG8_LDB
#undef PG8_MMA
#undef PG8_CAT8
#undef PG8_WAIT_V
#undef PG8_WAIT_L
#undef PG8_WAIT_V8_OR_24
#undef PG8_WAIT_FIRST2
#undef PG8_BAR
#undef PG8_SCHED
#undef PG8_VOFF
}
}
#define GAS __attribute__((address_space(1)))
#define LAS __attribute__((address_space(3)))
typedef unsigned v4u __attribute__((ext_vector_type(4)));
typedef unsigned v2u __attribute__((ext_vector_type(2)));
typedef float f32x4 __attribute__((ext_vector_type(4)));
typedef short s16x4 __attribute__((ext_vector_type(4)));
typedef short bf16x8 __attribute__((ext_vector_type(8)));
constexpr int NWAVES = 8, NTHREADS = 512;
constexpr int LDS_BYTES = 163840;
#define LDS_WAIT() asm volatile("s_waitcnt lgkmcnt(0)" ::: "memory")

#ifndef MIXWIN
#define MIXWIN 1
#endif
#ifndef MIX_X
#define MIX_X 0
#endif
#ifndef PRO_SKIP_L0
#define PRO_SKIP_L0 0
#endif
#ifndef PRO_NTST
#define PRO_NTST 1
#endif
#if PRO_NTST
#define PRO_STORE(p, v) __builtin_nontemporal_store(v, p)
#else
#define PRO_STORE(p, v) (*(p) = (v))
#endif
#ifndef PRO_NT
#define PRO_NT 1
#endif
#if PRO_NT
#define PRO_LOAD(p) __builtin_nontemporal_load(p)
#else
#define PRO_LOAD(p) (*(p))
#endif
struct Params { const float* in[22]; float* out; unsigned char* ws; };

typedef const __attribute__((address_space(4))) Params* KParamsPtr;
__device__ __forceinline__ Params kparams() {
    KParamsPtr p = (KParamsPtr)__builtin_amdgcn_kernarg_segment_ptr();
    asm volatile("" : "+s"(p));
    Params P;
#pragma unroll
    for (int i = 0; i < 22; ++i) P.in[i] = p->in[i];
    P.out = p->out; P.ws = p->ws;
    return P;
}
__device__ __forceinline__ unsigned pk2(float lo, float hi) { return (unsigned)f2bf(lo) | ((unsigned)f2bf(hi) << 16); }

struct TItem { const float* src; bf16_t* dst; int ldw, ldt; unsigned char* dst8; };
__device__ __forceinline__ TItem titem(const float* W, int ldw, bf16_t* WT, int ldt, int k0, int n0, int orow0) { TItem t; t.src = W + (size_t)k0 * ldw + n0; t.dst = WT + (size_t)orow0 * ldt + k0; t.ldw = ldw; t.ldt = ldt; t.dst8 = nullptr; return t; }
__device__ __forceinline__ TItem titem8(const float* W, int ldw, unsigned char* WT8, int ldt, int k0, int n0, int orow0) { TItem t; t.src = W + (size_t)k0 * ldw + n0; t.dst = nullptr; t.ldw = ldw; t.ldt = ldt; t.dst8 = WT8 + (size_t)orow0 * ldt + k0; return t; }
__device__ __forceinline__ void titem_load(const TItem& t, int lane, f32x4 (&wv)[8]) {
#pragma unroll
    for (int i = 0; i < 8; ++i) wv[i] = PRO_LOAD((const f32x4*)(t.src + (size_t)(8 * i + (lane >> 3)) * t.ldw + 4 * (lane & 7)));
}
__device__ __forceinline__ void titem_finish(const TItem& t, const f32x4 (&wv)[8], LAS float* scr, int lane) {
#pragma unroll
    for (int i = 0; i < 8; ++i) { LAS float* d = scr + (8 * i + (lane >> 3)) * 33 + 4 * (lane & 7); d[0] = wv[i][0]; d[1] = wv[i][1]; d[2] = wv[i][2]; d[3] = wv[i][3]; }
    LDS_WAIT(); asm volatile("" ::: "memory");
    const int c = lane & 7;
#pragma unroll
    for (int j = 0; j < 4; ++j) { const int n = (lane >> 3) + 8 * j; const LAS float* sp = scr + (8 * c) * 33 + n;
        if (t.dst8) { const float sc = (float)(1 << W8_SHIFT);
            v2u o; o.x = pk_fp8x4(sp[0 * 33] * sc, sp[1 * 33] * sc, sp[2 * 33] * sc, sp[3 * 33] * sc); o.y = pk_fp8x4(sp[4 * 33] * sc, sp[5 * 33] * sc, sp[6 * 33] * sc, sp[7 * 33] * sc);
            PRO_STORE((v2u*)(t.dst8 + (size_t)n * t.ldt + 8 * c), o); }
        else { v4u o; o.x = pk2(sp[0 * 33], sp[1 * 33]); o.y = pk2(sp[2 * 33], sp[3 * 33]); o.z = pk2(sp[4 * 33], sp[5 * 33]); o.w = pk2(sp[6 * 33], sp[7 * 33]);
            PRO_STORE((v4u*)(t.dst + (size_t)n * t.ldt + 8 * c), o); } }
    LDS_WAIT(); asm volatile("" ::: "memory");
}
__device__ __forceinline__ void transpose_item(const float* W, int ldw, bf16_t* WT, int ldt, int k0, int n0, int orow0, LAS float* scr, int lane) {
    const TItem t = titem(W, ldw, WT, ldt, k0, n0, orow0); f32x4 wv[8]; titem_load(t, lane, wv); titem_finish(t, wv, scr, lane);
}

constexpr int IT_WIN = (D / 64) * (2 * DR / 32);
constexpr int IT_WOUT = (DR / 64) * (D / 32);
constexpr int IT_WQKV = (D / 64) * (QKVD / 32);
constexpr int IT_WO = (D / 64) * (D / 32);
constexpr int IT_W1 = (D / 64) * (DE / 32);
constexpr int IT_W2 = (DE / 64) * (D / 32);
constexpr int IT_MOE_LAYER = NE * (2 * IT_W1 + IT_W2);
constexpr int IT_DENSE = IT_WIN + IT_WOUT + IT_WQKV + IT_WO;

__device__ __forceinline__ TItem dense_titem(const Params& P, int r) {
    unsigned char* ws = P.ws;
#if WIN_F8
    if (r < IT_WIN) { const int nb = 2 * DR / 32, kb = r / nb, n0 = (r % nb) * 32; return titem8(P.in[1], 2 * DR, ws + WS_WIN, D, kb * 64, n0, n0); } r -= IT_WIN;
#else
    if (r < IT_WIN) { const int nb = 2 * DR / 32, kb = r / nb, n0 = (r % nb) * 32; return titem(P.in[1], 2 * DR, (bf16_t*)(ws + WS_WIN), D, kb * 64, n0, n0); } r -= IT_WIN;
#endif
#if WOUT_F8
    if (r < IT_WOUT) { const int nb = D / 32, kb = r / nb, n0 = (r % nb) * 32; return titem8(P.in[9], D, ws + WS_WOUT, DR, kb * 64, n0, n0); } r -= IT_WOUT;
#else
    if (r < IT_WOUT) { const int nb = D / 32, kb = r / nb, n0 = (r % nb) * 32; return titem(P.in[9], D, (bf16_t*)(ws + WS_WOUT), DR, kb * 64, n0, n0); } r -= IT_WOUT;
#endif
#if ATT_F8
    if (r < IT_WQKV) { const int nb = QKVD / 32, kb = r / nb, n0 = (r % nb) * 32; return titem8(P.in[10], QKVD, ws + WS_WQKV, D, kb * 64, n0, n0); } r -= IT_WQKV;
    { const int nb = D / 32, kb = r / nb, n0 = (r % nb) * 32; return titem8(P.in[12], D, ws + WS_WO, D, kb * 64, n0, n0); }
#else
    if (r < IT_WQKV) { const int nb = QKVD / 32, kb = r / nb, n0 = (r % nb) * 32; return titem(P.in[10], QKVD, (bf16_t*)(ws + WS_WQKV), D, kb * 64, n0, n0); } r -= IT_WQKV;
    { const int nb = D / 32, kb = r / nb, n0 = (r % nb) * 32; return titem(P.in[12], D, (bf16_t*)(ws + WS_WO), D, kb * 64, n0, n0); }
#endif
}
__device__ __forceinline__ void cvt_dense_item(const Params& P, int r, LAS float* scr, int lane) {
    const TItem t = dense_titem(P, r); f32x4 wv[8]; titem_load(t, lane, wv); titem_finish(t, wv, scr, lane);
}
__device__ __forceinline__ TItem moe_titem(const Params& P, int layer, int r) {
    unsigned char* ws = P.ws;
    const int per_e = 2 * IT_W1 + IT_W2, e = r / per_e; int q = r % per_e;
#if UP_F8 || DOWN_F8
    if ((q < 2 * IT_W1) ? UP_F8 : DOWN_F8)
    { unsigned char* W13t8 = ws + WS_W13 + ((size_t)layer * NE + e) * (size_t)(D * D);
      unsigned char* W2t8 = ws + WS_W2 + ((size_t)layer * NE + e) * (size_t)(D * DE);
      const size_t eoff8 = ((size_t)layer * NE + e) * (size_t)(D * DE);
      if (q < 2 * IT_W1) { const int which = q / IT_W1; q %= IT_W1; const int nb = DE / 32, kb = 2 * (q / (2 * nb)) + (q & 1), n0 = ((q >> 1) % nb) * 32;
          const int orow0 = (n0 / 128) * 256 + which * 128 + (n0 % 128);
          return titem8((which ? P.in[18] : P.in[17]) + eoff8, DE, W13t8, D, kb * 64, n0, orow0); }
      q -= 2 * IT_W1;
      const int nb = D / 32, kb = 2 * (q / (2 * nb)) + (q & 1), n0 = ((q >> 1) % nb) * 32;
      return titem8(P.in[19] + eoff8, D, W2t8, DE, kb * 64, n0, n0); }
#endif
    bf16_t* W13t = (bf16_t*)(ws + WS_W13) + ((size_t)layer * NE + e) * (size_t)(D * D);
    bf16_t* W2t = (bf16_t*)(ws + WS_W2) + ((size_t)layer * NE + e) * (size_t)(D * DE);
    const size_t eoff13 = ((size_t)layer * NE + e) * (size_t)(D * DE);
    if (q < 2 * IT_W1) { const int which = q / IT_W1; q %= IT_W1; const int nb = DE / 32, kb = q / nb, n0 = (q % nb) * 32;
        const int orow0 = (n0 / 128) * 256 + which * 128 + (n0 % 128);
        return titem((which ? P.in[18] : P.in[17]) + eoff13, DE, W13t, D, kb * 64, n0, orow0); }
    q -= 2 * IT_W1;
    const int nb = D / 32, kb = q / nb, n0 = (q % nb) * 32;
    return titem(P.in[19] + eoff13, D, W2t, DE, kb * 64, n0, n0);
}
__device__ __forceinline__ void cvt_moe_item(const Params& P, int layer, int r, LAS float* scr, int lane) {
    unsigned char* ws = P.ws;
    const int per_e = 2 * IT_W1 + IT_W2, e = r / per_e; int q = r % per_e;
    bf16_t* W13t = (bf16_t*)(ws + WS_W13) + ((size_t)layer * NE + e) * (size_t)(D * D);
    bf16_t* W2t = (bf16_t*)(ws + WS_W2) + ((size_t)layer * NE + e) * (size_t)(D * DE);
    const size_t eoff13 = ((size_t)layer * NE + e) * (size_t)(D * DE);
    if (q < 2 * IT_W1) { const int which = q / IT_W1; q %= IT_W1; const int nb = DE / 32, kb = q / nb, n0 = (q % nb) * 32;
        const int orow0 = (n0 / 128) * 256 + which * 128 + (n0 % 128);
        transpose_item((which ? P.in[18] : P.in[17]) + eoff13, DE, W13t, D, kb * 64, n0, orow0, scr, lane); return; }
    q -= 2 * IT_W1;
    { const int nb = D / 32, kb = q / nb, n0 = (q % nb) * 32; transpose_item(P.in[19] + eoff13, D, W2t, DE, kb * 64, n0, n0, scr, lane); }
}

__device__ __forceinline__ void cvt_gate_frags(const Params& P, int gtid, int gthreads) {
    v2u* GF = (v2u*)(P.ws + WS_GF);
    for (int i = gtid; i < 2 * 16 * 25 * 64; i += gthreads) {
        const int l = i & 63, ks = (i >> 6) % 5, jt = (i / 320) % 5, n = (i / 1600) % 16, mat = i / 25600;
        const float* w = (mat ? P.in[6] : P.in[4]) + (size_t)n * BW * BW;
        const int j = 16 * jt + (l & 15), k = 16 * ks + 4 * (l >> 4);
        v2u o; o.x = pk2(w[(k + 0) * BW + j], w[(k + 1) * BW + j]); o.y = pk2(w[(k + 2) * BW + j], w[(k + 3) * BW + j]);
        GF[i] = o;
    }
}
__device__ __forceinline__ void cvt_router(const Params& P, int gw, int NGW, int lane) {
    const int fr = lane & 15, fq = lane >> 4;
    for (int it = gw; it < 2 * 96 + 2 * 36; it += NGW) {
        if (it < 192) {
            const int layer = it / 96, s = (it % 96) / 3, ct = it % 3;
            const float* lg = P.in[20] + (size_t)(layer * 2) * D;
            const float* we = P.in[15] + (size_t)layer * D * 32; const float* wg = P.in[13] + (size_t)layer * D * 4;
            unsigned h[8], l[8];
#pragma unroll
            for (int j = 0; j < 8; ++j) { const int k = 32 * s + 8 * fq + j; const float v = lg[k] * ((ct < 2) ? we[(size_t)k * 32 + 16 * ct + fr] : wg[(size_t)k * 4 + (fr & 3)]);
                const bf16_t hh = f2bf(v); h[j] = hh; l[j] = f2bf(v - bf2f(hh)); }
            const v4u H = {h[0] | (h[1] << 16), h[2] | (h[3] << 16), h[4] | (h[5] << 16), h[6] | (h[7] << 16)}, L = {l[0] | (l[1] << 16), l[2] | (l[3] << 16), l[4] | (l[5] << 16), l[6] | (l[7] << 16)};
            unsigned char* rf = P.ws + WS_RF + (size_t)layer * RF_BYTES;
            if (ct < 2) { *(v4u*)(rf + ((s * 2 + ct) * 2 + 0) * 1024 + lane * 16) = H; *(v4u*)(rf + ((s * 2 + ct) * 2 + 1) * 1024 + lane * 16) = L; }
            else if (fr < 4) { *(v4u*)(rf + 131072 + (s * 2 + 0) * 256 + (fr + 4 * fq) * 16) = H; *(v4u*)(rf + 131072 + (s * 2 + 1) * 256 + (fr + 4 * fq) * 16) = L; }
        } else {
            const int q = it - 192, layer = q / 36, n = q % 36;
            const float* lg = P.in[20] + (size_t)(layer * 2) * D; const float* lb = P.in[21] + (size_t)(layer * 2) * D;
            const float* we = P.in[15] + (size_t)layer * D * 32; const float* wg = P.in[13] + (size_t)layer * D * 4;
            float a2 = 0.f, a3 = 0.f;
#pragma unroll
            for (int i = 0; i < 16; ++i) { const int k = lane + 64 * i; const float wv = (n < 32) ? we[(size_t)k * 32 + n] : wg[(size_t)k * 4 + (n - 32)]; const float v = lg[k] * wv;
                const bf16_t hh = f2bf(v); a2 += bf2f(hh) + bf2f(f2bf(v - bf2f(hh))); a3 += lb[k] * wv; }
#pragma unroll
            for (int o = 1; o < 64; o <<= 1) { a2 += __shfl_xor(a2, o); a3 += __shfl_xor(a3, o); }
            float* rc = (float*)(P.ws + WS_RC) + layer * 96;
            if (lane == 0) { rc[n] = a2; rc[48 + n] = a3 + ((n < 32) ? P.in[16][layer * 32 + n] : P.in[14][layer * 4 + (n - 32)]); }
        }
    }
}
__device__ __forceinline__ void router_load(const Params& P, int it, int lane, float (&ra)[16], float (&rb)[16], float (&rc)[16]) {
    const int fr = lane & 15, fq = lane >> 4;
    if (it < 192) {
        const int layer = it / 96, s = (it % 96) / 3, ct = it % 3;
        const float* lg = P.in[20] + (size_t)(layer * 2) * D;
        const float* we = P.in[15] + (size_t)layer * D * 32; const float* wg = P.in[13] + (size_t)layer * D * 4;
#pragma unroll
        for (int j = 0; j < 8; ++j) { const int k = 32 * s + 8 * fq + j; ra[j] = lg[k]; rb[j] = (ct < 2) ? we[(size_t)k * 32 + 16 * ct + fr] : wg[(size_t)k * 4 + (fr & 3)]; }
    } else {
        const int q = it - 192, layer = q / 36, n = q % 36;
        const float* lg = P.in[20] + (size_t)(layer * 2) * D; const float* lb = P.in[21] + (size_t)(layer * 2) * D;
        const float* we = P.in[15] + (size_t)layer * D * 32; const float* wg = P.in[13] + (size_t)layer * D * 4;
#pragma unroll
        for (int i = 0; i < 16; ++i) { const int k = lane + 64 * i; ra[i] = lg[k]; rb[i] = (n < 32) ? we[(size_t)k * 32 + n] : wg[(size_t)k * 4 + (n - 32)]; rc[i] = lb[k]; }
    }
}
__device__ __forceinline__ void router_finish(const Params& P, int it, int lane, const float (&ra)[16], const float (&rb)[16], const float (&rc)[16]) {
    const int fr = lane & 15, fq = lane >> 4;
    if (it < 192) {
        const int layer = it / 96, s = (it % 96) / 3, ct = it % 3;
        unsigned h[8], l[8];
#pragma unroll
        for (int j = 0; j < 8; ++j) { const float v = ra[j] * rb[j]; const bf16_t hh = f2bf(v); h[j] = hh; l[j] = f2bf(v - bf2f(hh)); }
        const v4u H = {h[0] | (h[1] << 16), h[2] | (h[3] << 16), h[4] | (h[5] << 16), h[6] | (h[7] << 16)}, L = {l[0] | (l[1] << 16), l[2] | (l[3] << 16), l[4] | (l[5] << 16), l[6] | (l[7] << 16)};
        unsigned char* rf = P.ws + WS_RF + (size_t)layer * RF_BYTES;
        if (ct < 2) { *(v4u*)(rf + ((s * 2 + ct) * 2 + 0) * 1024 + lane * 16) = H; *(v4u*)(rf + ((s * 2 + ct) * 2 + 1) * 1024 + lane * 16) = L; }
        else if (fr < 4) { *(v4u*)(rf + 131072 + (s * 2 + 0) * 256 + (fr + 4 * fq) * 16) = H; *(v4u*)(rf + 131072 + (s * 2 + 1) * 256 + (fr + 4 * fq) * 16) = L; }
    } else {
        const int q = it - 192, layer = q / 36, n = q % 36;
        float a2 = 0.f, a3 = 0.f;
#pragma unroll
        for (int i = 0; i < 16; ++i) { const float v = ra[i] * rb[i]; const bf16_t hh = f2bf(v); a2 += bf2f(hh) + bf2f(f2bf(v - bf2f(hh))); a3 += rc[i] * rb[i]; }
#pragma unroll
        for (int o = 1; o < 64; o <<= 1) { a2 += __shfl_xor(a2, o); a3 += __shfl_xor(a3, o); }
        float* rcp_ = (float*)(P.ws + WS_RC) + layer * 96;
        if (lane == 0) { rcp_[n] = a2; rcp_[48 + n] = a3 + ((n < 32) ? P.in[16][layer * 32 + n] : P.in[14][layer * 4 + (n - 32)]); }
    }
}
__device__ __forceinline__ void gate_frag_load(const Params& P, int i, float (&w4)[4]) {
    const int l = i & 63, ks = (i >> 6) % 5, jt = (i / 320) % 5, n = (i / 1600) % 16, mat = i / 25600;
    const float* w = (mat ? P.in[6] : P.in[4]) + (size_t)n * BW * BW;
    const int j = 16 * jt + (l & 15), k = 16 * ks + 4 * (l >> 4);
#pragma unroll
    for (int e = 0; e < 4; ++e) w4[e] = w[(k + e) * BW + j];
}
__device__ __forceinline__ void cvt_x(const Params& P, int gtid, int gthreads) {
    const f32x4* x = (const f32x4*)P.in[0]; v4u* xb = (v4u*)(P.ws + WS_XB); v2u* x8 = (v2u*)(P.ws + WS_XB8);
    const size_t n = (size_t)T * D / 8;
    size_t i = gtid;
    for (; i + 3 * (size_t)gthreads < n; i += 4 * (size_t)gthreads) {
        f32x4 a[4], b[4];
#pragma unroll
        for (int k = 0; k < 4; ++k) { a[k] = PRO_LOAD(x + 2 * (i + k * (size_t)gthreads)); b[k] = PRO_LOAD(x + 2 * (i + k * (size_t)gthreads) + 1); }
#pragma unroll
        for (int k = 0; k < 4; ++k) { v4u o; o.x = pk2(a[k][0], a[k][1]); o.y = pk2(a[k][2], a[k][3]); o.z = pk2(b[k][0], b[k][1]); o.w = pk2(b[k][2], b[k][3]); st16_wt(xb + i + k * (size_t)gthreads, o);
            if (WIN_F8) x8[i + k * (size_t)gthreads] = (v2u){pk_fp8x4(a[k][0], a[k][1], a[k][2], a[k][3]), pk_fp8x4(b[k][0], b[k][1], b[k][2], b[k][3])}; }
    }
    for (; i < n; i += gthreads) { const f32x4 a = PRO_LOAD(x + 2 * i), b = PRO_LOAD(x + 2 * i + 1);
        v4u o; o.x = pk2(a[0], a[1]); o.y = pk2(a[2], a[3]); o.z = pk2(b[0], b[1]); o.w = pk2(b[2], b[3]); st16_wt(xb + i, o);
        if (WIN_F8) x8[i] = (v2u){pk_fp8x4(a[0], a[1], a[2], a[3]), pk_fp8x4(b[0], b[1], b[2], b[3])}; }
}
constexpr int XQ_PARTS = 64;
constexpr unsigned XQ_NEED = 64u * XQ_PARTS;
__device__ __forceinline__ void convert_x_queue(const Params& P, int tid) {
    const int lane = tid & 63;
    unsigned* q = (unsigned*)(P.ws + WS_Q) + 8;
    unsigned* rdy = (unsigned*)(P.ws + WS_XRDY);
    const int total = (T / 256) * XQ_PARTS;
    for (int guard = 0; guard <= total; ++guard) {
        const unsigned b0 = __hip_atomic_fetch_add(q, 1u, __ATOMIC_RELAXED, __HIP_MEMORY_SCOPE_AGENT);
        const int tk = __builtin_amdgcn_readfirstlane((int)(b0 >> 6));
        if (tk >= total) break;
        const int o = tk / XQ_PARTS, part = tk % XQ_PARTS, pm = 16 * (o & 7) + (o >> 3);
        const size_t e0 = ((size_t)pm * 256 + part * 4) * D;
        const f32x4* x = (const f32x4*)(P.in[0] + e0); bf16_t* xb = (bf16_t*)(P.ws + WS_XB) + e0;
        f32x4 a[8], b[8];
#pragma unroll
        for (int k = 0; k < 8; ++k) { a[k] = PRO_LOAD(x + 2 * (lane + 64 * k)); b[k] = PRO_LOAD(x + 2 * (lane + 64 * k) + 1); }
#pragma unroll
        for (int k = 0; k < 8; ++k) { v4u o4; o4.x = pk2(a[k][0], a[k][1]); o4.y = pk2(a[k][2], a[k][3]); o4.z = pk2(b[k][0], b[k][1]); o4.w = pk2(b[k][2], b[k][3]);
            asm volatile("global_store_dwordx4 %0, %1, off sc1\n\ts_nop 1" :: "v"(xb + 8 * (lane + 64 * k)), "v"(o4) : "memory"); }
        asm volatile("s_waitcnt vmcnt(0)" ::: "memory");
        (void)__hip_atomic_fetch_add(rdy + 64 * pm, 1u, __ATOMIC_RELAXED, __HIP_MEMORY_SCOPE_AGENT);
    }
}
constexpr int CQ_BATCH = 8;
__device__ __forceinline__ void convert_queue(const Params& P, LAS unsigned char* lds, int tid, int limit = 2 * IT_MOE_LAYER) {
    const int lane = tid & 63, wave = __builtin_amdgcn_readfirstlane(tid >> 6);
    LAS float* scr = (LAS float*)(lds + wave * 16384);
    unsigned* q = (unsigned*)(P.ws + WS_Q);
    const int total = 2 * IT_MOE_LAYER;
    for (;;) {
        unsigned b0 = 0u; if (lane == 0) b0 = __hip_atomic_fetch_add(q, (unsigned)CQ_BATCH, __ATOMIC_RELAXED, __HIP_MEMORY_SCOPE_AGENT);
        int it = __builtin_amdgcn_readfirstlane((int)b0);
        if (it >= total) break;
        const int end = (it + CQ_BATCH < total) ? it + CQ_BATCH : total;
        f32x4 wa[8], wb[8]; TItem ia = moe_titem(P, it / IT_MOE_LAYER, it % IT_MOE_LAYER), ib = ia;
        titem_load(ia, lane, wa);
        while (it < end) {
            const int nx = it + 1;
            if (nx < end) { ib = moe_titem(P, nx / IT_MOE_LAYER, nx % IT_MOE_LAYER); titem_load(ib, lane, wb); }
            titem_finish(ia, wa, scr, lane);
            ia = ib;
#pragma unroll
            for (int i = 0; i < 8; ++i) wa[i] = wb[i];
            it = nx;
        }
        if (end > limit) break;
    }
}
__device__ __forceinline__ void phase_prologue(LAS unsigned char* lds, const int tid_in, int vcu, int G) {
    const Params P = kparams();
    int tid = tid_in; asm volatile("" : "+v"(tid));
    const int lane = tid & 63, wave = __builtin_amdgcn_readfirstlane(tid >> 6);
    LAS float* scr = (LAS float*)(lds + wave * 16384);
    const int gw = vcu * NWAVES + wave, NGW = G * NWAVES;
    if (!(MIXWIN && G % 8 == 0)) { int it = gw + (PRO_SKIP_L0 ? IT_MOE_LAYER : 0); const int end = 2 * IT_MOE_LAYER;
      f32x4 wa[8], wb[8]; TItem ia = moe_titem(P, 0, 0), ib = ia;
      if (it < end) { ia = moe_titem(P, it / IT_MOE_LAYER, it % IT_MOE_LAYER); titem_load(ia, lane, wa); }
      while (it < end) {
          const int nx = it + NGW;
          if (nx < end) { ib = moe_titem(P, nx / IT_MOE_LAYER, nx % IT_MOE_LAYER); titem_load(ib, lane, wb); }
          titem_finish(ia, wa, scr, lane);
          ia = ib;
#pragma unroll
          for (int i = 0; i < 8; ++i) wa[i] = wb[i];
          it = nx;
      } }
    { const bool h0 = gw < IT_DENSE, h1 = gw + NGW < IT_DENSE;
      TItem d0 = dense_titem(P, 0), d1 = d0; f32x4 wa[8], wb[8];
      if (h0) { d0 = dense_titem(P, gw); titem_load(d0, lane, wa); }
      if (h1) { d1 = dense_titem(P, gw + NGW); titem_load(d1, lane, wb); }
      const int rit = NGW - 1 - gw; const bool hr = rit < 2 * 96 + 2 * 36;
      float ra[16], rb[16], rc[16];
#pragma unroll
      for (int i = 0; i < 16; ++i) { ra[i] = 0.f; rb[i] = 0.f; rc[i] = 0.f; }
      if (hr) router_load(P, rit, lane, ra, rb, rc);
      const int gi = vcu * NTHREADS + tid; const bool hg = gi < 2 * 16 * 25 * 64;
      float w4[4] = {0.f, 0.f, 0.f, 0.f};
      if (hg) gate_frag_load(P, gi, w4);
      if (!(MIXWIN && MIX_X && G % 8 == 0)) cvt_x(P, vcu * NTHREADS + tid, G * NTHREADS);
      if (h0) titem_finish(d0, wa, scr, lane);
      if (h1) titem_finish(d1, wb, scr, lane);
      if (hr) router_finish(P, rit, lane, ra, rb, rc);
      if (hg) { v2u o; o.x = pk2(w4[0], w4[1]); o.y = pk2(w4[2], w4[3]); ((v2u*)(P.ws + WS_GF))[gi] = o; }
      for (int it = gw + 2 * NGW; it < IT_DENSE; it += NGW) cvt_dense_item(P, it, scr, lane);
      cvt_router(P, rit + NGW, NGW, lane);
      cvt_gate_frags(P, gi + G * NTHREADS, G * NTHREADS); }
}

__device__ __forceinline__ void phase_cvt_moe(int layer, LAS unsigned char* lds, const int tid_in, int vcu, int G) {
    const Params P = kparams();
    int tid = tid_in; asm volatile("" : "+v"(tid));
    const int lane = tid & 63, wave = __builtin_amdgcn_readfirstlane(tid >> 6);
    LAS float* scr = (LAS float*)(lds + wave * 16384);
    const int gw = vcu * NWAVES + wave, NGW = G * NWAVES;
    for (int it = gw; it < IT_MOE_LAYER; it += NGW) cvt_moe_item(P, layer, it, scr, lane);
}
#define XB_TMO      128
#define XB_XCNT(j)  (256  + 64 * (j))
#define XB_XSUB(j)  (1280 + 64 * (j))
#define XB_XGEN(j)  (2304 + 64 * (j))
#define XB_TOP      3328
#define XB_TOPGEN   3392
#define XCD_BAR_WORDS 3456
#ifndef XB_DIRECT_RELEASE
#define XB_DIRECT_RELEASE 0
#endif
#define XB_SPIN_CAP (1u << 18)

__device__ __forceinline__ unsigned xb_ld(unsigned* p)              { return __hip_atomic_load(p, __ATOMIC_RELAXED, __HIP_MEMORY_SCOPE_AGENT); }
__device__ __forceinline__ unsigned xb_add(unsigned* p, unsigned v) { return __hip_atomic_fetch_add(p, v, __ATOMIC_RELAXED, __HIP_MEMORY_SCOPE_AGENT); }
__device__ __forceinline__ unsigned xb_xcc_id() { return (unsigned)__builtin_amdgcn_s_getreg((3 << 11) | 20) & 0xFu; }
#define XB_SPIN(cond, bar) do { unsigned _sp = 0; while (cond) { __builtin_amdgcn_s_sleep(1); \
    if ((++_sp & 255u) == 0u) { if (xb_ld(&(bar)[XB_TMO])) break; if (_sp > XB_SPIN_CAP) { atomicAdd(&(bar)[XB_TMO], 1u); break; } } } } while (0)

struct XcdBarrier {
    unsigned* bar; unsigned x;
    volatile LAS unsigned* st;
};

__device__ __forceinline__ XcdBarrier xcd_barrier_post(unsigned* bar, volatile LAS unsigned* st, const int xb_tid) {
    XcdBarrier b; b.bar = bar; b.x = xb_xcc_id(); b.st = st;
    if (xb_tid == 0) (void)xb_add(&bar[XB_XCNT(b.x)], 1u);
    return b;
}
__device__ __forceinline__ void xcd_barrier_complete(unsigned* bar, unsigned x, unsigned& nloc, unsigned& nx) {
    const unsigned G = gridDim.x * gridDim.y * gridDim.z;
    unsigned sum, cnt, mine, sp = 0u;
    for (;;) {
        sum = 0u; cnt = 0u; mine = 0u;
#pragma unroll
        for (unsigned j = 0; j < 16; ++j) { const unsigned c = xb_ld(&bar[XB_XCNT(j)]); sum += c; cnt += (c > 0u) ? 1u : 0u; mine = (j == x) ? c : mine; }
        if (sum == G) break;
        __builtin_amdgcn_s_sleep(1);
        if ((++sp & 255u) == 0u) { if (xb_ld(&bar[XB_TMO])) break; if (sp > XB_SPIN_CAP) { atomicAdd(&bar[XB_TMO], 1u); break; } }
    }
    nloc = mine > 0u ? mine : 1u; nx = cnt > 0u ? cnt : 1u;
}

__device__ __forceinline__ void xcd_barrier(const XcdBarrier& b, const int xb_tid) {
    asm volatile("s_waitcnt vmcnt(0)" ::: "memory");
    __syncthreads();
    if (xb_tid == 0) {
        unsigned* bar = b.bar;
        __builtin_amdgcn_s_waitcnt(0);
        unsigned nloc = b.st[0], nx = b.st[1];
        if (nloc == 0u) { xcd_barrier_complete(bar, b.x, nloc, nx); b.st[0] = nloc; b.st[1] = nx; }
        const unsigned old = xb_add(&bar[XB_XSUB(b.x)], 1u);
        const unsigned gen = old / nloc;
        if (old + 1u == (gen + 1u) * nloc) {
            __builtin_amdgcn_fence(__ATOMIC_RELEASE, "agent");
            asm volatile("s_waitcnt vmcnt(0)" ::: "memory");
#if XB_DIRECT_RELEASE
            const unsigned og = xb_add(&bar[XB_TOP], 1u);
            const unsigned tg = og / nx;
            if (og + 1u == (tg + 1u) * nx) {
#pragma unroll
                for (unsigned j = 0; j < 16; ++j) xb_add(&bar[XB_XGEN(j)], 1u);
            }
            XB_SPIN(xb_ld(&bar[XB_XGEN(b.x)]) == gen, bar);
            __builtin_amdgcn_fence(__ATOMIC_ACQUIRE, "agent");
            asm volatile("s_waitcnt vmcnt(0)" ::: "memory");
#else
            const unsigned og = xb_add(&bar[XB_TOP], 1u);
            const unsigned tg = og / nx;
            if (og + 1u == (tg + 1u) * nx) xb_add(&bar[XB_TOPGEN], 1u);
            else XB_SPIN(xb_ld(&bar[XB_TOPGEN]) == tg, bar);
            __builtin_amdgcn_fence(__ATOMIC_ACQUIRE, "agent");
            xb_add(&bar[XB_XGEN(b.x)], 1u);
            asm volatile("s_waitcnt vmcnt(0)" ::: "memory");
#endif
        } else {
            XB_SPIN(xb_ld(&bar[XB_XGEN(b.x)]) == gen, bar);
            __builtin_amdgcn_fence(__ATOMIC_ACQUIRE, "agent");
            asm volatile("s_waitcnt vmcnt(0)" ::: "memory");
        }
    }
    __syncthreads();
}
#ifndef WGM_WIN
#define WGM_WIN PG8_WGM
#endif
#ifndef WGM_QKV
#define WGM_QKV PG8_WGM
#endif
#ifndef WGM_WOUT
#define WGM_WOUT PG8_WGM
#endif
#ifndef WGM_WO
#define WGM_WO PG8_WGM
#endif
#ifndef WGM_UP
#define WGM_UP PG8_WGM
#endif
#ifndef WGM_DOWN
#define WGM_DOWN PG8_WGM
#endif
#ifndef DOWN_DEP
#define DOWN_DEP 3
#endif
#ifndef DOWN_DYN
#define DOWN_DYN 1
#endif
#ifndef MIX_FIRST_LIMIT
#define MIX_FIRST_LIMIT (2 * IT_MOE_LAYER)
#endif
#ifndef MIX_SEL
#define MIX_SEL(g_) (((g_) & 7) >= 5)
#endif
#ifndef WOUT_RES_BF16
#define WOUT_RES_BF16 1
#endif
#ifndef PG8_ALIGN
#define PG8_ALIGN true
#endif
enum Phase { PH_PROLOGUE = 0, PH_WIN, PH_RGLRU, PH_WOUT, PH_LN0, PH_ROUTE0, PH_UP0, PH_DOWN0, PH_COMB0, PH_QKV, PH_ATTN, PH_WO, PH_LN1, PH_ROUTE1, PH_UP1, PH_DOWN1, PH_COMB1, PH_COUNT };
__device__ __forceinline__ void phase_gemm_win(LAS unsigned char* lds, const int tid_in, int bid, int G) {
    const Params P = kparams(); unsigned char* ws = P.ws;
#if WIN_F8
    typedef pg8::Order<D / 2, 2 * DR / 256, false, false, 0, WGM_WIN, false, true> O;
    const O S{T / 256, G, bid, (const char*)(ws + WS_XB8), (const char*)(ws + WS_WIN), nullptr, nullptr, nullptr, 0u, nullptr};
#else
    typedef pg8::Order<D, 2 * DR / 256, false, false, 0, WGM_WIN> O;
    const O S{T / 256, G, bid, (const char*)(ws + WS_XB), (const char*)(ws + WS_WIN), nullptr, nullptr, nullptr, 0u, nullptr};
#endif
    const pg8::EpiBf16 E{(bf16_t*)(ws + WS_M + M_G), DR, DR, (size_t)(M_XR - M_G) / 2, 1.f};
    pg8::gemm_phase<pg8::EpiBf16, O, PG8_ALIGN>(lds, tid_in, S, E);
}
__device__ __forceinline__ void phase_win_mixed(LAS unsigned char* lds, const int tid_in, int bid, int G) {
    const Params P = kparams(); unsigned char* ws = P.ws;
    if (G % 8 != 0) { phase_gemm_win(lds, tid_in, bid, G); return; }
    int tid = tid_in; asm volatile("" : "+v"(tid));
    if (MIX_SEL(bid >> 3)) { if (MIX_X) convert_x_queue(P, tid); convert_queue(P, lds, tid, MIX_FIRST_LIMIT); __syncthreads(); }
    { typedef pg8::Order<WIN_F8 ? D / 2 : D, 2 * DR / 256, false, false, MIX_X ? 3 : 0, WGM_WIN, true, (WIN_F8 != 0)> O;
      O S{T / 256, G, bid, (const char*)(ws + (WIN_F8 ? WS_XB8 : WS_XB)), (const char*)(ws + WS_WIN), nullptr, nullptr, (unsigned*)(ws + WS_XRDY), XQ_NEED, nullptr};
      S.qctr = (unsigned*)(ws + WS_Q) + 16 * (1 + (bid & 7));
      const pg8::EpiBf16 E{(bf16_t*)(ws + WS_M + M_G), DR, DR, (size_t)(M_XR - M_G) / 2, 1.f};
      pg8::gemm_phase<pg8::EpiBf16, O, PG8_ALIGN>(lds, tid_in, S, E); }
    __syncthreads();
    { int t2 = tid_in; asm volatile("" : "+v"(t2)); if (MIX_X) convert_x_queue(P, t2); convert_queue(P, lds, t2); }
}
constexpr unsigned CQK_NEED_ = 64u * (256 / 16);
#ifndef MIXQ
#define MIXQ 0
#endif
#ifndef MIXQ_SEL
#define MIXQ_SEL(g_) (((g_) & 3) == 3)
#endif
__device__ __forceinline__ void comb_queue(const Params& P, LAS unsigned char* lds, int tid);
__device__ __forceinline__ void phase_qkv_mixed(LAS unsigned char* lds, const int tid_in, int bid, int G) {
    const Params P = kparams(); unsigned char* ws = P.ws;
    int tid = tid_in; asm volatile("" : "+v"(tid));
    if (MIXQ_SEL(bid >> 3)) { comb_queue(P, lds, tid); __builtin_amdgcn_fence(__ATOMIC_ACQUIRE, "agent"); __syncthreads(); }
    { typedef pg8::Order<D, QKVD / 256, false, false, 3, WGM_QKV, true> O;
      O S{T / 256, G, bid, (const char*)(ws + WS_XB2), (const char*)(ws + WS_WQKV), nullptr, nullptr, (unsigned*)(ws + WS_XRDY), CQK_NEED_, nullptr};
      S.qctr = (unsigned*)(ws + WS_Q) + 16 * (40 + (bid & 7));
      const pg8::EpiBf16 E{(bf16_t*)(ws + WS_M + M_QKV), QKVD, 1024, 1024, QSCALE};
      pg8::gemm_phase<pg8::EpiBf16, O, PG8_ALIGN>(lds, tid_in, S, E); }
    __syncthreads();
    { int t2 = tid_in; asm volatile("" : "+v"(t2)); comb_queue(P, lds, t2); }
}
__device__ __forceinline__ void phase_gemm_qkv(LAS unsigned char* lds, const int tid_in, int bid, int G) {
    const Params P = kparams(); unsigned char* ws = P.ws;
#if ATT_F8
    typedef pg8::Order<D / 2, QKVD / 256, false, false, 0, WGM_QKV, false, true> O;
    const O S{T / 256, G, bid, (const char*)(ws + WS_XB8), (const char*)(ws + WS_WQKV), nullptr, nullptr, nullptr, 0u, nullptr};
#else
    typedef pg8::Order<D, QKVD / 256, false, false, 0, WGM_QKV> O;
    const O S{T / 256, G, bid, (const char*)(ws + WS_XB), (const char*)(ws + WS_WQKV), nullptr, nullptr, nullptr, 0u, nullptr};
#endif
    const pg8::EpiBf16 E{(bf16_t*)(ws + WS_M + M_QKV), QKVD, 1024, 1024, QSCALE};
    pg8::gemm_phase<pg8::EpiBf16, O, PG8_ALIGN>(lds, tid_in, S, E);
}
__device__ __forceinline__ void phase_gemm_wout(LAS unsigned char* lds, const int tid_in, int bid, int G) {
    const Params P = kparams(); unsigned char* ws = P.ws;
#if WOUT_F8
    typedef pg8::Order<DR / 2, D / 256, false, false, 0, WGM_WOUT, false, true, Y8_SHIFT> O;
    const O S{T / 256, G, bid, (const char*)(ws + WS_M + M_Y8), (const char*)(ws + WS_WOUT), nullptr, nullptr, nullptr, 0u, nullptr};
#else
    typedef pg8::Order<DR, D / 256, false, false, 0, WGM_WOUT> O;
    const O S{T / 256, G, bid, (const char*)(ws + WS_M + M_G), (const char*)(ws + WS_WOUT), nullptr, nullptr, nullptr, 0u, nullptr};
#endif
#if WOUT_RES_BF16
    const pg8::EpiResidZ<true> E{ws + WS_XB, LNSTAT ? (bf16_t*)(ws + WS_XB) : (bf16_t*)P.out, ALPHA};
    pg8::gemm_phase<pg8::EpiResidZ<true>, O, PG8_ALIGN>(lds, tid_in, S, E);
#else
    const pg8::EpiResidZ<false> E{P.in[0], (bf16_t*)P.out, ALPHA};
    pg8::gemm_phase<pg8::EpiResidZ<false>, O, PG8_ALIGN>(lds, tid_in, S, E);
#endif
}
__device__ __forceinline__ void phase_gemm_wo(LAS unsigned char* lds, const int tid_in, int bid, int G) {
    const Params P = kparams(); unsigned char* ws = P.ws;
#if ATT_F8
    typedef pg8::Order<D / 2, D / 256, false, false, 0, WGM_WO, false, true, O8_SHIFT> O;
#else
    typedef pg8::Order<D, D / 256, false, false, 0, WGM_WO> O;
#endif
    const O S{T / 256, G, bid, (const char*)(ws + WS_M + M_O), (const char*)(ws + WS_WO), nullptr, nullptr, nullptr, 0u, nullptr};
    const pg8::EpiResidZ<true> E{ws + ((MIXQ && G % 8 == 0) ? WS_XB2 : WS_XB), LNSTAT ? (bf16_t*)(ws + WS_XB) : (bf16_t*)P.out, ALPHA};
    pg8::gemm_phase<pg8::EpiResidZ<true>, O, PG8_ALIGN>(lds, tid_in, S, E);
}
__device__ __forceinline__ void phase_moe_up(int layer, LAS unsigned char* lds, const int tid_in, int bid, int G) {
    const Params P = kparams(); unsigned char* ws = P.ws; const int* ctl = (const int*)(ws + WS_CTL);
#if UP_F8
    typedef pg8::Order<D / 2, 4, true, true, 1, WGM_UP, false, true> O;
    const O S{ctl[97], G, bid, (const char*)(ws + WS_XB8), (const char*)(ws + WS_W13) + (size_t)layer * NE * (size_t)(D * D), ctl + 128, (const int*)(ws + WS_ROUTE + 512 * 1024), (unsigned*)(ws + WS_READY + (size_t)layer * READY_BANK), 0u, (const LAS int*)(lds + 131072 + 4096)};
#else
    typedef pg8::Order<D, 4, true, true, 1, WGM_UP> O;
    const O S{ctl[97], G, bid, (const char*)(ws + WS_XB), (const char*)(ws + WS_W13) + (size_t)layer * NE * (size_t)(D * D * 2), ctl + 128, (const int*)(ws + WS_ROUTE + 512 * 1024), (unsigned*)(ws + WS_READY + (size_t)layer * READY_BANK), 0u, (const LAS int*)(lds + 131072 + 4096)};
#endif
    { int t_ = tid_in; asm volatile("" : "+v"(t_)); S.fill_tokl((LAS int*)(lds + 131072 + 4096), t_); __syncthreads(); }
#if DOWN_F8
    const pg8::EpiSwiglu8 E{ws + WS_M + M_HDN};
    pg8::gemm_phase<pg8::EpiSwiglu8, O, PG8_ALIGN>(lds, tid_in, S, E);
#else
    const pg8::EpiSwiglu E{(bf16_t*)(ws + WS_M + M_HDN)};
    pg8::gemm_phase<pg8::EpiSwiglu, O, PG8_ALIGN>(lds, tid_in, S, E);
#endif
}
__device__ __forceinline__ void phase_moe_down(int layer, LAS unsigned char* lds, const int tid_in, int bid, int G) {
    const Params P = kparams(); unsigned char* ws = P.ws; const int* ctl = (const int*)(ws + WS_CTL);
#if DOWN_F8
    if (DOWN_DYN && G % 8 == 0) {
      typedef pg8::Order<DE / 2, 4, false, true, DOWN_DEP, WGM_DOWN, true, true> O;
      O S{ctl[97], G, bid, (const char*)(ws + WS_M + M_HDN), (const char*)(ws + WS_W2) + (size_t)layer * NE * (size_t)(D * DE), ctl + 128, nullptr, (unsigned*)(ws + WS_READY + (size_t)layer * READY_BANK), 32u, nullptr};
      S.qctr = (unsigned*)(ws + WS_Q) + 16 * (17 + 8 * layer + (bid & 7));
#if YS_F8
      const pg8::EpiFp8 E{ws + WS_M + M_YS, D};
      pg8::gemm_phase<pg8::EpiFp8, O, PG8_ALIGN>(lds, tid_in, S, E);
#else
      const pg8::EpiBf16 E{(bf16_t*)(ws + WS_M + M_YS), D, 0, 0, 1.f};
      pg8::gemm_phase<pg8::EpiBf16, O, PG8_ALIGN>(lds, tid_in, S, E);
#endif
      return; }
    { typedef pg8::Order<DE / 2, 4, false, true, DOWN_DEP, WGM_DOWN, false, true> O;
      const O S{ctl[97], G, G - 1 - bid, (const char*)(ws + WS_M + M_HDN), (const char*)(ws + WS_W2) + (size_t)layer * NE * (size_t)(D * DE), ctl + 128, nullptr, (unsigned*)(ws + WS_READY + (size_t)layer * READY_BANK), 32u, nullptr};
#if YS_F8
      const pg8::EpiFp8 E{ws + WS_M + M_YS, D};
      pg8::gemm_phase<pg8::EpiFp8, O, PG8_ALIGN>(lds, tid_in, S, E);
#else
      const pg8::EpiBf16 E{(bf16_t*)(ws + WS_M + M_YS), D, 0, 0, 1.f};
      pg8::gemm_phase<pg8::EpiBf16, O, PG8_ALIGN>(lds, tid_in, S, E);
#endif
      return; }
#endif
#if DOWN_DYN
    if (G % 8 == 0) {
        typedef pg8::Order<DE, 4, false, true, DOWN_DEP, WGM_DOWN, true> O;
        O S{ctl[97], G, bid, (const char*)(ws + WS_M + M_HDN), (const char*)(ws + WS_W2) + (size_t)layer * NE * (size_t)(D * DE * 2), ctl + 128, nullptr, (unsigned*)(ws + WS_READY + (size_t)layer * READY_BANK), 32u, nullptr};
        S.qctr = (unsigned*)(ws + WS_Q) + 16 * (17 + 8 * layer + (bid & 7));
#if YS_F8
        const pg8::EpiFp8 E{ws + WS_M + M_YS, D};
        pg8::gemm_phase<pg8::EpiFp8, O, PG8_ALIGN>(lds, tid_in, S, E);
#else
        const pg8::EpiBf16 E{(bf16_t*)(ws + WS_M + M_YS), D, 0, 0, 1.f};
        pg8::gemm_phase<pg8::EpiBf16, O, PG8_ALIGN>(lds, tid_in, S, E);
#endif
        return;
    }
#endif
    typedef pg8::Order<DE, 4, false, true, DOWN_DEP, WGM_DOWN> O;
    const O S{ctl[97], G, G - 1 - bid, (const char*)(ws + WS_M + M_HDN), (const char*)(ws + WS_W2) + (size_t)layer * NE * (size_t)(D * DE * 2), ctl + 128, nullptr, (unsigned*)(ws + WS_READY + (size_t)layer * READY_BANK), 32u, nullptr};
#if YS_F8
    const pg8::EpiFp8 E{ws + WS_M + M_YS, D};
    pg8::gemm_phase<pg8::EpiFp8, O, PG8_ALIGN>(lds, tid_in, S, E);
#else
    const pg8::EpiBf16 E{(bf16_t*)(ws + WS_M + M_YS), D, 0, 0, 1.f};
    pg8::gemm_phase<pg8::EpiBf16, O, PG8_ALIGN>(lds, tid_in, S, E);
#endif
}

__device__ __forceinline__ void phase_gemm_win_null(LAS unsigned char* lds, const int tid_in, int bid, int G) {
    const Params P = kparams(); unsigned char* ws = P.ws;
    typedef pg8::Order<D, 2 * DR / 256, false, false> O;
    const O S{T / 256, G, bid, (const char*)(ws + WS_XB), (const char*)(ws + WS_WIN), nullptr, nullptr, nullptr, 0u, nullptr};
    const pg8::EpiNull E{};
    pg8::gemm_phase<pg8::EpiNull, O, PG8_ALIGN>(lds, tid_in, S, E);
}

template <int VARD> __device__ __forceinline__ void phase_moe_down_var(int layer, LAS unsigned char* lds, const int tid_in, int bid, int G) {
    const Params P = kparams(); unsigned char* ws = P.ws; const int* ctl = (const int*)(ws + WS_CTL);
    typedef pg8::Order<DE, 4, false, true, (VARD & 2) ? 0 : 2, WGM_DOWN> O;
    const O S{ctl[97], G, G - 1 - bid, (const char*)(ws + WS_M + M_HDN), (const char*)(ws + WS_W2) + (size_t)layer * NE * (size_t)(D * DE * 2), ctl + 128, nullptr, (unsigned*)(ws + WS_READY + (size_t)layer * READY_BANK), 32u, nullptr};
    if (VARD & 1) { const pg8::EpiNull E{}; pg8::gemm_phase<pg8::EpiNull, O, PG8_ALIGN>(lds, tid_in, S, E); }
    else { const pg8::EpiBf16 E{(bf16_t*)(ws + WS_M + M_YS), D, 0, 0, 1.f}; pg8::gemm_phase<pg8::EpiBf16, O, PG8_ALIGN>(lds, tid_in, S, E); }
}

template <bool GATH> __device__ __forceinline__ void phase_moe_up_null(int layer, LAS unsigned char* lds, const int tid_in, int bid, int G) {
    const Params P = kparams(); unsigned char* ws = P.ws; const int* ctl = (const int*)(ws + WS_CTL);
    typedef pg8::Order<D, 4, GATH, true, 0, WGM_UP> O;
    const O S{ctl[97] < 128 ? ctl[97] : 128, G, bid, (const char*)(ws + WS_XB), (const char*)(ws + WS_W13) + (size_t)layer * NE * (size_t)(D * D * 2), ctl + 128, (const int*)(ws + WS_ROUTE + 512 * 1024), nullptr, 0u, (const LAS int*)(lds + 131072 + 4096)};
    if (GATH) { int t_ = tid_in; asm volatile("" : "+v"(t_)); S.fill_tokl((LAS int*)(lds + 131072 + 4096), t_); __syncthreads(); }
    const pg8::EpiNull E{};
    pg8::gemm_phase<pg8::EpiNull, O, PG8_ALIGN>(lds, tid_in, S, E);
}
constexpr size_t CTL_CNT = 16384;
constexpr int LN_ROWS = 32, LN_TILES = T / LN_ROWS;
typedef float f32x2v __attribute__((ext_vector_type(2)));

__device__ __forceinline__ float wave_sum(float v) {
#pragma unroll
    for (int o = 1; o < 64; o <<= 1) v += __shfl_xor(v, o);
    return v;
}
__device__ __forceinline__ void split_bf(float x, unsigned& hi, unsigned& lo) { hi = f2bf(x); lo = f2bf(x - __uint_as_float(hi << 16)); }

__device__ __forceinline__ void phase_ln(int layer, LAS unsigned char* lds, const int tid_in, int bid, int G, bool dry = false) {
    const Params P = kparams();
    unsigned char* ws = P.ws;
    const bf16_t* Z = (const bf16_t*)P.out; bf16_t* XB = (bf16_t*)(ws + (dry ? WS_M + 128 * MiB : WS_XB));
    const float* lg = P.in[20] + (size_t)(layer * 2) * D; const float* lb = P.in[21] + (size_t)(layer * 2) * D;
    const float* wg = P.in[13] + (size_t)layer * D * 4; const float* bg = P.in[14] + layer * 4;
    const float* we = P.in[15] + (size_t)layer * D * 32; const float* be = P.in[16] + layer * 32;
    unsigned char* rbase = ws + (dry ? WS_M + 192 * MiB : WS_ROUTE);
    int* EXP = (int*)(rbase); float* GATE = (float*)(rbase + 256 * 1024); int* rowtok = (int*)(rbase + 512 * 1024);
    int* CNT = dry ? (int*)(rbase + 2 * MiB) : (int*)(ws + WS_CTL) + CTL_CNT;
    int tid = tid_in; asm volatile("" : "+v"(tid));
    const int lane = tid & 63, w = __builtin_amdgcn_readfirstlane(tid >> 6), fr = lane & 15, fq = lane >> 4;
    for (int i = bid * NTHREADS + tid; i < NROWS_MAX; i += G * NTHREADS) rowtok[i] = -1;
    LAS float* stat = (LAS float*)lds;
    LAS float* part = (LAS float*)(lds + 2048);
    LAS float* logit = (LAS float*)(lds + 2048 + 49152);
    LAS int* hist = (LAS int*)(lds + 2048 + 49152 + 6144);
    v2u vp[2][4][2];
#define LN_LOAD(tl) do { _Pragma("unroll") for (int rt = 0; rt < 2; ++rt) _Pragma("unroll") for (int s = 0; s < 4; ++s) _Pragma("unroll") for (int hf = 0; hf < 2; ++hf) \
        vp[rt][s][hf] = NT_LOAD_S(0, (const v2u*)(Z + (size_t)((tl) * LN_ROWS + 16 * rt + fr) * D + 128 * w + 32 * s + 16 * hf + 4 * fq)); } while (0)
#define LN_UNPACK(p) ((f32x4){__uint_as_float((p).x << 16), __uint_as_float((p).x & 0xffff0000u), __uint_as_float((p).y << 16), __uint_as_float((p).y & 0xffff0000u)})
    if (bid < LN_TILES) LN_LOAD(bid);
    bf16x8 Bh[4][3];
    LAS bf16x8* Bl = (LAS bf16x8*)(lds + 58368) + (w * 12) * 64 + lane;
    { float wv[4][3][8];
#pragma unroll
      for (int s = 0; s < 4; ++s)
#pragma unroll
          for (int ct = 0; ct < 3; ++ct)
#pragma unroll
              for (int j = 0; j < 8; ++j) {
                  const int col = 128 * w + 32 * s + (j < 4 ? 4 * fq + j : 16 + 4 * fq + (j - 4));
                  wv[s][ct][j] = (ct < 2) ? we[(size_t)col * 32 + 16 * ct + fr] : wg[(size_t)col * 4 + (fr & 3)];
              }
#pragma unroll
      for (int s = 0; s < 4; ++s)
#pragma unroll
          for (int ct = 0; ct < 3; ++ct) {
              unsigned h[8], l[8];
#pragma unroll
              for (int j = 0; j < 8; ++j) split_bf((ct < 2 || fr < 4) ? wv[s][ct][j] : 0.f, h[j], l[j]);
              Bh[s][ct] = __builtin_bit_cast(bf16x8, (v4u){h[0] | (h[1] << 16), h[2] | (h[3] << 16), h[4] | (h[5] << 16), h[6] | (h[7] << 16)});
              Bl[(s * 3 + ct) * 64] = __builtin_bit_cast(bf16x8, (v4u){l[0] | (l[1] << 16), l[2] | (l[3] << 16), l[4] | (l[5] << 16), l[6] | (l[7] << 16)});
          } }
    for (int tile = bid; tile < LN_TILES; tile += G) {
        const int row0 = tile * LN_ROWS;
        if (tid < 32) hist[tid] = 0;
#pragma unroll
        for (int rt = 0; rt < 2; ++rt) {
            float sm = 0.f, sq = 0.f;
#pragma unroll
            for (int s = 0; s < 4; ++s)
#pragma unroll
                for (int hf = 0; hf < 2; ++hf) { const f32x4 x = LN_UNPACK(vp[rt][s][hf]); sm += (x[0] + x[1]) + (x[2] + x[3]); sq += (x[0] * x[0] + x[1] * x[1]) + (x[2] * x[2] + x[3] * x[3]); }
            sm += __shfl_xor(sm, 16); sm += __shfl_xor(sm, 32); sq += __shfl_xor(sq, 16); sq += __shfl_xor(sq, 32);
            if (fq == 0) *(LAS f32x2v*)(stat + ((w * 32) + 16 * rt + fr) * 2) = (f32x2v){sm, sq};
        }
#pragma unroll
        for (int rt = 0; rt < 2; ++rt)
#pragma unroll
            for (int s = 0; s < 4; ++s) asm volatile("" : "+v"(vp[rt][s][0]), "+v"(vp[rt][s][1]));
        __syncthreads();
        float mean[2], rstd[2];
#pragma unroll
        for (int rt = 0; rt < 2; ++rt) { float sm = 0.f, sq = 0.f;
#pragma unroll
            for (int ww = 0; ww < 8; ++ww) { const f32x2v a = *(LAS f32x2v*)(stat + ((ww * 32) + 16 * rt + fr) * 2); sm += a.x; sq += a.y; }
            mean[rt] = sm * (1.f / D); const float var = fmaxf(sq * (1.f / D) - mean[rt] * mean[rt], 0.f); rstd[rt] = 1.f / sqrtf(var + LN_EPS); }
        f32x4 acc[2][3];
#pragma unroll
        for (int rt = 0; rt < 2; ++rt)
#pragma unroll
            for (int ct = 0; ct < 3; ++ct) acc[rt][ct] = (f32x4){0.f, 0.f, 0.f, 0.f};
#pragma unroll
        for (int s = 0; s < 4; ++s) {
            asm volatile("" ::: "memory");
            f32x4 gg[2], bb[2];
#pragma unroll
            for (int hf = 0; hf < 2; ++hf) { gg[hf] = *(const f32x4*)(lg + 128 * w + 32 * s + 16 * hf + 4 * fq); bb[hf] = *(const f32x4*)(lb + 128 * w + 32 * s + 16 * hf + 4 * fq); }
#pragma unroll
            for (int rt = 0; rt < 2; ++rt) {
                unsigned hp[4], lp[4];
#pragma unroll
                for (int hf = 0; hf < 2; ++hf) {
                    f32x4 y = (LN_UNPACK(vp[rt][s][hf]) - mean[rt]) * rstd[rt] * gg[hf] + bb[hf];
                    const size_t off = (size_t)(row0 + 16 * rt + fr) * D + 128 * w + 32 * s + 16 * hf + 4 * fq;
#pragma unroll
                    for (int q = 0; q < 2; ++q) { const unsigned hh = pg8::cvt_pk_bf16(y[2 * q], y[2 * q + 1]);
                        hp[2 * hf + q] = hh; lp[2 * hf + q] = pg8::cvt_pk_bf16(y[2 * q] - __uint_as_float(hh << 16), y[2 * q + 1] - __uint_as_float(hh & 0xffff0000u)); }
                    st8_wt(XB + off, (v2u){hp[2 * hf], hp[2 * hf + 1]});
                }
                const bf16x8 Ah = __builtin_bit_cast(bf16x8, (v4u){hp[0], hp[1], hp[2], hp[3]});
                const bf16x8 Al = __builtin_bit_cast(bf16x8, (v4u){lp[0], lp[1], lp[2], lp[3]});
#pragma unroll
                for (int ct = 0; ct < 3; ++ct) {
                    acc[rt][ct] = __builtin_amdgcn_mfma_f32_16x16x32_bf16(Ah, Bh[s][ct], acc[rt][ct], 0, 0, 0);
                    acc[rt][ct] = __builtin_amdgcn_mfma_f32_16x16x32_bf16(Ah, Bl[(s * 3 + ct) * 64], acc[rt][ct], 0, 0, 0);
                    acc[rt][ct] = __builtin_amdgcn_mfma_f32_16x16x32_bf16(Al, Bh[s][ct], acc[rt][ct], 0, 0, 0);
                }
                __builtin_amdgcn_sched_barrier(0);
            }
        }
#pragma unroll
        for (int rt = 0; rt < 2; ++rt)
#pragma unroll
            for (int ct = 0; ct < 3; ++ct) *(LAS f32x4*)(part + (((w * 2 + rt) * 3 + ct) * 64 + lane) * 4) = acc[rt][ct];
        asm volatile("" ::: "memory");
        if (tile + G < LN_TILES) LN_LOAD(tile + G);
        __syncthreads();
#pragma unroll
        for (int k = 0; k < 3; ++k) {
            const int idx = tid + k * NTHREADS, r = idx & 3, ln = (idx >> 2) & 63, t6 = idx >> 8;
            float s = 0.f;
#pragma unroll
            for (int ww = 0; ww < 8; ++ww) s += part[((ww * 6 + t6) * 64 + ln) * 4 + r];
            const int rt = t6 / 3, ct = t6 % 3, row = 16 * rt + 4 * (ln >> 4) + r, col = 16 * ct + (ln & 15);
            logit[row * 48 + col] = s;
        }
        __syncthreads();
        if (tid < 32) {
            const LAS float* L = logit + tid * 48;
            int gi = 0; float gm = L[32] + bg[0];
            for (int o = 1; o < 4; ++o) { const float x = L[32 + o] + bg[o]; if (x > gm) { gm = x; gi = o; } }
            float gs = 0.f;
            for (int o = 0; o < 4; ++o) gs += __expf(L[32 + o] + bg[o] - gm);
            const float ggate = 1.f / gs;
            int i0 = 0; float v0 = L[gi * 8] + be[gi * 8];
            for (int i = 1; i < 8; ++i) { const float x = L[gi * 8 + i] + be[gi * 8 + i]; if (x > v0) { v0 = x; i0 = i; } }
            int i1 = -1; float v1 = -INFINITY;
            for (int i = 0; i < 8; ++i) { const float x = L[gi * 8 + i] + be[gi * 8 + i]; if (i != i0 && x > v1) { v1 = x; i1 = i; } }
            const float w0 = 1.f / (1.f + __expf(v1 - v0)), w1 = 1.f - w0;
            const int row = row0 + tid, e0 = gi * 8 + i0, e1 = gi * 8 + i1;
            EXP[row * 2] = e0; EXP[row * 2 + 1] = e1; GATE[row * 2] = w0 * ggate; GATE[row * 2 + 1] = w1 * ggate;
            __hip_atomic_fetch_add(&hist[e0], 1, __ATOMIC_RELAXED, __HIP_MEMORY_SCOPE_WORKGROUP); __hip_atomic_fetch_add(&hist[e1], 1, __ATOMIC_RELAXED, __HIP_MEMORY_SCOPE_WORKGROUP);
        }
        __syncthreads();
        if (tid < 32) CNT[tile * 32 + tid] = hist[tid];
    }
#undef LN_LOAD
#undef LN_UNPACK
}

#ifndef OUT_NT
#define OUT_NT 0
#endif
#ifndef LN2_STAGGER
#define LN2_STAGGER 0
#endif
template <int VAR = 0> __device__ __forceinline__ void phase_ln2(int layer, LAS unsigned char* lds, const int tid_in, int bid, int G, bool dry = false) {
    const Params P = kparams();
    unsigned char* ws = P.ws;
    const bf16_t* Z = LNSTAT ? (const bf16_t*)(ws + WS_XB) : (const bf16_t*)P.out; bf16_t* XB = (bf16_t*)(ws + (dry ? WS_M + 128 * MiB : WS_XB));
    const float* lg = P.in[20] + (size_t)(layer * 2) * D; const float* lb = P.in[21] + (size_t)(layer * 2) * D;
    unsigned char* rbase = ws + (dry ? WS_M + 192 * MiB : WS_ROUTE);
    int* EXP = (int*)(rbase); float* GATE = (float*)(rbase + 256 * 1024); int* rowtok = (int*)(rbase + 512 * 1024);
    int* CNT = dry ? (int*)(rbase + 2 * MiB) : (int*)(ws + WS_CTL) + CTL_CNT;
    const unsigned char* RF = ws + WS_RF + (size_t)layer * RF_BYTES; const float* RC = (const float*)(ws + WS_RC) + layer * 96;
    int tid0 = tid_in; asm volatile("" : "+v"(tid0));
    const int w = __builtin_amdgcn_readfirstlane(tid0 >> 6);
    __builtin_amdgcn_s_waitcnt(0x0F70);
    LAS int* hist = (LAS int*)(lds + 155648);
    LAS float* Ls = (LAS float*)(lds + w * 2560);
    for (int blk = bid; blk < T / 128; blk += G) {
        int tid = tid0; asm volatile("" : "+v"(tid));
        const int lane = tid & 63, fr = lane & 15, fq = lane >> 4, lr = lane >> 2, lc = lane & 3;
        const int row0 = blk * 128 + 16 * w;
        __syncthreads();
        { const unsigned char* rfl = RF + (unsigned)(tid * 16);
#pragma unroll
          for (int i = 0; i < ((VAR & 4) ? 1 : 18); ++i) __builtin_amdgcn_global_load_lds((const unsigned*)(rfl + i * 8192), (LAS unsigned*)(lds + i * 8192 + w * 1024), 16, 0, 0);
          __builtin_amdgcn_global_load_lds((const unsigned*)((const unsigned char*)(w < 4 ? lg : lb - D) + (unsigned)(tid * 16)), (LAS unsigned*)(lds + 147456 + w * 1024), 16, 0, 0); }
        if (tid < 128) hist[tid] = 0;
        LAS int* lflag = (LAS int*)(lds + 156160);
        if (tid == 0) *lflag = 0;
        float s2c[3], s3c[3];
#pragma unroll
        for (int ct = 0; ct < 3; ++ct) { const int n = (ct < 2) ? 16 * ct + fr : 32 + (fr & 3); s2c[ct] = RC[n]; s3c[ct] = RC[48 + n]; }
        v4u zr[32];
        const bf16_t* zrow = Z + (size_t)(((VAR & 16) ? 16 * w : row0) + lr) * D + 8 * lc;
#if LN2_STAGGER
        asm volatile("" ::: "memory"); __builtin_amdgcn_s_waitcnt(0x0070); asm volatile("" ::: "memory");
        __builtin_amdgcn_s_barrier();
        asm volatile("" ::: "memory");
        if (w >= 4) { while (__hip_atomic_load(lflag, __ATOMIC_RELAXED, __HIP_MEMORY_SCOPE_WORKGROUP) < 4) __builtin_amdgcn_s_sleep(8); }
#pragma unroll
        for (int s = 0; s < 32; ++s) zr[s] = NT_LOAD_S(0, (const v4u*)(zrow + 32 * s));
#else
#pragma unroll
        for (int s = 0; s < 32; ++s) zr[s] = NT_LOAD_S(0, (const v4u*)(zrow + 32 * s));
        asm volatile("" ::: "memory"); if (VAR & 4) __builtin_amdgcn_s_waitcnt(0x0070); else __builtin_amdgcn_s_waitcnt(0x8070 | 0x0000); asm volatile("" ::: "memory");
        __builtin_amdgcn_s_barrier();
        asm volatile("" ::: "memory");
#endif
        f32x4 acc[3];
#pragma unroll
        for (int ct = 0; ct < 3; ++ct) acc[ct] = (f32x4){0.f, 0.f, 0.f, 0.f};
        float sm = 0.f, sq = 0.f;
        const LAS bf16x8* Be = (const LAS bf16x8*)lds + lane;
        const LAS bf16x8* Bg = (const LAS bf16x8*)(lds + 131072) + (fr & 3) + 4 * fq;
        bf16x8 bq[2][6];
#define LN2_LDB(dst, s_) do { dst[0] = Be[(((s_) * 2 + 0) * 2 + 0) * 64]; dst[1] = Be[(((s_) * 2 + 1) * 2 + 0) * 64]; dst[2] = Bg[((s_) * 2 + 0) * 16]; \
                              dst[3] = Be[(((s_) * 2 + 0) * 2 + 1) * 64]; dst[4] = Be[(((s_) * 2 + 1) * 2 + 1) * 64]; dst[5] = Bg[((s_) * 2 + 1) * 16]; } while (0)
        const int pidx = 16 * fr + 4 * fq;
#define LN2_PERM(dst, src) do { dst.x = (unsigned)__builtin_amdgcn_ds_bpermute(pidx, (int)(src).x); dst.y = (unsigned)__builtin_amdgcn_ds_bpermute(pidx, (int)(src).y); \
                                dst.z = (unsigned)__builtin_amdgcn_ds_bpermute(pidx, (int)(src).z); dst.w = (unsigned)__builtin_amdgcn_ds_bpermute(pidx, (int)(src).w); } while (0)
        v4u ac, an;
        LN2_LDB(bq[0], 0); LN2_PERM(ac, zr[0]); an = ac;
#pragma unroll
        for (int s = 0; s < 32; ++s) {
            if (s + 1 < 32) { LN2_LDB(bq[(s + 1) & 1], s + 1); LN2_PERM(an, zr[s + 1]); }
            const v4u zz = zr[s];
            const bf16x8 a = __builtin_bit_cast(bf16x8, ac);
#pragma unroll
            for (int i = 0; i < ((VAR & 2) ? 0 : 6); ++i) acc[i % 3] = __builtin_amdgcn_mfma_f32_16x16x32_bf16(a, bq[s & 1][i], acc[i % 3], 0, 0, 0);
#pragma unroll
            for (int e = 0; e < 4; ++e) { const float x0 = __uint_as_float(zz[e] << 16), x1 = __uint_as_float(zz[e] & 0xffff0000u); sm += x0 + x1; sq = __builtin_fmaf(x0, x0, sq); sq = __builtin_fmaf(x1, x1, sq); }
            ac = an;
            __builtin_amdgcn_sched_barrier(0);
        }
#undef LN2_LDB
#undef LN2_PERM
        if (LN2_STAGGER && w < 4 && lane == 0) __hip_atomic_fetch_add(lflag, 1, __ATOMIC_RELAXED, __HIP_MEMORY_SCOPE_WORKGROUP);
#pragma unroll
        for (int s = 0; s < 32; ++s) asm volatile("" : "+v"(zr[s]));
        sm += __shfl_xor(sm, 1); sm += __shfl_xor(sm, 2); sq += __shfl_xor(sq, 1); sq += __shfl_xor(sq, 2);
        const float mean = sm * (1.f / D), rstd = 1.f / sqrtf(fmaxf(sq * (1.f / D) - mean * mean, 0.f) + LN_EPS);
        if (LNSTAT && !dry && lc == 0) ((float2*)(ws + WS_STAT))[row0 + lr] = make_float2(mean, rstd);
        { const LAS f32x4* G4 = (const LAS f32x4*)(lds + 147456) + 2 * lc; const LAS f32x4* B4 = G4 + 256;
          bf16_t* xrow = XB + (size_t)(row0 + lr) * D + 8 * lc;
          unsigned char* xrow8 = ws + (dry ? WS_M + 96 * MiB : WS_XB8) + (size_t)(row0 + lr) * D + 8 * lc;
#pragma unroll
          for (int s = 0; s < 32; ++s) {
              const v4u zz = zr[s];
              const f32x4 x0 = {__uint_as_float(zz.x << 16), __uint_as_float(zz.x & 0xffff0000u), __uint_as_float(zz.y << 16), __uint_as_float(zz.y & 0xffff0000u)};
              const f32x4 x1 = {__uint_as_float(zz.z << 16), __uint_as_float(zz.z & 0xffff0000u), __uint_as_float(zz.w << 16), __uint_as_float(zz.w & 0xffff0000u)};
              const f32x4 y0 = (x0 - mean) * rstd * G4[8 * s] + B4[8 * s], y1 = (x1 - mean) * rstd * G4[8 * s + 1] + B4[8 * s + 1];
              if (!LNSTAT && (!(VAR & 1) || s == 0)) { const v4u o16_ = {pg8::cvt_pk_bf16(y0[0], y0[1]), pg8::cvt_pk_bf16(y0[2], y0[3]), pg8::cvt_pk_bf16(y1[0], y1[1]), pg8::cvt_pk_bf16(y1[2], y1[3])};
                  if (OUT_NT) __builtin_nontemporal_store(o16_, (v4u*)(xrow + 32 * s)); else st16_wt(xrow + 32 * s, o16_); }
              if (UP_F8 && (!(VAR & 1) || s == 0)) { const v2u o8_ = {pk_fp8x4(y0[0], y0[1], y0[2], y0[3]), pk_fp8x4(y1[0], y1[1], y1[2], y1[3])}; if (OUT_NT) __builtin_nontemporal_store(o8_, (v2u*)(xrow8 + 32 * s)); else *(v2u*)(xrow8 + 32 * s) = o8_; }
          } }
        float lv[3][4];
#pragma unroll
        for (int r = 0; r < 4; ++r) { const float mr = __shfl(mean, 4 * (4 * fq + r)), rr = __shfl(rstd, 4 * (4 * fq + r));
#pragma unroll
            for (int ct = 0; ct < 3; ++ct) lv[ct][r] = rr * (acc[ct][r] - mr * s2c[ct]) + s3c[ct]; }
        __syncthreads();
#pragma unroll
        for (int ct = 0; ct < 3; ++ct)
#pragma unroll
            for (int r = 0; r < 4; ++r) if (ct < 2 || fr < 4) Ls[(4 * fq + r) * 37 + 16 * ct + fr] = lv[ct][r];
        LDS_WAIT();
        if (lane < 16 && !(VAR & 8)) {
            const LAS float* L = Ls + lane * 37;
            int gi = 0; float gm = L[32];
            for (int o = 1; o < 4; ++o) { const float x = L[32 + o]; if (x > gm) { gm = x; gi = o; } }
            float gs = 0.f;
            for (int o = 0; o < 4; ++o) gs += __expf(L[32 + o] - gm);
            const float ggate = 1.f / gs;
            int i0 = 0; float v0 = L[gi * 8];
            for (int i = 1; i < 8; ++i) { const float x = L[gi * 8 + i]; if (x > v0) { v0 = x; i0 = i; } }
            int i1 = -1; float v1 = -INFINITY;
            for (int i = 0; i < 8; ++i) { const float x = L[gi * 8 + i]; if (i != i0 && x > v1) { v1 = x; i1 = i; } }
            const float w0 = 1.f / (1.f + __expf(v1 - v0)), w1 = 1.f - w0;
            const int row = row0 + lane, e0 = gi * 8 + i0, e1 = gi * 8 + i1;
            EXP[row * 2] = e0; EXP[row * 2 + 1] = e1; GATE[row * 2] = w0 * ggate; GATE[row * 2 + 1] = w1 * ggate;
            LAS int* hh = hist + (w >> 1) * 32;
            __hip_atomic_fetch_add(&hh[e0], 1, __ATOMIC_RELAXED, __HIP_MEMORY_SCOPE_WORKGROUP); __hip_atomic_fetch_add(&hh[e1], 1, __ATOMIC_RELAXED, __HIP_MEMORY_SCOPE_WORKGROUP);
        }
        __syncthreads();
        if (tid < 128) CNT[(blk * 4 + (tid >> 5)) * 32 + (tid & 31)] = hist[tid];
    }
    for (int i = bid * NTHREADS + tid0; i < NROWS_MAX; i += G * NTHREADS) rowtok[i] = -1;
}

__device__ __forceinline__ void phase_route(LAS unsigned char* lds, const int tid_in, int bid, int G) {
    const Params P = kparams();
    unsigned char* ws = P.ws;
    int* ctl = (int*)(ws + WS_CTL); const int* CNT = ctl + CTL_CNT;
    const int* EXP = (const int*)(ws + WS_ROUTE); int* rowtok = (int*)(ws + WS_ROUTE + 512 * 1024); int* slotrow = (int*)(ws + WS_ROUTE + 1024 * 1024);
    int tid = tid_in; asm volatile("" : "+v"(tid));
    const int lane = tid & 63, w = __builtin_amdgcn_readfirstlane(tid >> 6);
    LAS int* tab = (LAS int*)lds;
    LAS int* csum = (LAS int*)(lds + 131072);
    LAS int* cbase = (LAS int*)(lds + 131072 + 2048);
    const int tile0 = bid * NWAVES + w;
    int ex0 = 0; if (tile0 < LN_TILES) ex0 = EXP[tile0 * 64 + lane];
#pragma unroll
    for (int i = 0; i < LN_TILES * 32 * 4 / (NTHREADS * 16); ++i)
        __builtin_amdgcn_global_load_lds((const unsigned*)((const unsigned char*)CNT + (unsigned)((i * NTHREADS + tid) * 16)), (LAS unsigned*)(lds + i * 8192 + w * 1024), 16, 0, 0);
    asm volatile("s_waitcnt vmcnt(0)" ::: "memory");
    __syncthreads();
    const int e = tid & 31, ch = tid >> 5;
    { int run = 0;
#pragma unroll 8
      for (int t = 0; t < 64; ++t) { LAS int* p = tab + (ch * 64 + t) * 32 + e; const int v = *p; *p = run; run += v; }
      csum[ch * 32 + e] = run; }
    __syncthreads();
    if (tid < 32) { int run = 0; for (int c = 0; c < 16; ++c) { const int v = csum[c * 32 + tid]; cbase[c * 32 + tid] = run; run += v; } csum[tid] = run;   }
    __syncthreads();
    if (tid == 0) { int off = 0; for (int x = 0; x < NE; ++x) { const int p = (csum[x] + MB - 1) / MB * MB; csum[32 + x] = off;
            if (bid == 0) for (int r = off / MB; r < (off + p) / MB; ++r) ctl[128 + r] = x;
            off += p; }
        if (bid == 0) { ctl[96] = off; ctl[97] = off / MB; } }
    __syncthreads();
    for (int tile = tile0; tile < LN_TILES; tile += G * NWAVES) {
        const int slot = tile * 64 + lane, ex = (tile == tile0) ? ex0 : EXP[slot];
        int rank = 0;
        for (int x = 0; x < NE; ++x) { const unsigned long long m = __ballot(ex == x); if (ex == x) rank = __popcll(m & ((1ull << lane) - 1ull)); }
        const int row = csum[32 + ex] + cbase[(tile >> 6) * 32 + ex] + tab[tile * 32 + ex] + rank;
        rowtok[row] = slot; slotrow[slot] = row;
    }
}

#ifndef FINAL_NT
#define FINAL_NT 1
#endif
#ifndef CB_NQ
#define CB_NQ 2
#endif
__device__ __forceinline__ void phase_combine(int layer, const int tid_in, int bid, int G, bool dry = false) {
    const Params P = kparams();
    unsigned char* ws = P.ws;
    bf16_t* XB = (bf16_t*)(ws + WS_XB); float* Xo = P.out; const bf16_t* YS = (const bf16_t*)(ws + WS_M + M_YS);
    const float* GATE = (const float*)(ws + WS_ROUTE + 256 * 1024); const int* slotrow = (const int*)(ws + WS_ROUTE + 1024 * 1024);
    const float* g = P.in[20] + (size_t)(layer * 2 + 1) * D; const float* b = P.in[21] + (size_t)(layer * 2 + 1) * D;
    int tid = tid_in; asm volatile("" : "+v"(tid));
    const int lane = tid & 63, w = __builtin_amdgcn_readfirstlane(tid >> 6);
    constexpr int NQ = CB_NQ;
    const int NW = G * NWAVES, w0 = bid * NWAVES + w;
    const int nit = (T - w0 + NQ * NW - 1) / (NQ * NW);
    float mgv[4], mstv[4]; int msv[4];
    v2u raw[2][NQ][4]; unsigned rys[2][NQ][4][2];
#define CB_RLF(v_, l_) __uint_as_float((unsigned)__builtin_amdgcn_readlane((int)__float_as_uint(v_), (l_)))
#define CB_META(bf, i_) do { int row = w0 + NQ * NW * (i_) + ((lane >> 1) & (NQ - 1)) * NW; row = row < T ? row : w0; const int ix_ = row * 2 + (lane & 1); \
        mgv[bf] = GATE[ix_]; msv[bf] = slotrow[ix_]; if (LNSTAT) mstv[bf] = ((const float*)(ws + WS_STAT))[ix_]; } while (0)
#define CB_ROWS(rb, bf, i_) do { _Pragma("unroll") for (int q = 0; q < NQ; ++q) { int row = w0 + NQ * NW * (i_) + q * NW; row = row < T ? row : w0; \
        const v2u* xr = (const v2u*)(XB + (size_t)row * D); \
        const unsigned* y0 = (const unsigned*)((const unsigned char*)YS + (size_t)__builtin_amdgcn_readlane(msv[bf], 2 * q) * D); const unsigned* y1 = (const unsigned*)((const unsigned char*)YS + (size_t)__builtin_amdgcn_readlane(msv[bf], 2 * q + 1) * D); \
        _Pragma("unroll") for (int j = 0; j < 4; ++j) { raw[rb][q][j] = NT_LOAD_S(1, xr + lane + 64 * j); rys[rb][q][j][0] = y0[lane + 64 * j]; rys[rb][q][j][1] = y1[lane + 64 * j]; } } } while (0)
    static_assert(YS_F8 == 1 && (NQ == 2 || NQ == 4), "combine: fp8 expert outputs, 2 or 4 rows per iteration");
    f32x4 gg[4], bb[4];
#pragma unroll
    for (int j = 0; j < 4; ++j) { gg[j] = ((const f32x4*)g)[lane + 64 * j]; bb[j] = ((const f32x4*)b)[lane + 64 * j]; }
    f32x4 g1[4], b1[4];
    if (LNSTAT) { const float* g1p = P.in[20] + (size_t)(layer * 2) * D; const float* b1p = P.in[21] + (size_t)(layer * 2) * D;
#pragma unroll
        for (int j = 0; j < 4; ++j) { g1[j] = ((const f32x4*)g1p)[lane + 64 * j]; b1[j] = ((const f32x4*)b1p)[lane + 64 * j]; } }
    if (nit > 0) { CB_META(0, 0); if (nit > 1) CB_META(1, 1); if (nit > 2) CB_META(2, 2); CB_ROWS(0, 0, 0); if (nit > 1) CB_ROWS(1, 1, 1); }
#define CB_BODY(BF, I) do { constexpr int RB_ = (BF) & 1; \
        _Pragma("unroll") for (int h = 0; h < NQ / 2; ++h) { \
            f32x4 v[2][4]; float s[2]; \
            _Pragma("unroll") for (int q2 = 0; q2 < 2; ++q2) { const int q = 2 * h + q2; \
                const float g0 = CB_RLF(mgv[BF], 2 * q), g1_ = CB_RLF(mgv[BF], 2 * q + 1); const float zm = LNSTAT ? CB_RLF(mstv[BF], 2 * q) : 0.f, zs = LNSTAT ? CB_RLF(mstv[BF], 2 * q + 1) : 0.f; \
                s[q2] = 0.f; \
                _Pragma("unroll") for (int j = 0; j < 4; ++j) { const v2u xx = raw[RB_][q][j]; const unsigned a_ = rys[RB_][q][j][0], c_ = rys[RB_][q][j][1]; \
                    f32x4 x = {__uint_as_float(xx.x << 16), __uint_as_float(xx.x & 0xffff0000u), __uint_as_float(xx.y << 16), __uint_as_float(xx.y & 0xffff0000u)}; \
                    if (LNSTAT) x = (x - zm) * zs * g1[j] + b1[j]; \
                    const f32x4 fa = {__builtin_amdgcn_cvt_f32_fp8((int)a_, 0), __builtin_amdgcn_cvt_f32_fp8((int)a_, 1), __builtin_amdgcn_cvt_f32_fp8((int)a_, 2), __builtin_amdgcn_cvt_f32_fp8((int)a_, 3)}; \
                    const f32x4 fc = {__builtin_amdgcn_cvt_f32_fp8((int)c_, 0), __builtin_amdgcn_cvt_f32_fp8((int)c_, 1), __builtin_amdgcn_cvt_f32_fp8((int)c_, 2), __builtin_amdgcn_cvt_f32_fp8((int)c_, 3)}; \
                    v[q2][j] = x * ALPHA + (fa * g0 + fc * g1_); \
                    s[q2] += (v[q2][j][0] + v[q2][j][1]) + (v[q2][j][2] + v[q2][j][3]); } } \
            if (h == NQ / 2 - 1) { if ((I) + 3 < nit) CB_META(((BF) + 3) & 3, (I) + 3); if ((I) + 2 < nit) CB_ROWS(RB_, ((BF) + 2) & 3, (I) + 2); } \
            _Pragma("unroll") for (int q2 = 0; q2 < 2; ++q2) { \
                const int row = w0 + NQ * NW * (I) + (2 * h + q2) * NW; \
                if (row >= T) continue; \
                const float mean = wave_sum(s[q2]) * (1.f / D); \
                float qq = 0.f; \
                _Pragma("unroll") for (int j = 0; j < 4; ++j) { v[q2][j] = v[q2][j] - mean; qq += (v[q2][j][0] * v[q2][j][0] + v[q2][j][1] * v[q2][j][1]) + (v[q2][j][2] * v[q2][j][2] + v[q2][j][3] * v[q2][j][3]); } \
                const float rstd = 1.f / sqrtf(wave_sum(qq) * (1.f / D) + LN_EPS); \
                _Pragma("unroll") for (int j = 0; j < 4; ++j) { \
                    const f32x4 y = v[q2][j] * rstd * gg[j] + bb[j]; \
                    if (layer == 0) { const v2u ob_ = {pk2(y[0], y[1]), pk2(y[2], y[3])}; \
                        ((v2u*)(XB + (size_t)row * D))[lane + 64 * j] = ob_; \
                        if (ATT_F8) { const unsigned o8_ = pk_fp8x4(y[0], y[1], y[2], y[3]); ((unsigned*)(ws + WS_XB8 + (size_t)row * D))[lane + 64 * j] = o8_; } } \
                    else __builtin_nontemporal_store(y, (f32x4*)(Xo + (size_t)row * D) + lane + 64 * j); } } } } while (0)
#pragma unroll 1
    for (int i = 0; i < nit; i += 4) {
        CB_BODY(0, i);
        if (i + 1 < nit) CB_BODY(1, i + 1);
        if (i + 2 < nit) CB_BODY(2, i + 2);
        if (i + 3 < nit) CB_BODY(3, i + 3);
    }
#undef CB_BODY
#undef CB_RLF
#undef CB_META
#undef CB_ROWS
}

constexpr int CQK_ROWS = 16, CQK_PARTS = 256 / CQK_ROWS;
constexpr unsigned CQK_NEED = 64u * CQK_PARTS;
__device__ __forceinline__ void comb_queue(const Params& P, LAS unsigned char* lds, int tid) {
    unsigned char* ws = P.ws;
    const bf16_t* XB = (const bf16_t*)(ws + WS_XB); bf16_t* XB2 = (bf16_t*)(ws + WS_XB2); const bf16_t* YS = (const bf16_t*)(ws + WS_M + M_YS);
    const float* GATE = (const float*)(ws + WS_ROUTE + 256 * 1024); const int* slotrow = (const int*)(ws + WS_ROUTE + 1024 * 1024);
    const float* g = P.in[20] + (size_t)D; const float* b = P.in[21] + (size_t)D;
    unsigned* q = (unsigned*)(ws + WS_Q) + 12;
    unsigned* rdy = (unsigned*)(ws + WS_XRDY);
    const int lane = tid & 63;
    const int total = (T / 256) * CQK_PARTS;
    LAS f32x4* gbl = (LAS f32x4*)lds;
    gbl[tid] = (tid < 256) ? ((const f32x4*)g)[tid] : ((const f32x4*)b)[tid - 256];
    __syncthreads();
#define CQ_ROW0(tk_) ((16 * (((tk_) / CQK_PARTS) & 7) + (((tk_) / CQK_PARTS) >> 3)) * 256 + ((tk_) % CQK_PARTS) * CQK_ROWS)
#define CQ_META(tk_, mg0_, mg1_, ms0_, ms1_) do { const int r_ = CQ_ROW0(tk_) + (lane & 15); mg0_ = GATE[r_ * 2]; mg1_ = GATE[r_ * 2 + 1]; ms0_ = slotrow[r_ * 2]; ms1_ = slotrow[r_ * 2 + 1]; } while (0)
#define CQ_LOAD(rowb_, qd_, ms0_, ms1_) do { _Pragma("unroll") for (int qq = 0; qq < 4; ++qq) { const int rl_ = 4 * (qd_) + qq; \
        const v2u* xr = (const v2u*)(XB + (size_t)((rowb_) + rl_) * D); \
        const v2u* y0 = (const v2u*)(YS + (size_t)__builtin_amdgcn_readlane(ms0_, rl_) * D); const v2u* y1 = (const v2u*)(YS + (size_t)__builtin_amdgcn_readlane(ms1_, rl_) * D); \
        _Pragma("unroll") for (int j = 0; j < 4; ++j) { raw[qq][j][0] = xr[lane + 64 * j]; raw[qq][j][1] = y0[lane + 64 * j]; raw[qq][j][2] = y1[lane + 64 * j]; } } } while (0)
    unsigned b0 = __hip_atomic_fetch_add(q, 1u, __ATOMIC_RELAXED, __HIP_MEMORY_SCOPE_AGENT);
    int tk = __builtin_amdgcn_readfirstlane((int)(b0 >> 6));
    if (tk >= total) return;
    float mg0, mg1, ng0 = 0.f, ng1 = 0.f; int ms0, ms1, ns0 = 0, ns1 = 0;
    v2u raw[4][4][3];
    CQ_META(tk, mg0, mg1, ms0, ms1);
    CQ_LOAD(CQ_ROW0(tk), 0, ms0, ms1);
    for (int guard = 0; guard <= total; ++guard) {
        const int row0 = CQ_ROW0(tk), pm = row0 >> 8;
        const unsigned b1 = __hip_atomic_fetch_add(q, 1u, __ATOMIC_RELAXED, __HIP_MEMORY_SCOPE_AGENT);
        const int tkn = __builtin_amdgcn_readfirstlane((int)(b1 >> 6));
        const bool more = tkn < total;
        if (more) CQ_META(tkn, ng0, ng1, ns0, ns1);
#pragma unroll
        for (int qd = 0; qd < 4; ++qd) {
            f32x4 v[4][4]; float sm[4];
#pragma unroll
            for (int qq = 0; qq < 4; ++qq) {
                const float g0 = __uint_as_float((unsigned)__builtin_amdgcn_readlane((int)__float_as_uint(mg0), 4 * qd + qq)), g1 = __uint_as_float((unsigned)__builtin_amdgcn_readlane((int)__float_as_uint(mg1), 4 * qd + qq));
                sm[qq] = 0.f;
#pragma unroll
                for (int j = 0; j < 4; ++j) { const v2u xx = raw[qq][j][0], a = raw[qq][j][1], c = raw[qq][j][2];
                    const f32x4 x = {__uint_as_float(xx.x << 16), __uint_as_float(xx.x & 0xffff0000u), __uint_as_float(xx.y << 16), __uint_as_float(xx.y & 0xffff0000u)};
                    const f32x4 fa = {__uint_as_float(a.x << 16), __uint_as_float(a.x & 0xffff0000u), __uint_as_float(a.y << 16), __uint_as_float(a.y & 0xffff0000u)};
                    const f32x4 fc = {__uint_as_float(c.x << 16), __uint_as_float(c.x & 0xffff0000u), __uint_as_float(c.y << 16), __uint_as_float(c.y & 0xffff0000u)};
                    v[qq][j] = x * ALPHA + (fa * g0 + fc * g1);
                    sm[qq] += (v[qq][j][0] + v[qq][j][1]) + (v[qq][j][2] + v[qq][j][3]); }
            }
            if (qd < 3) CQ_LOAD(row0, qd + 1, ms0, ms1);
            else if (more) CQ_LOAD(CQ_ROW0(tkn), 0, ns0, ns1);
#pragma unroll
            for (int qq = 0; qq < 4; ++qq) {
                const int row = row0 + 4 * qd + qq;
                const float mean = wave_sum(sm[qq]) * (1.f / D);
                float q2 = 0.f;
#pragma unroll
                for (int j = 0; j < 4; ++j) { v[qq][j] = v[qq][j] - mean; q2 += (v[qq][j][0] * v[qq][j][0] + v[qq][j][1] * v[qq][j][1]) + (v[qq][j][2] * v[qq][j][2] + v[qq][j][3] * v[qq][j][3]); }
                const float rstd = 1.f / sqrtf(wave_sum(q2) * (1.f / D) + LN_EPS);
#pragma unroll
                for (int j = 0; j < 4; ++j) { const f32x4 y = v[qq][j] * rstd * gbl[lane + 64 * j] + gbl[256 + lane + 64 * j];
                    const v2u o2 = {pk2(y[0], y[1]), pk2(y[2], y[3])};
                    asm volatile("global_store_dwordx2 %0, %1, off sc1\n\ts_nop 0" :: "v"((v2u*)(XB2 + (size_t)row * D) + lane + 64 * j), "v"(o2) : "memory"); }
            }
        }
        asm volatile("s_waitcnt vmcnt(0)" ::: "memory");
        (void)__hip_atomic_fetch_add(rdy + 64 * pm, 1u, __ATOMIC_RELAXED, __HIP_MEMORY_SCOPE_AGENT);
        if (!more) break;
        tk = tkn; mg0 = ng0; mg1 = ng1; ms0 = ns0; ms1 = ns1;
    }
#undef CQ_LOAD
#undef CQ_META
#undef CQ_ROW0
}
constexpr int ATT_KSTR = 144;
constexpr int ATT_VSTR = 528;
constexpr int ATT_K_OFF = 0, ATT_V_OFF = 256 * ATT_KSTR;
template <int VAR = 0> __device__ __forceinline__ void phase_attn(LAS unsigned char* lds, const int tid_in, int bid, int G) {
    const Params P = kparams();
    unsigned char* ws = P.ws;
    const bf16_t* QKV = (const bf16_t*)(ws + WS_M + M_QKV); bf16_t* O = (bf16_t*)(ws + WS_M + M_O);
    const float* sinks = P.in[11];
    int tid = tid_in; asm volatile("" : "+v"(tid));
    const int lane = tid & 63, w = __builtin_amdgcn_readfirstlane(tid >> 6), fr = lane & 15, fq = lane >> 4;
    const int g = w >> 1, qh = w & 1;
    const int vcu = (G % 8 == 0) ? (bid % 8) * (G / 8) + bid / 8 : bid;
    LAS unsigned char* Kl = lds + ATT_K_OFF; LAS unsigned char* Vl = lds + ATT_V_OFF;
    const float L2E = 1.4426950408889634f;
    v4u kvr[4], vvr[4];
#pragma unroll
    for (int it = 0; it < 4; ++it) { kvr[it] = (v4u){0u, 0u, 0u, 0u}; vvr[it] = (v4u){0u, 0u, 0u, 0u}; }
    bf16x8 qf[2][2];
#define ATT_QLOAD(unit_, it_) do { const int nb_ = (unit_) & 15, kvh_ = ((unit_) >> 4) & 3, b_ = (unit_) >> 6; \
        const bf16_t* qp_ = QKV + (size_t)((long)b_ * SEQ + nb_ * 128 + 64 * qh + 32 * (it_) + fr) * QKVD + (kvh_ * 4 + g) * 64 + 8 * fq; \
        _Pragma("unroll") for (int qt = 0; qt < 2; ++qt) _Pragma("unroll") for (int ds = 0; ds < 2; ++ds) qf[qt][ds] = NT_LOAD_S(3, (const bf16x8*)(qp_ + (size_t)(16 * qt) * QKVD + 32 * ds)); } while (0)
    if (vcu * 4 < BATCH * 4 * 16) ATT_QLOAD(vcu * 4, 0);
    for (int L = vcu * 4; L < BATCH * 4 * 16; L += G * 4) {
      for (int u4 = 0; u4 < 4; ++u4) {
        const int unit = L + u4; if (unit >= BATCH * 4 * 16) break;
        const int nb = unit & 15, kvh = (unit >> 4) & 3, b = unit >> 6;
        const int h = kvh * 4 + g;
        const float slope2 = __builtin_amdgcn_exp2f(-0.5f * (float)(h + 1)) * L2E, sink2 = sinks[h] * L2E;
        const long rowbase = (long)b * SEQ + nb * 128 - 128;
        if (u4 == 0) {
#pragma unroll
            for (int it = 0; it < 4; ++it) {
                const int c = tid + it * NTHREADS, sj = c >> 3, ch = c & 7;
                kvr[it] = (v4u){0u, 0u, 0u, 0u}; vvr[it] = (v4u){0u, 0u, 0u, 0u};
                if (!(VAR & 1) && (nb > 0 || sj >= 128)) { const bf16_t* rp = QKV + (size_t)(rowbase + sj) * QKVD + kvh * 64 + ch * 8; kvr[it] = *(const v4u*)(rp + 1024); vvr[it] = *(const v4u*)(rp + 1280); }
            }
        }
        __syncthreads();
#pragma unroll
        for (int it = 0; it < 4; ++it) {
            const int c = tid + it * NTHREADS, sj = c >> 3, ch = c & 7;
            *(LAS v4u*)(Kl + sj * ATT_KSTR + ch * 16) = kvr[it];
            LAS bf16_t* vt = (LAS bf16_t*)(Vl + (ch * 8) * ATT_VSTR) + (sj ^ (ch << 2));
            const v4u vv = vvr[it];
#pragma unroll
            for (int e = 0; e < 8; ++e) vt[e * (ATT_VSTR / 2)] = (bf16_t)(vv[e >> 1] >> (16 * (e & 1)));
        }
        __syncthreads();
        if (u4 < 3 && unit + 1 < BATCH * 4 * 16) {
            const long rb2 = rowbase + 128;
#pragma unroll
            for (int it = 0; it < 4; ++it) {
                const int c = tid + it * NTHREADS, sj = c >> 3, ch = c & 7;
                const bf16_t* rp = QKV + (size_t)(rb2 + sj) * QKVD + kvh * 64 + ch * 8;
                if (!(VAR & 1)) { kvr[it] = *(const v4u*)(rp + 1024); vvr[it] = *(const v4u*)(rp + 1280); }
            }
        }
#pragma unroll 1
        for (int it = 0; it < 2; ++it) {
            const int kb = 4 * qh + 2 * it;
            const int qrow0 = 64 * qh + 32 * it;
            f32x4 acc[2][9];
#pragma unroll
            for (int qt = 0; qt < 2; ++qt)
#pragma unroll
                for (int i = 0; i < 9; ++i) acc[qt][i] = (f32x4){0.f, 0.f, 0.f, 0.f};
#pragma unroll
            for (int u = 0; u < 10; ++u)
#pragma unroll
                for (int ds = 0; ds < 2; ++ds) {
                    const bf16x8 kf = *(const LAS bf16x8*)(Kl + (16 * (kb + u) + fr) * ATT_KSTR + ds * 64 + fq * 16);
                    if (u <= 8) acc[0][u] = __builtin_amdgcn_mfma_f32_16x16x32_bf16(kf, qf[0][ds], acc[0][u], 0, 0, 0);
                    if (u >= 1) acc[1][u - 1] = __builtin_amdgcn_mfma_f32_16x16x32_bf16(kf, qf[1][ds], acc[1][u - 1], 0, 0, 0);
                }
            {
              const int nunit = (it == 0) ? unit : (u4 < 3 ? unit + 1 : L + G * 4);
              if (nunit < BATCH * 4 * 16) ATT_QLOAD(nunit, it ^ 1); }
#pragma unroll
            for (int qt = 0; qt < 2; ++qt) {
                const int kt0 = kb + qt;
                const int q = qrow0 + 16 * qt + fr;
                float m = -INFINITY;
                const float abias = -slope2 * (float)(fr - 4 * fq);
#pragma unroll
                for (int i = 0; i < 9; ++i)
#pragma unroll
                    for (int r = 0; r < 4; ++r) {
                        const int e = 4 * fq + r;
                        bool ok = (i == 0) ? (e > fr) : (i == 8) ? (e <= fr) : true;
                        if (nb == 0) ok = ok && (kt0 + i >= 8);
                        const float s = (VAR & 2) ? acc[qt][i][r] : (ok ? acc[qt][i][r] + __builtin_fmaf(slope2, (float)(r - 16 * (8 - i)), abias) : -INFINITY);
                        acc[qt][i][r] = s; m = fmaxf(m, s);
                    }
                m = fmaxf(m, __shfl_xor(m, 16)); m = fmaxf(m, __shfl_xor(m, 32));
                m = fmaxf(m, sink2);
                float l = 0.f;
                unsigned pk[10][2];
#pragma unroll
                for (int i = 0; i < 9; ++i) {
                    float p[4];
#pragma unroll
                    for (int r = 0; r < 4; ++r) { p[r] = (VAR & 2) ? acc[qt][i][r] : __builtin_amdgcn_exp2f(acc[qt][i][r] - m); l += p[r]; }
                    pk[i][0] = pg8::cvt_pk_bf16(p[0], p[1]); pk[i][1] = pg8::cvt_pk_bf16(p[2], p[3]);
                }
                pk[9][0] = 0u; pk[9][1] = 0u;
                l += __shfl_xor(l, 16); l += __shfl_xor(l, 32);
                l += __builtin_amdgcn_exp2f(sink2 - m);
                const float rl = 1.f / l;
                f32x4 oacc[4];
#pragma unroll
                for (int dt = 0; dt < 4; ++dt) oacc[dt] = (f32x4){0.f, 0.f, 0.f, 0.f};
#pragma unroll
                for (int c = 0; c < 5; ++c) {
                    const int i0 = 2 * c, i1 = (c < 4) ? 2 * c + 1 : 7;
                    const bf16x8 pf = __builtin_bit_cast(bf16x8, (v4u){pk[i0][0], pk[i0][1], pk[2 * c + 1][0], pk[2 * c + 1][1]});
#pragma unroll
                    for (int dt = 0; dt < 4; ++dt) {
                        const LAS unsigned char* vr = Vl + (16 * dt + fr) * ATT_VSTR;
                        const int vsw = (((16 * dt + fr) >> 3) & 7) << 3;
                        const v2u a0 = *(const LAS v2u*)(vr + ((32 * (kt0 + i0) + 8 * fq) ^ vsw)), a1 = *(const LAS v2u*)(vr + ((32 * (kt0 + i1) + 8 * fq) ^ vsw));
                        const bf16x8 vf = __builtin_bit_cast(bf16x8, (v4u){a0.x, a0.y, a1.x, a1.y});
                        oacc[dt] = __builtin_amdgcn_mfma_f32_16x16x32_bf16(vf, pf, oacc[dt], 0, 0, 0);
                    }
                }
                bf16_t* orow = O + (size_t)(rowbase + 128 + q) * D + h * 64 + 4 * fq;
#pragma unroll
                for (int dt = 0; dt < 4; ++dt) {
                    if (ATT_F8) { const float r8 = rl * (float)(1 << O8_SHIFT);
                        *(unsigned*)((unsigned char*)O + (size_t)(rowbase + 128 + q) * D + h * 64 + 4 * fq + 16 * dt) = pk_fp8x4(oacc[dt][0] * r8, oacc[dt][1] * r8, oacc[dt][2] * r8, oacc[dt][3] * r8); }
                    else st8_wt(orow + 16 * dt, (v2u){pg8::cvt_pk_bf16(oacc[dt][0] * rl, oacc[dt][1] * rl), pg8::cvt_pk_bf16(oacc[dt][2] * rl, oacc[dt][3] * rl)}); }
            }
        }
      }
    }
#undef ATT_QLOAD
}
constexpr int RG_GF_OFF = 0;
constexpr int RG_C_OFF = 25600;
constexpr int RG_TOT_OFF = 25600 + 2560;
constexpr int RG_RS = 176;
constexpr int RG_X_OFF = 35840, RG_XB = 131 * RG_RS + 48;
constexpr int RG_G_OFF = RG_X_OFF + 2 * RG_XB, RG_GB = 128 * RG_RS;
constexpr int RG_Y_OFF = RG_G_OFF + 2 * RG_GB;
static_assert(RG_Y_OFF + RG_GB <= 163840 - 16, "RG-LRU LDS map");
#ifndef BG_IN_RGLRU
#define BG_IN_RGLRU 0
#endif
#ifndef BG_NTST
#define BG_NTST 0
#endif
#if BG_NTST
#define BG_ST(v, p) __builtin_nontemporal_store(v, p)
#else
#define BG_ST(v, p) (*(p) = (v))
#endif
constexpr int BG_CHUNKS = 3 * NE * 512;
struct BgChunk { const float* src; bf16_t* dst; int nstride; };
__device__ __forceinline__ BgChunk bg_decode(const Params& P, int layer, int id, int lane) {
    const int me = id >> 9, q = id & 511, mat = me % 3, e = me / 3;
    BgChunk c;
    if (mat < 2) { const int nb = q >> 6, kb = q & 63, n = nb * 64 + lane;
        c.src = (mat ? P.in[18] : P.in[17]) + ((size_t)layer * NE + e) * (size_t)(D * DE) + (size_t)(kb * 16) * DE + n; c.nstride = DE;
        c.dst = (bf16_t*)(P.ws + WS_W13) + ((size_t)layer * NE + e) * (size_t)(D * D) + (size_t)((n >> 7) * 256 + mat * 128 + (n & 127)) * D + kb * 16; }
    else { const int nb = q >> 5, kb = q & 31, n = nb * 64 + lane;
        c.src = P.in[19] + ((size_t)layer * NE + e) * (size_t)(D * DE) + (size_t)(kb * 16) * D + n; c.nstride = D;
        c.dst = (bf16_t*)(P.ws + WS_W2) + ((size_t)layer * NE + e) * (size_t)(D * DE) + (size_t)n * DE + kb * 16; }
    return c;
}
__device__ __forceinline__ float fast_sigmoid(float x) { return __builtin_amdgcn_rcpf(1.f + __builtin_amdgcn_exp2f(-1.4426950408889634f * x)); }
template <int VAR = 0> __device__ __forceinline__ void phase_rglru(LAS unsigned char* lds, const int tid_in, int bid, int G, bool dry = false) {
    const Params P = kparams();
    unsigned char* ws = P.ws;
    const bf16_t* Gt = (const bf16_t*)(ws + WS_M + M_G); bf16_t* Yo = dry ? (bf16_t*)P.out : (bf16_t*)(ws + WS_M + M_G); const bf16_t* XR = (const bf16_t*)(ws + WS_M + M_XR);
    int tid = tid_in; asm volatile("" : "+v"(tid));
    const int lane = tid & 63, w = __builtin_amdgcn_readfirstlane(tid >> 6), fr = lane & 15, fq = lane >> 4;
    LAS v2u* gfl = (LAS v2u*)(lds + RG_GF_OFF);
    LAS float* cst = (LAS float*)(lds + RG_C_OFF);
    LAS float* tot = (LAS float*)(lds + RG_TOT_OFF);
    LAS float* hinb = (LAS float*)(lds + RG_TOT_OFF + 5120);
    const int vcu = (G % 8 == 0) ? (bid % 8) * (G / 8) + bid / 8 : bid;
    int xro[3], gro[3];
    unsigned xgo[3];
#pragma unroll
    for (int i = 0; i < 3; ++i) { const int idx = tid + i * NTHREADS, rw = idx / 10, ch = idx % 10;
        xro[i] = (idx < 1310) ? rw * RG_RS + ch * 16 : -1; gro[i] = (idx < 1280) ? rw * RG_RS + ch * 16 : -1; xgo[i] = (unsigned)(rw * DR + ch * 8); }
    const int bg_cpw = (BG_CHUNKS + G * NWAVES - 1) / (G * NWAVES);
    int bg_next = (bid * NWAVES + w) * bg_cpw, bg_end = bg_next + bg_cpw; if (bg_end > BG_CHUNKS) bg_end = BG_CHUNKS; if (!BG_IN_RGLRU || dry) bg_next = bg_end;
    float bgv[2][16]; bf16_t* bgd[2]; bool bgh[2];
#pragma unroll
    for (int s = 0; s < 2; ++s) { bgd[s] = nullptr; bgh[s] = false;
#pragma unroll
        for (int k = 0; k < 16; ++k) bgv[s][k] = 0.f; }
#define BG_ISSUE(s) do { bgh[s] = bg_next < bg_end; if (bgh[s]) { const BgChunk c_ = bg_decode(P, 0, bg_next, lane); ++bg_next; bgd[s] = c_.dst; \
        _Pragma("unroll") for (int k = 0; k < 16; ++k) bgv[s][k] = __builtin_nontemporal_load(c_.src + (size_t)k * c_.nstride); } } while (0)
#define BG_FINISH(s) do { if (bgh[s]) { v4u o0_, o1_; \
        o0_.x = pg8::cvt_pk_bf16(bgv[s][0], bgv[s][1]); o0_.y = pg8::cvt_pk_bf16(bgv[s][2], bgv[s][3]); o0_.z = pg8::cvt_pk_bf16(bgv[s][4], bgv[s][5]); o0_.w = pg8::cvt_pk_bf16(bgv[s][6], bgv[s][7]); \
        o1_.x = pg8::cvt_pk_bf16(bgv[s][8], bgv[s][9]); o1_.y = pg8::cvt_pk_bf16(bgv[s][10], bgv[s][11]); o1_.z = pg8::cvt_pk_bf16(bgv[s][12], bgv[s][13]); o1_.w = pg8::cvt_pk_bf16(bgv[s][14], bgv[s][15]); \
        BG_ST(o0_, (v4u*)bgd[s]); BG_ST(o1_, (v4u*)bgd[s] + 1); bgh[s] = false; } } while (0)
    for (int unit = vcu; unit < BATCH * 16; unit += G) {
        const int b = unit >> 4, n = unit & 15;
        const bf16_t* xbase = XR + ((size_t)b * SEQ) * DR + n * 80; const bf16_t* gbase = Gt + ((size_t)b * SEQ) * DR + n * 80; bf16_t* ybase = Yo + ((size_t)b * SEQ) * DR + n * 80;
#define RG_FETCH(rr) do { _Pragma("unroll") for (int i = 0; i < 3; ++i) { xs[i] = (v4u){0u, 0u, 0u, 0u}; gs[i] = (v4u){0u, 0u, 0u, 0u}; \
            if (xro[i] >= 0 && ((rr) > 0 || xro[i] >= 3 * RG_RS)) xs[i] = NT_LOAD_S(2, (const v4u*)(xbase + (long)(128 * (rr) - 3) * DR + xgo[i])); \
            if (gro[i] >= 0) gs[i] = NT_LOAD_S(2, (const v4u*)(gbase + (size_t)(128 * (rr)) * DR + xgo[i])); } } while (0)
#define RG_STASH(bufi) do { _Pragma("unroll") for (int i = 0; i < 3; ++i) { \
            if (xro[i] >= 0) *(LAS v4u*)(lds + RG_X_OFF + (bufi) * RG_XB + xro[i]) = xs[i]; \
            if (gro[i] >= 0) *(LAS v4u*)(lds + RG_G_OFF + (bufi) * RG_GB + gro[i]) = gs[i]; } } while (0)
#define RG_YSTORE(rr) do { _Pragma("unroll") for (int i = 0; i < 3; ++i) { if (gro[i] >= 0) \
            st16_wt(ybase + (size_t)(128 * (rr)) * DR + xgo[i], *(const LAS v4u*)(lds + RG_Y_OFF + gro[i])); } } while (0)
        v4u xs[3], gs[3];
        __syncthreads();
        RG_FETCH(0);
        { const v2u* GF = (const v2u*)(ws + WS_GF);
          v2u gtmp[7];
#pragma unroll
          for (int k = 0; k < 7; ++k) { const int i = tid + k * NTHREADS, mat = i / 1600, rem = i % 1600; gtmp[k] = (i < 2 * 1600) ? GF[(size_t)(mat * 16 + n) * 1600 + rem] : (v2u){0u, 0u}; }
#pragma unroll
          for (int k = 0; k < 7; ++k) { const int i = tid + k * NTHREADS; if (i < 2 * 1600) gfl[i] = gtmp[k]; }
          if (tid < 80) { const int c = n * 80 + tid;
              cst[0 * 80 + tid] = P.in[2][0 * DR + c]; cst[1 * 80 + tid] = P.in[2][1 * DR + c]; cst[2 * 80 + tid] = P.in[2][2 * DR + c]; cst[3 * 80 + tid] = P.in[2][3 * DR + c];
              cst[4 * 80 + tid] = P.in[3][c]; cst[5 * 80 + tid] = -1.4426950408889634f * P.in[5][c]; cst[6 * 80 + tid] = -1.4426950408889634f * P.in[7][c];
              cst[7 * 80 + tid] = -8.0f * log1pf(expf(-P.in[8][c])) * 1.4426950408889634f; } }
        RG_STASH(0);
        __syncthreads();
        float hcar = 0.f;
#pragma unroll 1
        for (int r = 0; r < SEQ / 128; ++r) {
            const LAS unsigned char* xb = lds + RG_X_OFF + (r & 1) * RG_XB + (16 * w + fr) * RG_RS + 8 * fq;
            const LAS unsigned char* gb = lds + RG_G_OFF + (r & 1) * RG_GB + (16 * w + fr) * RG_RS + 8 * fq;
            if (!(VAR & 2)) { if (r + 1 < SEQ / 128) RG_FETCH(r + 1); }
            BG_FINISH(0); BG_FINISH(1); BG_ISSUE(0); BG_ISSUE(1);
            float xc[5][4]; s16x4 bfr[5];
#pragma unroll
            for (int ks = 0; ks < 5; ++ks) {
                const int c0 = 16 * ks + 4 * fq;
                f32x4 s = *(LAS f32x4*)(cst + 4 * 80 + c0);
#pragma unroll
                for (int k = 0; k < 4; ++k) { const f32x4 wv = *(LAS f32x4*)(cst + k * 80 + c0); const v2u x = *(const LAS v2u*)(xb + k * RG_RS + 32 * ks);
                    s[0] += __uint_as_float(x.x << 16) * wv[0]; s[1] += __uint_as_float(x.x & 0xffff0000u) * wv[1]; s[2] += __uint_as_float(x.y << 16) * wv[2]; s[3] += __uint_as_float(x.y & 0xffff0000u) * wv[3]; }
#pragma unroll
                for (int j = 0; j < 4; ++j) xc[ks][j] = s[j];
                bfr[ks] = __builtin_bit_cast(s16x4, (v2u){pg8::cvt_pk_bf16(s[0], s[1]), pg8::cvt_pk_bf16(s[2], s[3])});
            }
            f32x4 ra[5], ia[5];
#pragma unroll
            for (int jt = 0; jt < 5; ++jt) { ra[jt] = (f32x4){0.f, 0.f, 0.f, 0.f}; ia[jt] = (f32x4){0.f, 0.f, 0.f, 0.f};
#pragma unroll
                for (int ks = 0; ks < 5; ++ks) {
                    const s16x4 ar = __builtin_bit_cast(s16x4, gfl[(jt * 5 + ks) * 64 + lane]), ai = __builtin_bit_cast(s16x4, gfl[1600 + (jt * 5 + ks) * 64 + lane]);
                    ra[jt] = __builtin_amdgcn_mfma_f32_16x16x16bf16_1k(ar, bfr[ks], ra[jt], 0, 0, 0);
                    ia[jt] = __builtin_amdgcn_mfma_f32_16x16x16bf16_1k(ai, bfr[ks], ia[jt], 0, 0, 0);
                } }
            float A[5][4], U[5][4];
#pragma unroll
            for (int jt = 0; jt < 5; ++jt) {
                const int c0 = 16 * jt + 4 * fq;
                const f32x4 brv = *(LAS f32x4*)(cst + 5 * 80 + c0), biv = *(LAS f32x4*)(cst + 6 * 80 + c0), cav = *(LAS f32x4*)(cst + 7 * 80 + c0);
#pragma unroll
                for (int j = 0; j < 4; ++j) {
                    const float rg = __builtin_amdgcn_rcpf(1.f + __builtin_amdgcn_exp2f(__builtin_fmaf(ra[jt][j], -1.4426950408889634f, brv[j]))), ig = __builtin_amdgcn_rcpf(1.f + __builtin_amdgcn_exp2f(__builtin_fmaf(ia[jt][j], -1.4426950408889634f, biv[j])));
                    const float la2 = rg * cav[j];
                    float a = __builtin_amdgcn_exp2f(la2);
                    float u = __builtin_amdgcn_sqrtf(fmaxf(1.f - a * a, 0.f)) * (ig * xc[jt][j]);
                    A[jt][j] = a; U[jt][j] = u;
                }
#define RG_SCAN4(S) asm volatile("s_nop 1\n\t" \
                    "v_fmac_f32_dpp %0, %0, %4 row_shr:" #S " row_mask:0xf bank_mask:0xf\n\tv_fmac_f32_dpp %1, %1, %5 row_shr:" #S " row_mask:0xf bank_mask:0xf\n\t" \
                    "v_fmac_f32_dpp %2, %2, %6 row_shr:" #S " row_mask:0xf bank_mask:0xf\n\tv_fmac_f32_dpp %3, %3, %7 row_shr:" #S " row_mask:0xf bank_mask:0xf\n\t" \
                    "v_mul_f32_dpp %4, %4, %4 row_shr:" #S " row_mask:0xf bank_mask:0xf\n\tv_mul_f32_dpp %5, %5, %5 row_shr:" #S " row_mask:0xf bank_mask:0xf\n\t" \
                    "v_mul_f32_dpp %6, %6, %6 row_shr:" #S " row_mask:0xf bank_mask:0xf\n\tv_mul_f32_dpp %7, %7, %7 row_shr:" #S " row_mask:0xf bank_mask:0xf" \
                    : "+v"(U[jt][0]), "+v"(U[jt][1]), "+v"(U[jt][2]), "+v"(U[jt][3]), "+v"(A[jt][0]), "+v"(A[jt][1]), "+v"(A[jt][2]), "+v"(A[jt][3]))
                RG_SCAN4(1); RG_SCAN4(2); RG_SCAN4(4); RG_SCAN4(8);
#undef RG_SCAN4
            }
            if (fr == 15) {
#pragma unroll
                for (int jt = 0; jt < 5; ++jt)
#pragma unroll
                    for (int j = 0; j < 4; j += 2) *(LAS f32x4*)(tot + w * 160 + (16 * jt + 4 * fq + j) * 2) = (f32x4){A[jt][j], U[jt][j], A[jt][j + 1], U[jt][j + 1]};
            }
            if (!(VAR & 1)) __syncthreads();
            if (tid < 80) { f32x2v qv[8];
#pragma unroll
                for (int ww = 0; ww < 8; ++ww) qv[ww] = *(LAS f32x2v*)(tot + ww * 160 + tid * 2);
#pragma unroll
                for (int ww = 0; ww < 8; ++ww) { hinb[ww * 80 + tid] = hcar; hcar = qv[ww].x * hcar + qv[ww].y; }
            }
            if (r > 0 && !(WOUT_F8 && !dry)) RG_YSTORE(r - 1);
            if (!(VAR & 2)) { if (r + 1 < SEQ / 128) RG_STASH((r + 1) & 1); }
            if (!(VAR & 1)) __syncthreads();
#pragma unroll
            for (int jt = 0; jt < 5; ++jt) {
                const f32x4 hq = *(LAS f32x4*)(hinb + w * 80 + 16 * jt + 4 * fq);
                const v2u gv = *(const LAS v2u*)(gb + 32 * jt);
                float y[4];
#pragma unroll
                for (int j = 0; j < 4; ++j) {
                    const float h = A[jt][j] * hq[j] + U[jt][j];
                    const unsigned gw = (j < 2) ? gv.x : gv.y;
                    const float gt = (j & 1) ? __uint_as_float(gw & 0xffff0000u) : __uint_as_float(gw << 16);
                    const float arg = gt * __builtin_fmaf(gt * gt, -0.10294324f, -2.3022082f);
                    y[j] = (h * gt) * __builtin_amdgcn_rcpf(1.f + __builtin_amdgcn_exp2f(arg));
                }
                if (WOUT_F8 && !dry) { const float s8 = (float)(1 << Y8_SHIFT);
                    *(unsigned*)(ws + WS_M + M_Y8 + ((size_t)b * SEQ + 128 * r + 16 * w + fr) * DR + n * 80 + 16 * jt + 4 * fq) = pk_fp8x4(y[0] * s8, y[1] * s8, y[2] * s8, y[3] * s8); }
                else *(LAS v2u*)(lds + RG_Y_OFF + (16 * w + fr) * RG_RS + 8 * fq + 32 * jt) = (v2u){pg8::cvt_pk_bf16(y[0], y[1]), pg8::cvt_pk_bf16(y[2], y[3])};
            }
        }
        __syncthreads();
        if (!(WOUT_F8 && !dry)) RG_YSTORE(SEQ / 128 - 1);
#undef RG_FETCH
#undef RG_STASH
#undef RG_YSTORE
    }
    BG_FINISH(0); BG_FINISH(1);
    while (bg_next < bg_end) { BG_ISSUE(0); BG_FINISH(0); }
#undef BG_ISSUE
#undef BG_FINISH
}
#ifndef PROBE_MASK
#define PROBE_MASK 0
#endif
#ifndef PROBE_VAR
#define PROBE_VAR 0
#endif
#ifndef PROBE_PFX_NULL
#define PROBE_PFX_NULL 0
#endif
#ifndef PROBE_DOWNVAR
#define PROBE_DOWNVAR 0
#endif
#if PROBE_DOWNVAR
#define DOWNVAR_CALL phase_moe_down_var<PROBE_DOWNVAR>(0, lds, tid_in, bid, G);
#else
#define DOWNVAR_CALL
#endif
#ifndef PROBE_UPVAR
#define PROBE_UPVAR 0
#endif
#if PROBE_UPVAR == 1
#define UPVAR_CALL phase_moe_up_null<true>(0, lds, tid_in, bid, G);
#elif PROBE_UPVAR == 2
#define UPVAR_CALL phase_moe_up_null<false>(0, lds, tid_in, bid, G);
#else
#define UPVAR_CALL
#endif
#ifndef PROBE_HALFLN
#define PROBE_HALFLN 0
#endif
#ifndef LN_V2
#define LN_V2 1
#endif
#if LN_V2
#define LN_FN phase_ln2
#else
#define LN_FN phase_ln
#endif
#ifndef PROBE_DRY
#define PROBE_DRY 0
#endif
struct Args { Params P; int ph_lo, ph_hi; };
__device__ __forceinline__ int lane_id_now() { int l; asm volatile("v_mbcnt_lo_u32_b32 %0, -1, 0\n\tv_mbcnt_hi_u32_b32 %0, -1, %0" : "=v"(l)); return l; }
__global__ void __launch_bounds__(NTHREADS, 2) mk_fwd(Args a) {
    extern __shared__ __attribute__((aligned(16))) unsigned char lds_raw[];
    LAS unsigned char* lds = (LAS unsigned char*)lds_raw;
    const int wv = __builtin_amdgcn_readfirstlane(threadIdx.x >> 6);
#define MYTID(wvv) ((wvv) * 64 + lane_id_now())
    volatile LAS unsigned* bst = (volatile LAS unsigned*)(lds + LDS_BYTES - 16);
    { const int t0 = MYTID(wv); if (t0 < 4) bst[t0] = 0u;
      __syncthreads();
      const Params P0 = kparams(); (void)xcd_barrier_post((unsigned*)(P0.ws + WS_BAR), bst, t0); }
#define SEAM(ph) do { if (hi > PH_COUNT) cg::this_grid().sync();   { const Params Pb = kparams(); XcdBarrier xb; xb.bar = (unsigned*)(Pb.ws + WS_BAR); xb.x = xb_xcc_id(); xb.st = bst; xcd_barrier(xb, tid_in); } } while (0)
#define RUN(ph, call) do { if (lo <= (ph) && (ph) < hi) { int bid = blockIdx.x, G = gridDim.x, wvl = wv; asm volatile("" : "+s"(bid), "+s"(G), "+s"(wvl)); const int tid_in = MYTID(wvl); \
        call; if ((PROBE_MASK >> (ph)) & 1) { call; } if ((ph) + 1 < hi && (ph) != PH_UP0 && (ph) != PH_UP1 && !(MIXQ && (ph) == PH_COMB0 && gridDim.x % 8 == 0)) SEAM(ph); } } while (0)
#define PHASE_PROGRAM \
    RUN(PH_PROLOGUE, phase_prologue(lds, tid_in, bid, G)); \
    RUN(PH_WIN, { if (pfx && PROBE_PFX_NULL) phase_gemm_win_null(lds, tid_in, bid, G); else if (MIXWIN) phase_win_mixed(lds, tid_in, bid, G); else phase_gemm_win(lds, tid_in, bid, G); }); \
    if ((PROBE_DRY >> PH_RGLRU) & 1) { int bid = blockIdx.x, G = gridDim.x; asm volatile("" : "+s"(bid), "+s"(G)); phase_rglru<PROBE_VAR>(lds, MYTID(wv), bid, G, true); } \
    RUN(PH_RGLRU, phase_rglru(lds, tid_in, bid, G)); \
    RUN(PH_WOUT, phase_gemm_wout(lds, tid_in, bid, G)); \
    RUN(PH_LN0, { if (PROBE_HALFLN == 1) phase_ln2<PROBE_VAR>(0, lds, tid_in, bid, G, true); else if (PROBE_HALFLN == 3) { for (int rep_ = 0; rep_ < 2; ++rep_) { asm volatile("" : "+s"(bid), "+s"(G)); phase_ln2<PROBE_VAR>(0, lds, tid_in, bid, G, true); } } else if (PROBE_HALFLN == 2) { if ((bid & 7) < 4) phase_ln(0, lds, tid_in, (bid >> 3) * 4 + (bid & 7), G / 2, true); } LN_FN(0, lds, tid_in, bid, G); }); \
    RUN(PH_ROUTE0, phase_route(lds, tid_in, bid, G)); \
    RUN(PH_UP0, { UPVAR_CALL phase_moe_up(0, lds, tid_in, bid, G); }); \
    RUN(PH_DOWN0, { DOWNVAR_CALL phase_moe_down(0, lds, tid_in, bid, G); }); \
    RUN(PH_COMB0, { if (!(MIXQ && G % 8 == 0)) phase_combine(0, tid_in, bid, G); }); \
    RUN(PH_QKV, { if (MIXQ && G % 8 == 0) phase_qkv_mixed(lds, tid_in, bid, G); else phase_gemm_qkv(lds, tid_in, bid, G); }); \
    if ((PROBE_DRY >> PH_ATTN) & 1) { int bid = blockIdx.x, G = gridDim.x; asm volatile("" : "+s"(bid), "+s"(G)); phase_attn<PROBE_VAR>(lds, MYTID(wv), bid, G); } \
    RUN(PH_ATTN, phase_attn(lds, tid_in, bid, G)); \
    RUN(PH_WO, phase_gemm_wo(lds, tid_in, bid, G)); \
    RUN(PH_LN1, LN_FN(1, lds, tid_in, bid, G)); \
    RUN(PH_ROUTE1, phase_route(lds, tid_in, bid, G)); \
    RUN(PH_UP1, phase_moe_up(1, lds, tid_in, bid, G)); \
    RUN(PH_DOWN1, phase_moe_down(1, lds, tid_in, bid, G)); \
    RUN(PH_COMB1, phase_combine(1, tid_in, bid, G));
#ifdef PROBE_PREFIX
    { const int lo = 0, hi = PROBE_PREFIX; const bool pfx = true; PHASE_PROGRAM { const int tid_in = MYTID(wv); SEAM(0); } }
#endif
    { const int lo = a.ph_lo, hi = a.ph_hi; const bool pfx = false; PHASE_PROGRAM }
#ifdef PROBE_XBAR
    { const int hi = a.ph_hi; const int tid_in = MYTID(wv); for (int i = 0; i < PROBE_XBAR; ++i) SEAM(PH_COUNT - 1); }
#endif
#undef RUN
#undef SEAM
#undef MYTID
}
static int g_grid = 0;
extern "C" void kernel_launch(void* const* d_in, const int* in_sizes, int n_in, void* d_out, int out_size, void* d_ws, size_t ws_size, hipStream_t stream) {
    if (ws_size < WS_END || n_in < 22) { fprintf(stderr, "kernel_launch: workspace too small (%zu < %zu) or %d inputs\n", ws_size, (size_t)WS_END, n_in); return; }
    if (g_grid == 0) {
        int dev = 0, cus = 0, per_cu = 0;
        (void)hipGetDevice(&dev); (void)hipDeviceGetAttribute(&cus, hipDeviceAttributeMultiprocessorCount, dev);
        if (hipFuncSetAttribute((const void*)mk_fwd, hipFuncAttributeMaxDynamicSharedMemorySize, LDS_BYTES) != hipSuccess) fprintf(stderr, "kernel_launch: hipFuncSetAttribute failed\n");
        if (hipOccupancyMaxActiveBlocksPerMultiprocessor(&per_cu, (const void*)mk_fwd, NTHREADS, LDS_BYTES) != hipSuccess || per_cu < 1) { fprintf(stderr, "kernel_launch: occupancy query says %d blocks per CU\n", per_cu); per_cu = 1; }
        (void)hipGetLastError();
        g_grid = cus;
    }
    (void)hipMemsetAsync((unsigned char*)d_ws + WS_READY, 0, WS_BAR + 16384 - WS_READY, stream);
    Args a{};
    for (int i = 0; i < 22; ++i) a.P.in[i] = (const float*)d_in[i];
    a.P.out = (float*)d_out; a.P.ws = (unsigned char*)d_ws;
    a.ph_lo = 0; a.ph_hi = PH_COUNT;
    void* args[] = {&a};
    hipError_t e = hipLaunchCooperativeKernel((const void*)mk_fwd, dim3(g_grid), dim3(NTHREADS), args, LDS_BYTES, stream);
    if (e != hipSuccess) fprintf(stderr, "kernel_launch: cooperative launch failed: %s (grid %d)\n", hipGetErrorString(e), g_grid);
}
```
